# Optimizing an MI355X kernel written in HIP

```python
import math
import jax, jax.numpy as jnp
from jax import lax
import numpy as np

D_MODEL = 1024
BATCH = 16
SEQ = 2048
DEPTH = 1

GRID_W = 64
CTX_LEN = 256

N_HEADS = 8
N_KV_HEADS = 2
HEAD_DIM = 128
ATTN_DIM = N_HEADS * HEAD_DIM
KV_DIM = N_KV_HEADS * HEAD_DIM
Q_BLOCK = 128
ROPE_THETA = 10000.0
ROPE_AXIS_DIM = HEAD_DIM // 2

SSM_DIM = 512
SSM_GROUP = 16
N_SSM_GROUPS = SSM_DIM // SSM_GROUP
SSM_STATE = 64
N_DIRECTIONS = 2
DT_MIN = 1e-3
DT_MAX = 1e-1

N_BRANCHES = 2
Q_END = ATTN_DIM
K_END = Q_END + KV_DIM
V_END = K_END + KV_DIM
U_END = V_END + SSM_DIM
D_IN = U_END + N_BRANCHES * D_MODEL

D_FF = 2816
CONV_W = 3

N_MOD = 6
EPS = 1e-6

kernel_name = 'hybrid_s5_gqa_convffn_dit_prefix'


def _rmsnorm(x, w):
    xf = x.astype(jnp.float32)
    y = xf * lax.rsqrt(jnp.mean(xf * xf, axis=-1, keepdims=True) + EPS)
    return (y * w.astype(jnp.float32)).astype(x.dtype)


def _modulate(h, shift, scale):
    return h * (1.0 + scale) + shift


def _heads(t, n_heads):
    b, l, _ = t.shape
    return t.reshape(b, l, n_heads, HEAD_DIM).transpose(0, 2, 1, 3)


def _tokens(t):
    b, n, l, dh = t.shape
    return t.transpose(0, 2, 1, 3).reshape(b, l, n * dh)


def _rope_tables(rows, cols):
    inv_freq = ROPE_THETA ** (-jnp.arange(0, ROPE_AXIS_DIM, 2, dtype=jnp.float32) / ROPE_AXIS_DIM)
    ang = jnp.concatenate([rows[:, None] * inv_freq, cols[:, None] * inv_freq], axis=-1)
    return jnp.cos(ang), jnp.sin(ang)


def _apply_rope(t, cos, sin):
    tf = t.astype(jnp.float32).reshape(*t.shape[:-1], HEAD_DIM // 2, 2)
    t0, t1 = tf[..., 0], tf[..., 1]
    out = jnp.stack([t0 * cos - t1 * sin, t0 * sin + t1 * cos], axis=-1)
    return out.reshape(t.shape).astype(t.dtype)


def _gqa_sweep(q, k, v):
    b, h, lq, dh = q.shape
    rep = h // N_KV_HEADS
    nblk = lq // Q_BLOCK
    qb = jnp.moveaxis(q.reshape(b, N_KV_HEADS, rep, nblk, Q_BLOCK, dh), 3, 0)
    scale = 1.0 / math.sqrt(HEAD_DIM)

    def one_block(q_blk):
        s = jnp.einsum('bkgqd,bktd->bkgqt', q_blk, k).astype(jnp.float32) * scale
        p = jax.nn.softmax(s, axis=-1).astype(v.dtype)
        return jnp.einsum('bkgqt,bktd->bkgqd', p, v)

    o = lax.map(one_block, qb)
    return jnp.moveaxis(o, 0, 3).reshape(b, h, lq, dh)


def _zoh(lam_re, lam_im, log_dt, b_re, b_im):
    lam_re = lam_re.astype(jnp.float32)
    lam_im = lam_im.astype(jnp.float32)
    b_re = b_re.astype(jnp.float32)
    b_im = b_im.astype(jnp.float32)
    dt = jnp.exp(log_dt.astype(jnp.float32))[:, None]
    mag = jnp.exp(lam_re * dt)
    ang = lam_im * dt
    abar_re = mag * jnp.cos(ang)
    abar_im = mag * jnp.sin(ang)
    den = lam_re * lam_re + lam_im * lam_im
    nr = abar_re - 1.0
    ni = abar_im
    f_re = (nr * lam_re + ni * lam_im) / den
    f_im = (ni * lam_re - nr * lam_im) / den
    bbar_re = f_re[..., None] * b_re - f_im[..., None] * b_im
    bbar_im = f_re[..., None] * b_im + f_im[..., None] * b_re
    return abar_re, abar_im, bbar_re, bbar_im


def _ssm_combine(first, second):
    a_re, a_im, x_re, x_im = first
    b_re, b_im, y_re, y_im = second
    return (a_re * b_re - a_im * b_im,
            a_re * b_im + a_im * b_re,
            b_re * x_re - b_im * x_im + y_re,
            b_re * x_im + b_im * x_re + y_im)


def _s5_direction(u_ctx, u_lat, lam_re, lam_im, log_dt, b_re, b_im, reverse):
    abar_re, abar_im, bbar_re, bbar_im = _zoh(lam_re, lam_im, log_dt, b_re, b_im)

    def drive(u):
        return (jnp.einsum('blgp,gnp->blgn', u, bbar_re),
                jnp.einsum('blgp,gnp->blgn', u, bbar_im))

    def scan(bu_re, bu_im):
        l = bu_re.shape[1]
        a_re = jnp.broadcast_to(abar_re, (1, l) + abar_re.shape)
        a_im = jnp.broadcast_to(abar_im, (1, l) + abar_im.shape)
        _, _, s_re, s_im = lax.associative_scan(
            _ssm_combine, (a_re, a_im, bu_re, bu_im), reverse=reverse, axis=1)
        return s_re, s_im

    ctx_end = 0 if reverse else -1
    lat_start = -1 if reverse else 0
    sc_re, sc_im = scan(*drive(u_ctx))
    s0_re, s0_im = sc_re[:, ctx_end], sc_im[:, ctx_end]
    bl_re, bl_im = drive(u_lat)
    bl_re = bl_re.at[:, lat_start].add(abar_re * s0_re - abar_im * s0_im)
    bl_im = bl_im.at[:, lat_start].add(abar_re * s0_im + abar_im * s0_re)
    sl_re, sl_im = scan(bl_re, bl_im)
    return sl_re, sl_im, sc_re, sc_im


def _s5_readout(s_re, s_im, c_re, c_im):
    y = (jnp.einsum('blgn,gpn->blgp', s_re, c_re.astype(jnp.float32))
         - jnp.einsum('blgn,gpn->blgp', s_im, c_im.astype(jnp.float32)))
    return y.reshape(y.shape[0], y.shape[1], SSM_DIM)


def _s5_bidirectional(u_lat, u_ctx, lam_re, lam_im, log_dt, b_re, b_im, c_re, c_im, d_skip, with_ctx_out):
    b, l, _ = u_lat.shape
    lc = u_ctx.shape[1]
    ul = u_lat.astype(jnp.float32).reshape(b, l, N_SSM_GROUPS, SSM_GROUP)
    uc = u_ctx.astype(jnp.float32).reshape(b, lc, N_SSM_GROUPS, SSM_GROUP)
    d = d_skip.astype(jnp.float32)
    y_lat = u_lat.astype(jnp.float32) * d
    ctx_terms = [u_ctx.astype(jnp.float32) * d] if with_ctx_out else []
    for direction in range(N_DIRECTIONS):
        sl_re, sl_im, sc_re, sc_im = _s5_direction(
            uc, ul, lam_re[direction], lam_im[direction], log_dt[direction],
            b_re[direction], b_im[direction], reverse=(direction == 1))
        y_lat = y_lat + _s5_readout(sl_re, sl_im, c_re[direction], c_im[direction])
        if with_ctx_out:
            ctx_terms.append(_s5_readout(sc_re, sc_im, c_re[direction], c_im[direction]))
    y_ctx = sum(ctx_terms).astype(u_ctx.dtype) if with_ctx_out else None
    return y_lat.astype(u_lat.dtype), y_ctx


def _merge_branches(attn_tok, ssm_tok, g, w_attn_br, w_glu, w_out):
    p_attn = attn_tok @ w_attn_br
    glu_a, glu_b = jnp.split(jax.nn.gelu(ssm_tok) @ w_glu, 2, axis=-1)
    p_ssm = glu_a * jax.nn.sigmoid(glu_b)
    g_attn, g_ssm = jnp.split(g, N_BRANCHES, axis=-1)
    return (jax.nn.sigmoid(g_attn) * p_attn + jax.nn.sigmoid(g_ssm) * p_ssm) @ w_out


def _conv_ffn(h, w_up, conv_w, conv_b, w_down):
    z = h @ w_up
    l = z.shape[1]
    pad = CONV_W // 2
    zp = jnp.pad(z, ((0, 0), (pad, pad), (0, 0)))
    z = sum(zp[:, j:j + l] * conv_w[j] for j in range(CONV_W)) + conv_b
    val, gate = jnp.split(z, 2, axis=-1)
    return (jax.nn.silu(gate) * val) @ w_down


def setup_inputs(seed: int = 0) -> dict:
    key = jax.random.key(seed)
    ks = jax.random.split(key, 32)
    f32 = jnp.float32
    G, N, P = N_SSM_GROUPS, SSM_STATE, SSM_GROUP

    def nrm(k, shape, scale):
        return jax.random.normal(k, shape, f32) * scale

    n_idx = jnp.arange(N, dtype=f32)
    lam_re = -0.5 + nrm(ks[10], (DEPTH, N_DIRECTIONS, G, N), 0.01)
    lam_im = math.pi * n_idx + nrm(ks[11], (DEPTH, N_DIRECTIONS, G, N), 0.01)
    log_dt = jax.random.uniform(ks[12], (DEPTH, N_DIRECTIONS, G), f32,
                                math.log(DT_MIN), math.log(DT_MAX))
    return {
        'x': nrm(ks[0], (BATCH, SEQ, D_MODEL), 1.0),
        'c': nrm(ks[1], (BATCH, D_MODEL), 1.0),
        'ctx': nrm(ks[2], (BATCH, CTX_LEN, D_MODEL), 1.0),
        'c_ctx': nrm(ks[3], (D_MODEL,), 1.0),
        'w_mod': nrm(ks[4], (DEPTH, D_MODEL, N_MOD * D_MODEL), 0.5 * D_MODEL ** -0.5),
        'b_mod': nrm(ks[5], (DEPTH, N_MOD * D_MODEL), 0.02),
        'norm1_w': 1.0 + nrm(ks[6], (DEPTH, D_MODEL), 0.02),
        'norm2_w': 1.0 + nrm(ks[7], (DEPTH, D_MODEL), 0.02),
        'w_in': nrm(ks[8], (DEPTH, D_MODEL, D_IN), D_MODEL ** -0.5),
        'q_norm_w': 1.0 + nrm(ks[9], (DEPTH, HEAD_DIM), 0.02),
        'k_norm_w': 1.0 + nrm(ks[13], (DEPTH, HEAD_DIM), 0.02),
        'w_attn_br': nrm(ks[14], (DEPTH, ATTN_DIM, D_MODEL), ATTN_DIM ** -0.5),
        'ssm_lambda_re': lam_re,
        'ssm_lambda_im': lam_im,
        'ssm_log_dt': log_dt,
        'ssm_b_re': nrm(ks[15], (DEPTH, N_DIRECTIONS, G, N, P), (2 * P) ** -0.5),
        'ssm_b_im': nrm(ks[16], (DEPTH, N_DIRECTIONS, G, N, P), (2 * P) ** -0.5),
        'ssm_c_re': nrm(ks[17], (DEPTH, N_DIRECTIONS, G, P, N), (2 * N) ** -0.5),
        'ssm_c_im': nrm(ks[18], (DEPTH, N_DIRECTIONS, G, P, N), (2 * N) ** -0.5),
        'ssm_d': nrm(ks[19], (DEPTH, SSM_DIM), 1.0),
        'w_glu': nrm(ks[20], (DEPTH, SSM_DIM, 2 * D_MODEL), SSM_DIM ** -0.5),
        'w_out': nrm(ks[21], (DEPTH, D_MODEL, D_MODEL), D_MODEL ** -0.5),
        'w_up': nrm(ks[22], (DEPTH, D_MODEL, 2 * D_FF), D_MODEL ** -0.5),
        'conv_w': nrm(ks[23], (DEPTH, CONV_W, 2 * D_FF), CONV_W ** -0.5),
        'conv_b': nrm(ks[24], (DEPTH, 2 * D_FF), 0.02),
        'w_down': nrm(ks[25], (DEPTH, D_FF, D_MODEL), D_FF ** -0.5),
        'final_norm_w': 1.0 + nrm(ks[26], (D_MODEL,), 0.02),
    }


def reference(x, c, ctx, c_ctx, w_mod, b_mod, norm1_w, norm2_w, w_in, q_norm_w, k_norm_w,
              w_attn_br, ssm_lambda_re, ssm_lambda_im, ssm_log_dt, ssm_b_re, ssm_b_im,
              ssm_c_re, ssm_c_im, ssm_d, w_glu, w_out, w_up, conv_w, conv_b, w_down,
              final_norm_w):
    l = x.shape[1]
    ROWS = l // GRID_W
    rows = jnp.repeat(jnp.arange(ROWS, dtype=jnp.float32), GRID_W)
    cols = jnp.tile(jnp.arange(GRID_W, dtype=jnp.float32), ROWS)
    cos, sin = _rope_tables(rows, cols)

    for layer in range(DEPTH):
        update_ctx = layer < DEPTH - 1
        mod = jax.nn.silu(c) @ w_mod[layer] + b_mod[layer]
        mod_c = jax.nn.silu(c_ctx) @ w_mod[layer] + b_mod[layer]
        sh1, sc1, g1, sh2, sc2, g2 = jnp.split(mod[:, None, :], N_MOD, axis=-1)
        csh1, csc1, cg1, csh2, csc2, cg2 = jnp.split(mod_c, N_MOD, axis=-1)
        w_in_l = w_in[layer]

        h = _modulate(_rmsnorm(x, norm1_w[layer]), sh1, sc1)
        hc = _modulate(_rmsnorm(ctx, norm1_w[layer]), csh1, csc1)
        q, k, v, u, g = jnp.split(h @ w_in_l, (Q_END, K_END, V_END, U_END), axis=-1)
        kc, vc, uc = jnp.split(hc @ w_in_l[:, Q_END:U_END], (KV_DIM, 2 * KV_DIM), axis=-1)

        q = _apply_rope(_rmsnorm(_heads(q, N_HEADS), q_norm_w[layer]), cos, sin)
        k = _apply_rope(_rmsnorm(_heads(k, N_KV_HEADS), k_norm_w[layer]), cos, sin)
        v = _heads(v, N_KV_HEADS)
        kc = _rmsnorm(_heads(kc, N_KV_HEADS), k_norm_w[layer])
        vc = _heads(vc, N_KV_HEADS)
        attn_tok = _tokens(_gqa_sweep(q, jnp.concatenate([kc, k], axis=2),
                                      jnp.concatenate([vc, v], axis=2)))

        y_ssm, y_ssm_c = _s5_bidirectional(
            u, uc, ssm_lambda_re[layer], ssm_lambda_im[layer], ssm_log_dt[layer],
            ssm_b_re[layer], ssm_b_im[layer], ssm_c_re[layer], ssm_c_im[layer], ssm_d[layer],
            with_ctx_out=update_ctx)

        x_mix = _merge_branches(attn_tok, y_ssm, g, w_attn_br[layer], w_glu[layer], w_out[layer])
        x = x + g1 * x_mix

        h2 = _modulate(_rmsnorm(x, norm2_w[layer]), sh2, sc2)
        x = x + g2 * _conv_ffn(h2, w_up[layer], conv_w[layer], conv_b[layer], w_down[layer])

        if update_ctx:
            qc = _rmsnorm(_heads(hc @ w_in_l[:, :Q_END], N_HEADS), q_norm_w[layer])
            gc = hc @ w_in_l[:, U_END:]
            attn_c = _tokens(_gqa_sweep(qc, kc, vc))
            ctx = ctx + cg1 * _merge_branches(attn_c, y_ssm_c, gc, w_attn_br[layer],
                                              w_glu[layer], w_out[layer])
            hc2 = _modulate(_rmsnorm(ctx, norm2_w[layer]), csh2, csc2)
            ctx = ctx + cg2 * _conv_ffn(hc2, w_up[layer], conv_w[layer], conv_b[layer], w_down[layer])

    return _rmsnorm(x, final_norm_w)
```

```cpp
#include <hip/hip_runtime.h>
#include <cstdio>
#include <cstdint>

typedef unsigned short bf16_t;
typedef short bf16x8 __attribute__((ext_vector_type(8)));
typedef short s16x4 __attribute__((ext_vector_type(4)));
typedef float f32x4 __attribute__((ext_vector_type(4)));
typedef float f32x16 __attribute__((ext_vector_type(16)));
typedef unsigned u32x4 __attribute__((ext_vector_type(4)));
typedef unsigned u32x2 __attribute__((ext_vector_type(2)));
typedef float f32x2 __attribute__((ext_vector_type(2)));

constexpr int NB = 16, SEQ = 2048, DM = 1024, LC = 256, LKV = LC + SEQ;
constexpr int ML = NB * SEQ, MC = NB * LC, MT = ML + MC;
constexpr int DIN = 4096, DFF = 2816, NUP = 2 * DFF;
constexpr int NG = 32, NS = 64, PG = 16;
constexpr int TCH = 32, NCH = SEQ / TCH, KCAT = TCH * PG + 256;
constexpr int UROWS = 1280;
constexpr float EPS = 1e-6f;

constexpr size_t MiB = 1u << 20;
constexpr size_t WS_CTL = 0, WS_MOD = 1 * MiB;
constexpr size_t WS_WIN = 16 * MiB, WS_WBR = 24 * MiB, WS_WGLU = 26 * MiB, WS_WOUT = 28 * MiB, WS_WUP = 30 * MiB, WS_WDN = 41 * MiB;
constexpr size_t WS_H = 48 * MiB;
constexpr size_t WS_Q = 120 * MiB;
constexpr size_t WS_K = 184 * MiB;
constexpr size_t WS_V = 202 * MiB;
constexpr size_t WS_UCAT = 220 * MiB;
constexpr size_t WS_SG = 280 * MiB;
constexpr size_t WS_O = 408 * MiB;
constexpr size_t WS_SSM = 472 * MiB;
constexpr size_t WS_A32 = 2 * MiB;
constexpr size_t OUT_W1 = 0, OUT_B3 = 8 * MiB, OUT_L = 32 * MiB;
constexpr size_t WS_YTMP = 48 * MiB;
constexpr size_t WS_GLU = 48 * MiB;
constexpr size_t WS_MG = 184 * MiB;
constexpr size_t WS_H2 = 48 * MiB;
constexpr size_t WS_A = 112 * MiB;
constexpr size_t WS_HALO = 288 * MiB;
constexpr size_t WS_XS = 300 * MiB;
constexpr size_t WS_XS2 = 301 * MiB;
constexpr size_t WS_NEED = 512 * MiB;

__device__ __forceinline__ int opaque_tid(int wave) { int t = wave * 64 + (int)__builtin_amdgcn_mbcnt_hi(~0u, __builtin_amdgcn_mbcnt_lo(~0u, 0u)); asm volatile("" : "+v"(t)); return t; }
__device__ __forceinline__ float bf2f(bf16_t v) { return __uint_as_float(((unsigned)v) << 16); }
__device__ __forceinline__ bf16_t f2bf(float f) { unsigned u = __float_as_uint(f); u += 0x7fffu + ((u >> 16) & 1u); return (bf16_t)(u >> 16); }
__device__ __forceinline__ float sigmoidf_(float x) { return 1.f / (1.f + __expf(-x)); }
__device__ __forceinline__ float siluf_(float x) { return x / (1.f + __expf(-x)); }
__device__ __forceinline__ float gelu_tanh(float x) { const float u = 0.7978845608028654f * (x + 0.044715f * x * x * x); return x / (1.f + __expf(-2.f * u)); }
__device__ __forceinline__ float wave_sum(float v) {
#pragma unroll
    for (int o = 1; o < 64; o <<= 1) v += __shfl_xor(v, o);
    return v;
}
__device__ __forceinline__ size_t ucat_idx(int b, int t, int ch) { const int g = ch >> 4, q = ch & 15, c = t >> 5, j = t & 31; return ((size_t)(g * UROWS + b * NCH + c)) * KCAT + j * PG + q; }
__device__ __forceinline__ size_t ucat_ctx_idx(int b, int tc, int ch) { const int g = ch >> 4, q = ch & 15, c = tc >> 5, j = tc & 31; return ((size_t)(g * UROWS + 1024 + b * 8 + c)) * KCAT + j * PG + q; }

__device__ __forceinline__ void qk_norm_rope_row(bf16_t* p, const float* __restrict__ w, int pos, int lane) {
    const unsigned raw = *(const unsigned*)(p + 2 * lane);
    const float v0 = bf2f((bf16_t)(raw & 0xffff)), v1 = bf2f((bf16_t)(raw >> 16));
    const float rs = rsqrtf(wave_sum(v0 * v0 + v1 * v1) * (1.f / 128.f) + EPS);
    float y0 = v0 * rs * w[2 * lane], y1 = v1 * rs * w[2 * lane + 1];
    if (pos >= 0) {
        const float coord = (lane < 32) ? (float)(pos >> 6) : (float)(pos & 63);
        const float invf = exp2f(-(float)(2 * (lane & 31)) * (13.287712379549449f / 64.f));
        const float ang = coord * invf; const float cs = cosf(ang), sn = sinf(ang);
        const float o0 = y0 * cs - y1 * sn, o1 = y0 * sn + y1 * cs; y0 = o0; y1 = o1;
    }
    *(unsigned*)(p + 2 * lane) = (unsigned)f2bf(y0) | ((unsigned)f2bf(y1) << 16);
}
namespace att {
constexpr int D = 128, NW = 8, QBLK = 32, KVBLK = 64;
constexpr float SCALE = 0.088388347648318440f;
constexpr float THR = 8.f;
constexpr int LDQ = 1024, LDK = 256, LDO = 1024;
constexpr size_t SHM_V = KVBLK * D * 2, SHM_K = KVBLK * D * 2, SHM_ATTN = 2 * SHM_V + 2 * SHM_K + NW * 64 * 4;
#define KSWZ(row, colB) ((row) * 256 + ((colB) ^ (((row) & 7) << 4)))
#define SBAR() __builtin_amdgcn_sched_barrier(0)
__device__ __forceinline__ int crow(int r, int hi) { return (r & 3) + 8 * (r >> 2) + 4 * hi; }
__device__ __forceinline__ unsigned cvtpk(float lo, float hi) { unsigned r; asm volatile("v_cvt_pk_bf16_f32 %0, %1, %2" : "=v"(r) : "v"(lo), "v"(hi)); return r; }
__device__ __forceinline__ void partialSM(f32x16& p0, f32x16& p1, float& m_reg, float& mn, float& alpha) {
    constexpr float C = SCALE * 1.4426950408889634f;
    float pmax = p0[0]; for (int r = 1; r < 16; ++r) pmax = fmaxf(pmax, p0[r]); for (int r = 0; r < 16; ++r) pmax = fmaxf(pmax, p1[r]);
    { auto rr = __builtin_amdgcn_permlane32_swap(__float_as_uint(pmax), __float_as_uint(pmax), false, false);
      pmax = fmaxf(__uint_as_float(rr[0]), __uint_as_float(rr[1])); }
    if (__builtin_expect(__all(pmax - m_reg <= THR / SCALE), 1)) { mn = m_reg; alpha = 1.f; }
    else { mn = fmaxf(m_reg, pmax); alpha = __builtin_amdgcn_exp2f((m_reg - mn) * C); m_reg = mn; }
    float mnC = -mn * C;
    for (int r = 0; r < 16; ++r) p0[r] = fmaf(p0[r], C, mnC); for (int r = 0; r < 16; ++r) p1[r] = fmaf(p1[r], C, mnC);
    for (int r = 0; r < 16; ++r) p0[r] = __builtin_amdgcn_exp2f(p0[r]);
}
__device__ __forceinline__ void finishSM(f32x16& p0, f32x16& p1, float alpha, float& l_reg, bf16x8& pa0, bf16x8& pa1, bf16x8& pa2, bf16x8& pa3) {
    for (int r = 0; r < 16; ++r) p1[r] = __builtin_amdgcn_exp2f(p1[r]);
    float ps = 0; for (int r = 0; r < 16; ++r) ps += p0[r]; for (int r = 0; r < 16; ++r) ps += p1[r];
    { auto rr = __builtin_amdgcn_permlane32_swap(__float_as_uint(ps), __float_as_uint(ps), false, false);
      ps = __uint_as_float(rr[0]) + __uint_as_float(rr[1]); }
    l_reg = l_reg * alpha + ps;
#define PK4(P, BASE, OUT) do { unsigned a0 = cvtpk(P[BASE + 0], P[BASE + 1]), a1 = cvtpk(P[BASE + 2], P[BASE + 3]);   \
    unsigned b0 = cvtpk(P[BASE + 4], P[BASE + 5]), b1 = cvtpk(P[BASE + 6], P[BASE + 7]);                              \
    auto r0 = __builtin_amdgcn_permlane32_swap(a0, b0, false, false); auto r1 = __builtin_amdgcn_permlane32_swap(a1, b1, false, false); \
    u32x4 w = {r0[0], r1[0], r0[1], r1[1]}; OUT = *reinterpret_cast<bf16x8*>(&w); } while (0)
    PK4(p0, 0, pa0); PK4(p0, 8, pa1); PK4(p1, 0, pa2); PK4(p1, 8, pa3);
#undef PK4
}
__device__ __forceinline__ void qkt(f32x16& p0, f32x16& p1, const bf16_t* Ks, const bf16x8* qr, int r32, int hi) {
    p0 = f32x16{}; p1 = f32x16{};
    for (int d0 = 0; d0 < 8; ++d0) { int cb = (d0 * 16 + hi * 8) * 2;
        bf16x8 b0 = *reinterpret_cast<const bf16x8*>((const char*)Ks + KSWZ(r32, cb));
        bf16x8 b1 = *reinterpret_cast<const bf16x8*>((const char*)Ks + KSWZ(32 + r32, cb));
        p0 = __builtin_amdgcn_mfma_f32_32x32x16_bf16(b0, qr[d0], p0, 0, 0, 0);
        p1 = __builtin_amdgcn_mfma_f32_32x32x16_bf16(b1, qr[d0], p1, 0, 0, 0); }
}
__device__ __forceinline__ int v_st(int k, int c) { const int kk = (k & ~0xC) | ((k & 4) << 1) | ((k & 8) >> 1); return ((kk >> 3) * 4 + (c >> 5)) * 512 + ((kk & 7) * 32 + (c & 31)) * 2; }
__device__ __forceinline__ int v_rd_base(int lane) { return ((lane & 3) << 3) | (((lane >> 2) & 3) << 6) | (((lane >> 4) & 1) << 5) | (((lane >> 5) & 1) << 8); }
constexpr int v_rd_off(int d0, int ks, int half) { return d0 * 512 + ks * 4096 + half * 2048; }
template <int OFF> __device__ __forceinline__ s16x4 tr_read(int vb) {
    s16x4 r; asm volatile("ds_read_b64_tr_b16 %0, %1 offset:%2" : "=&v"(r) : "v"(vb), "i"(OFF) : "memory"); return r;
}
template <int D0> __device__ __forceinline__ void pv_one(f32x16& od, int vb, bf16x8 pa0, bf16x8 pa1, bf16x8 pa2, bf16x8 pa3) {
    const s16x4 l0 = tr_read<v_rd_off(D0, 0, 0)>(vb), h0 = tr_read<v_rd_off(D0, 0, 1)>(vb), l1 = tr_read<v_rd_off(D0, 1, 0)>(vb), h1 = tr_read<v_rd_off(D0, 1, 1)>(vb);
    const s16x4 l2 = tr_read<v_rd_off(D0, 2, 0)>(vb), h2 = tr_read<v_rd_off(D0, 2, 1)>(vb), l3 = tr_read<v_rd_off(D0, 3, 0)>(vb), h3 = tr_read<v_rd_off(D0, 3, 1)>(vb);
    asm volatile("s_waitcnt lgkmcnt(0)" ::: "memory"); SBAR();
#define PK(L, H) (bf16x8){L[0], L[1], L[2], L[3], H[0], H[1], H[2], H[3]}
    od = __builtin_amdgcn_mfma_f32_32x32x16_bf16(pa0, PK(l0, h0), od, 0, 0, 0);
    od = __builtin_amdgcn_mfma_f32_32x32x16_bf16(pa1, PK(l1, h1), od, 0, 0, 0);
    od = __builtin_amdgcn_mfma_f32_32x32x16_bf16(pa2, PK(l2, h2), od, 0, 0, 0);
    od = __builtin_amdgcn_mfma_f32_32x32x16_bf16(pa3, PK(l3, h3), od, 0, 0, 0);
#undef PK
}
__device__ __forceinline__ void pv_d0(f32x16* o, int vb, bf16x8 pa0, bf16x8 pa1, bf16x8 pa2, bf16x8 pa3) {
    pv_one<0>(o[0], vb, pa0, pa1, pa2, pa3); pv_one<1>(o[1], vb, pa0, pa1, pa2, pa3); pv_one<2>(o[2], vb, pa0, pa1, pa2, pa3); pv_one<3>(o[3], vb, pa0, pa1, pa2, pa3);
}
__device__ __forceinline__ void attn_dense_body(const bf16_t* __restrict__ Qb, const bf16_t* __restrict__ Kh, const bf16_t* __restrict__ Vh, bf16_t* __restrict__ Ob, int seq, char* lds, int wave_id) {
    const int tid = opaque_tid(wave_id), wid = tid >> 6, lane = tid & 63, r32 = lane & 31, hi = lane >> 5;
    bf16_t* V_lds = (bf16_t*)lds; bf16_t* K_lds = (bf16_t*)(lds + 2 * SHM_V);
    float* ws = (float*)(lds + 2 * SHM_V + 2 * SHM_K) + wid * 64; float* li_l = ws; float* al_l = ws + 32;
    float m_reg = -1e30f, l_reg = 0; f32x16 o[4] = {}; bf16x8 qr[8];
    const bf16_t* Qw = Qb + (long)(wid * QBLK + r32) * LDQ + hi * 8;
#pragma unroll
    for (int d0 = 0; d0 < 8; ++d0) qr[d0] = *reinterpret_cast<const bf16x8*>(Qw + d0 * 16);
    const int sr = tid >> 4, sc = (tid & 15) * 8, vst0 = v_st(sr, sc), vst1 = v_st(32 + sr, sc);
    const int vb0 = (int)(uintptr_t)V_lds + v_rd_base(lane);
    struct { bf16x8 vs0, vs1, ks0, ks1; } sr_[2];
#define SLOAD(i, k0) do { sr_[i].vs0 = *reinterpret_cast<const bf16x8*>(&Vh[(long)((k0) + sr) * LDK + sc]); sr_[i].vs1 = *reinterpret_cast<const bf16x8*>(&Vh[(long)((k0) + 32 + sr) * LDK + sc]); \
    sr_[i].ks0 = *reinterpret_cast<const bf16x8*>(&Kh[(long)((k0) + sr) * LDK + sc]); sr_[i].ks1 = *reinterpret_cast<const bf16x8*>(&Kh[(long)((k0) + 32 + sr) * LDK + sc]); } while (0)
#define SWRITE(b, i) do { *(bf16x8*)((char*)V_lds + (b) * SHM_V + vst0) = sr_[i].vs0;          \
    *(bf16x8*)((char*)V_lds + (b) * SHM_V + vst1) = sr_[i].vs1; int kc = sc * 2;               \
    *(bf16x8*)((char*)K_lds + (b) * SHM_K + KSWZ(sr, kc)) = sr_[i].ks0;                       \
    *(bf16x8*)((char*)K_lds + (b) * SHM_K + KSWZ(32 + sr, kc)) = sr_[i].ks1; } while (0)
#define SWAIT() asm volatile("s_waitcnt vmcnt(4)" ::: "memory")
#define RESC(a) do { if (__any((a) < 1.f)) { if (hi == 0) al_l[r32] = (a); asm volatile("s_waitcnt lgkmcnt(0)" ::: "memory"); \
    for (int d = 0; d < 4; ++d) for (int r = 0; r < 16; ++r) o[d][r] *= al_l[crow(r, hi)]; } } while (0)
    f32x16 pA0, pA1, pB0, pB1; float mnA, mnB, alA, alB; bf16x8 pa0, pa1, pa2, pa3; const int NT = seq / KVBLK;
    constexpr int SE = 0, SO = 1;
    SLOAD(SE, 0); asm volatile("s_waitcnt vmcnt(0)" ::: "memory"); SWRITE(0, SE); __syncthreads();
    qkt(pA0, pA1, K_lds, qr, r32, hi); partialSM(pA0, pA1, m_reg, mnA, alA);
    SLOAD(SO, KVBLK); if (2 < NT) SLOAD(SE, 2 * KVBLK);
    SWAIT(); SWRITE(1, SO); __syncthreads();
    for (int j = 1; j + 1 < NT; j += 2) {
        SBAR(); qkt(pB0, pB1, (bf16_t*)((char*)K_lds + SHM_K), qr, r32, hi);
        finishSM(pA0, pA1, alA, l_reg, pa0, pa1, pa2, pa3); SBAR();
        SLOAD(SO, (j + 2) * KVBLK); SBAR();
        pv_d0(o, vb0, pa0, pa1, pa2, pa3); partialSM(pB0, pB1, m_reg, mnB, alB);
        __syncthreads(); SWAIT(); SWRITE(0, SE);
        RESC(alB); __syncthreads();
        SBAR(); qkt(pA0, pA1, K_lds, qr, r32, hi);
        finishSM(pB0, pB1, alB, l_reg, pa0, pa1, pa2, pa3); SBAR();
        if (j + 3 < NT) SLOAD(SE, (j + 3) * KVBLK); SBAR();
        pv_d0(o, vb0 + (int)SHM_V, pa0, pa1, pa2, pa3); partialSM(pA0, pA1, m_reg, mnA, alA);
        __syncthreads(); SWAIT(); SWRITE(1, SO);
        RESC(alA); __syncthreads();
    }
    SBAR(); qkt(pB0, pB1, (bf16_t*)((char*)K_lds + SHM_K), qr, r32, hi);
    finishSM(pA0, pA1, alA, l_reg, pa0, pa1, pa2, pa3); SBAR();
    pv_d0(o, vb0, pa0, pa1, pa2, pa3); partialSM(pB0, pB1, m_reg, mnB, alB);
    __syncthreads(); RESC(alB);
    finishSM(pB0, pB1, alB, l_reg, pa0, pa1, pa2, pa3); SBAR();
    pv_d0(o, vb0 + (int)SHM_V, pa0, pa1, pa2, pa3);
    { const int tid2 = opaque_tid(wave_id), lane2 = tid2 & 63, r32b = lane2 & 31, hib = lane2 >> 5;
      float* li2 = (float*)(lds + 2 * SHM_V + 2 * SHM_K) + wave_id * 64;
      if (hib == 0) li2[r32b] = l_reg; asm volatile("s_waitcnt lgkmcnt(0)" ::: "memory");
      float rli[16];
#pragma unroll
      for (int r = 0; r < 16; ++r) rli[r] = __builtin_amdgcn_rcpf(li2[crow(r, hib)]);
      bf16_t* Ow = Ob + (long)(wave_id * QBLK) * LDO;
#pragma unroll
      for (int r = 0; r < 16; ++r) { int orow = crow(r, hib);
          for (int d0 = 0; d0 < 4; ++d0) Ow[(long)orow * LDO + d0 * 32 + r32b] = f2bf(o[d0][r] * rli[r]); } }
    __syncthreads();
#undef SLOAD
#undef SWRITE
#undef SWAIT
#undef RESC
}
}

struct S5In { const float *lre, *lim, *ldt, *bre, *bim, *cre, *cim, *dsk; };
__device__ __forceinline__ void s5_naive_wave(const S5In& P, const bf16_t* __restrict__ Ucat, const bf16_t* __restrict__ Uctx, float* __restrict__ Ytmp, bf16_t* __restrict__ SSM, int n, int g, int b) {
    const float dskip = P.dsk[g * PG + (n & 15)];
    for (int dir = 0; dir < 2; ++dir) {
        const int dg = dir * NG + g;
        const float dt = expf(P.ldt[dg]), lr = P.lre[dg * NS + n], li = P.lim[dg * NS + n];
        const float mag = expf(lr * dt), ang = li * dt, are = mag * cosf(ang), aim = mag * sinf(ang);
        const float den = lr * lr + li * li, nr = are - 1.f, ni = aim, fre = (nr * lr + ni * li) / den, fim = (ni * lr - nr * li) / den;
        float bbr[PG], bbi[PG], cr[PG], ci[PG];
#pragma unroll
        for (int p = 0; p < PG; ++p) { const float br = P.bre[((size_t)dg * NS + n) * PG + p], bi = P.bim[((size_t)dg * NS + n) * PG + p];
            bbr[p] = fre * br - fim * bi; bbi[p] = fre * bi + fim * br; cr[p] = P.cre[((size_t)dg * PG + p) * NS + n]; ci[p] = P.cim[((size_t)dg * PG + p) * NS + n]; }
        float sre = 0.f, sim = 0.f;
        for (int i = 0; i < LC; ++i) { const int tc = dir == 0 ? i : LC - 1 - i;
            const bf16_t* upc = Ucat + ucat_ctx_idx(b, tc, g * PG); const bf16x8 u0 = *(const bf16x8*)upc, u1 = *(const bf16x8*)(upc + 8);
            float bur = 0.f, bui = 0.f;
#pragma unroll
            for (int p = 0; p < 8; ++p) { const float ua = bf2f((bf16_t)u0[p]), ub = bf2f((bf16_t)u1[p]); bur += bbr[p] * ua + bbr[p + 8] * ub; bui += bbi[p] * ua + bbi[p + 8] * ub; }
            const float nre = are * sre - aim * sim + bur, nim = are * sim + aim * sre + bui; sre = nre; sim = nim; }
        for (int i = 0; i < SEQ; ++i) { const int t = dir == 0 ? i : SEQ - 1 - i;
            const bf16_t* up = Ucat + ucat_idx(b, t, g * PG);
            const bf16x8 u0 = *(const bf16x8*)up, u1 = *(const bf16x8*)(up + 8);
            float uu[PG]; float bur = 0.f, bui = 0.f;
#pragma unroll
            for (int p = 0; p < 8; ++p) { uu[p] = bf2f((bf16_t)u0[p]); uu[p + 8] = bf2f((bf16_t)u1[p]); }
#pragma unroll
            for (int p = 0; p < PG; ++p) { bur += bbr[p] * uu[p]; bui += bbi[p] * uu[p]; }
            const float nre = are * sre - aim * sim + bur, nim = are * sim + aim * sre + bui; sre = nre; sim = nim;
            float mine = 0.f, myu = 0.f;
#pragma unroll
            for (int p = 0; p < PG; ++p) { const float y = wave_sum(cr[p] * sre - ci[p] * sim); if (n == p) { mine = y; myu = uu[p]; } }
            if (n < PG) { const size_t oi = ((size_t)(b * SEQ + t)) * 512 + g * PG + n;
                if (dir == 0) Ytmp[oi] = myu * dskip + mine;
                else SSM[oi] = f2bf(gelu_tanh(Ytmp[oi] + mine)); }
        }
    }
}

#include <hip/hip_cooperative_groups.h>
namespace cg = cooperative_groups;
#define LAS __attribute__((address_space(3)))
#define GAS __attribute__((address_space(1)))

namespace pg8 {
constexpr int BM = 256, BK = 64, HALF = 128, HTB = HALF * BK * 2, STAGE_BYTES = 8 * HTB, NXCD = 8, WGM = 8;
__host__ __device__ __forceinline__ int lds_byte(int r, int c) { const int st = (r >> 4) * 2 + (c >> 5), rr = r & 15, cc = c & 31, ob = rr * 64 + cc * 2; return st * 1024 + (ob ^ (((ob >> 9) & 1) << 5)); }
__host__ __device__ __forceinline__ void stage_rc(int b, int& R, int& C) { const int st = b / 1024, sb = b % 1024, swz = sb ^ (((sb >> 9) & 1) << 5); R = (st >> 1) * 16 + swz / 64; C = (st & 1) * 32 + (swz % 64) / 2; }
__host__ __device__ __forceinline__ int perm32(int rho) { const int n = rho >> 4, i = rho & 15; return 8 * (i >> 2) + 4 * n + (i & 3); }
struct Unit { int pm, pn, grp; };
struct Gemm { const bf16_t* A; const bf16_t* Bt; int lda, ldb, K; size_t a_grp, b_grp; int amode; };
struct StaticOrder {
    int nM, nN, nwg, G, c;
    __device__ __forceinline__ void init(int nM_, int nN_, int G_, int c_) { nM = nM_; nN = nN_; nwg = nM * nN; G = G_; c = c_; }
    __device__ __forceinline__ bool next(int i, Unit& u) const {
        const long L = (long)i * G + c; if (L >= nwg) return false;
        int wgid = (int)L; { const int q = nwg / NXCD, r = nwg % NXCD, xcd = wgid % NXCD, off = wgid / NXCD; wgid = (xcd < r ? xcd * (q + 1) : r * (q + 1) + (xcd - r) * q) + off; }
        const int nig = WGM * nN, gid = wgid / nig, fm = gid * WGM, gsz = (nM - fm) < WGM ? (nM - fm) : WGM;
        u.pm = fm + ((wgid % nig) % gsz); u.pn = (wgid % nig) / gsz; u.grp = 0; return true;
    }
};
__device__ __forceinline__ unsigned cvt_pk_bf16(float lo, float hi) { unsigned r; asm volatile("v_cvt_pk_bf16_f32 %0, %1, %2" : "=v"(r) : "v"(lo), "v"(hi)); return r; }
#define EPI_ROWS_BF16(ROWPTR, BJSTRIDE, XF) do { \
    _Pragma("unroll") for (int ai = 0; ai < 2; ++ai) _Pragma("unroll") for (int m = 0; m < 4; ++m) { const int row = row0 + ai * HALF + m * 16; bf16_t* rp = (ROWPTR); \
        _Pragma("unroll") for (int bj = 0; bj < 2; ++bj) { f32x4 v0 = acc[ai][bj][m][0], v1 = acc[ai][bj][m][1]; \
            _Pragma("unroll") for (int j = 0; j < 4; ++j) { v0[j] = XF(v0[j]); v1[j] = XF(v1[j]); } \
            u32x4 w; w.x = cvt_pk_bf16(v0[0], v0[1]); w.y = cvt_pk_bf16(v0[2], v0[3]); w.z = cvt_pk_bf16(v1[0], v1[1]); w.w = cvt_pk_bf16(v1[2], v1[3]); \
            *(u32x4*)(rp + (size_t)bj * (BJSTRIDE)) = w; } } } while (0)
template <class Epi, class Sched, bool ALIGN_EPI = true, bool SP2 = true>
__device__ __forceinline__ void gemm_phase(LAS unsigned char* lds, const Gemm g, const Sched& S, const Epi& E, int wave_id) {
    const int tid = opaque_tid(wave_id), wid = __builtin_amdgcn_readfirstlane(tid >> 6), lane = tid & 63, wr = wid >> 2, wc = wid & 3, fr = lane & 15, fq = lane >> 4;
    const int K = g.K, nt = K / BK;
    unsigned voffA[2], voffB[2];
#pragma unroll
    for (int i = 0; i < 2; ++i) { int R, C; stage_rc(tid * 16 + i * 8192, R, C); const int Rb = Epi::PERM ? ((R & ~31) + perm32(R & 31)) : R;
        voffA[i] = g.amode == 1 ? (unsigned)((((C >> 4) * 1024 + (R >> 5)) * 512 + (R & 31) * 16 + (C & 15)) * 2) : (unsigned)(R * g.lda + C) * 2u; voffB[i] = (unsigned)(Rb * g.ldb + C) * 2u; }
    const size_t kstep = (size_t)(BK * 2), kstepA = g.amode == 1 ? (size_t)4 * 1024 * 512 * 2 : kstep;
    const size_t hstepA = g.amode == 1 ? (size_t)4 * 512 * 2 : (size_t)HALF * g.lda * 2, hstepB = (size_t)HALF * g.ldb * 2;
    const size_t tstepA = 2 * hstepA, tstepB = 2 * hstepB;
    const unsigned ldsw = (unsigned)wid * 1024u;
    const int aoff = lds_byte(wr * 64 + fr, fq * 8), boff = lds_byte(wc * 32 + fr, fq * 8);
#define PG8_SA(b, h) (((b) * 2 + (h)) * HTB)
#define PG8_SB(b, h) ((4 + (b) * 2 + (h)) * HTB)
#define PG8_STAGE(bufoff, gbase, voff) do { _Pragma("unroll") for (int _i = 0; _i < 2; ++_i) \
        __builtin_amdgcn_global_load_lds((const unsigned*)((const char*)(gbase) + (voff)[_i]), (LAS unsigned*)(lds + (bufoff) + ldsw + _i * 8192), 16, 0, 0); } while (0)
#define PG8_LDA(dst, b, h) do { _Pragma("unroll") for (int m = 0; m < 4; ++m) _Pragma("unroll") for (int k = 0; k < 2; ++k) dst[m][k] = *(const LAS bf16x8*)(lds + PG8_SA(b, h) + aoff + m * 2048 + k * 1024); } while (0)
#define PG8_LDB(dst, b, h) do { _Pragma("unroll") for (int n = 0; n < 2; ++n) _Pragma("unroll") for (int k = 0; k < 2; ++k) dst[n][k] = *(const LAS bf16x8*)(lds + PG8_SB(b, h) + boff + n * 2048 + k * 1024); } while (0)
#define PG8_MMA(ai, bj, At, Bt) do { __builtin_amdgcn_s_setprio(1); _Pragma("unroll") for (int m = 0; m < 4; ++m) _Pragma("unroll") for (int n = 0; n < 2; ++n) _Pragma("unroll") for (int k = 0; k < 2; ++k) \
        acc[ai][bj][m][n] = __builtin_amdgcn_mfma_f32_16x16x32_bf16(Bt[n][k], At[m][k], acc[ai][bj][m][n], 0, 0, 0); __builtin_amdgcn_s_setprio(0); } while (0)
#define PG8_WAIT_V(n) asm volatile("s_waitcnt vmcnt(" #n ")" ::: "memory")
#define PG8_WAIT_L(n) asm volatile("s_waitcnt lgkmcnt(" #n ")" ::: "memory")
#define PG8_BAR __builtin_amdgcn_s_barrier()
#define PG8_SCHED __builtin_amdgcn_sched_barrier(0)
    Unit cur, nxt; int ui = 0;
    if (!S.next(0, cur)) return;
    f32x4 acc[2][2][4][2];
#pragma unroll
    for (int a = 0; a < 2; ++a)
#pragma unroll
        for (int b = 0; b < 2; ++b)
#pragma unroll
            for (int m = 0; m < 4; ++m)
#pragma unroll
                for (int n = 0; n < 2; ++n) acc[a][b][m][n] = (f32x4){0.f, 0.f, 0.f, 0.f};
    bf16x8 At[4][2], B0[2][2], B1[2][2];
    const char* cA = (const char*)g.A + (size_t)cur.grp * g.a_grp + (size_t)cur.pm * tstepA; const char* cB = (const char*)g.Bt + (size_t)cur.grp * g.b_grp + (size_t)cur.pn * tstepB;
    if constexpr (SP2) {
        PG8_STAGE(PG8_SB(0, 0), cB, voffB); PG8_STAGE(PG8_SB(0, 1), cB + hstepB, voffB); PG8_STAGE(PG8_SA(0, 0), cA, voffA); PG8_STAGE(PG8_SA(0, 1), cA + hstepA, voffA);
        if (wr == 1) PG8_BAR;
        PG8_WAIT_V(2); PG8_BAR;
        PG8_STAGE(PG8_SB(1, 0), cB + kstep, voffB); PG8_STAGE(PG8_SA(1, 0), cA + kstepA, voffA); PG8_STAGE(PG8_SB(1, 1), cB + hstepB + kstep, voffB);
        PG8_WAIT_V(6); PG8_BAR;
    } else {
        PG8_STAGE(PG8_SB(0, 0), cB, voffB); PG8_STAGE(PG8_SA(0, 0), cA, voffA); PG8_STAGE(PG8_SB(0, 1), cB + hstepB, voffB); PG8_STAGE(PG8_SA(0, 1), cA + hstepA, voffA);
        if (wr == 1) PG8_BAR;
        PG8_WAIT_V(4); PG8_BAR;
        PG8_STAGE(PG8_SB(1, 0), cB + kstep, voffB); PG8_STAGE(PG8_SA(1, 0), cA + kstepA, voffA); PG8_STAGE(PG8_SB(1, 1), cB + hstepB + kstep, voffB);
        PG8_WAIT_V(6); PG8_BAR;
    }
    for (;;) {
        const bool has_next = S.next(ui + 1, nxt);
        const char* nA = has_next ? (const char*)g.A + (size_t)nxt.grp * g.a_grp + (size_t)nxt.pm * tstepA : cA; const char* nB = has_next ? (const char*)g.Bt + (size_t)nxt.grp * g.b_grp + (size_t)nxt.pn * tstepB : cB;
        for (int t = 0; t < nt; t += 2) {
            const bool last = (t == nt - 2);
            const char* a1 = cA + (size_t)(t + 1) * kstepA;
            const char* a2 = last ? nA : cA + (size_t)(t + 2) * kstepA; const char* b2 = last ? nB : cB + (size_t)(t + 2) * kstep;
            const char* a3 = a2 + kstepA; const char* b3 = b2 + kstep;
            if constexpr (SP2) {
            PG8_LDB(B0, 0, 0); PG8_LDB(B1, 0, 1); PG8_SCHED; PG8_LDA(At, 0, 0); PG8_STAGE(PG8_SA(1, 1), a1 + hstepA, voffA);
            PG8_WAIT_V(8); PG8_WAIT_L(0); PG8_BAR; PG8_MMA(0, 0, At, B0); PG8_MMA(0, 1, At, B1); PG8_BAR; PG8_SCHED;
            PG8_LDA(At, 0, 1); PG8_STAGE(PG8_SB(0, 0), b2, voffB); PG8_STAGE(PG8_SB(0, 1), b2 + hstepB, voffB); PG8_STAGE(PG8_SA(0, 0), a2, voffA);
            PG8_WAIT_V(8); PG8_WAIT_L(0); PG8_BAR; PG8_MMA(1, 0, At, B0); PG8_MMA(1, 1, At, B1); PG8_BAR; PG8_SCHED;
            PG8_LDB(B0, 1, 0); PG8_LDB(B1, 1, 1); PG8_SCHED; PG8_LDA(At, 1, 0); PG8_STAGE(PG8_SA(0, 1), a2 + hstepA, voffA);
            PG8_WAIT_V(8); PG8_WAIT_L(0); PG8_BAR; PG8_MMA(0, 0, At, B0); PG8_MMA(0, 1, At, B1); PG8_BAR; PG8_SCHED;
            PG8_LDA(At, 1, 1); PG8_STAGE(PG8_SB(1, 0), b3, voffB); PG8_STAGE(PG8_SB(1, 1), b3 + hstepB, voffB); PG8_STAGE(PG8_SA(1, 0), a3, voffA);
            PG8_WAIT_V(8); PG8_WAIT_L(0); PG8_BAR; PG8_MMA(1, 0, At, B0); PG8_MMA(1, 1, At, B1); PG8_BAR; PG8_SCHED;
            } else {
            PG8_LDB(B0, 0, 0); PG8_SCHED; PG8_LDA(At, 0, 0); PG8_STAGE(PG8_SA(1, 1), a1 + hstepA, voffA);
            PG8_WAIT_L(8); PG8_BAR; PG8_WAIT_L(0); PG8_MMA(0, 0, At, B0); PG8_BAR; PG8_SCHED;
            PG8_LDB(B1, 0, 1); PG8_STAGE(PG8_SB(0, 0), b2, voffB);
            PG8_BAR; PG8_WAIT_L(0); PG8_MMA(0, 1, At, B1); PG8_BAR;
            PG8_LDA(At, 0, 1); PG8_STAGE(PG8_SA(0, 0), a2, voffA);
            PG8_BAR; PG8_WAIT_L(0); PG8_MMA(1, 0, At, B0); PG8_BAR; PG8_SCHED;
            PG8_STAGE(PG8_SB(0, 1), b2 + hstepB, voffB);
            PG8_WAIT_V(6); PG8_BAR; PG8_MMA(1, 1, At, B1); PG8_BAR;
            PG8_LDB(B0, 1, 0); PG8_SCHED; PG8_LDA(At, 1, 0); PG8_STAGE(PG8_SA(0, 1), a2 + hstepA, voffA);
            PG8_WAIT_L(8); PG8_BAR; PG8_WAIT_L(0); PG8_MMA(0, 0, At, B0); PG8_BAR; PG8_SCHED;
            PG8_LDB(B1, 1, 1); PG8_STAGE(PG8_SB(1, 0), b3, voffB);
            PG8_BAR; PG8_WAIT_L(0); PG8_MMA(0, 1, At, B1); PG8_BAR;
            PG8_LDA(At, 1, 1); PG8_STAGE(PG8_SA(1, 0), a3, voffA);
            PG8_BAR; PG8_WAIT_L(0); PG8_MMA(1, 0, At, B0); PG8_BAR; PG8_SCHED;
            PG8_STAGE(PG8_SB(1, 1), b3 + hstepB, voffB);
            PG8_WAIT_V(6); PG8_BAR; PG8_MMA(1, 1, At, B1); PG8_BAR;
            }
        }
        if constexpr (ALIGN_EPI) { if (wr == 0) PG8_BAR; }
        E(acc, cur, wr, wc, fr, fq);
        if (!has_next) break;
#pragma unroll
        for (int a = 0; a < 2; ++a)
#pragma unroll
            for (int b = 0; b < 2; ++b)
#pragma unroll
                for (int m = 0; m < 4; ++m)
#pragma unroll
                    for (int n = 0; n < 2; ++n) acc[a][b][m][n] = (f32x4){0.f, 0.f, 0.f, 0.f};
        cur = nxt; cA = nA; cB = nB; ++ui;
        if constexpr (ALIGN_EPI) { if (wr == 1) PG8_BAR; }
    }
    PG8_WAIT_V(0);
    if constexpr (!ALIGN_EPI) { if (wr == 0) PG8_BAR; }
    PG8_BAR;
#undef PG8_SA
#undef PG8_SB
#undef PG8_STAGE
#undef PG8_LDA
#undef PG8_LDB
#undef PG8_MMA
#undef PG8_WAIT_V
#undef PG8_WAIT_L
#undef PG8_BAR
#undef PG8_SCHED
}
}

#define XB_TMO      128
#define XB_XCNT(j)  (256  + 64 * (j))
#define XB_XSUB(j)  (1280 + 64 * (j))
#define XB_XGEN(j)  (2304 + 64 * (j))
#define XB_TOP      3328
#define XB_TOPGEN   3392
#define XCD_BAR_WORDS 3456
#define XB_SPIN_CAP (1u << 18)
__device__ __forceinline__ unsigned xb_ld(unsigned* p)              { return __hip_atomic_load(p, __ATOMIC_RELAXED, __HIP_MEMORY_SCOPE_AGENT); }
__device__ __forceinline__ unsigned xb_add(unsigned* p, unsigned v) { return __hip_atomic_fetch_add(p, v, __ATOMIC_RELAXED, __HIP_MEMORY_SCOPE_AGENT); }
__device__ __forceinline__ unsigned xb_xcc_id() { return (unsigned)__builtin_amdgcn_s_getreg((3 << 11) | 20) & 0xFu; }
#define XB_SPIN(cond, bar) do { unsigned _sp = 0; while (cond) { __builtin_amdgcn_s_sleep(1); \
    if ((++_sp & 255u) == 0u) { if (xb_ld(&(bar)[XB_TMO])) break; if (_sp > XB_SPIN_CAP) { atomicAdd(&(bar)[XB_TMO], 1u); break; } } } } while (0)
struct XcdBarrier { unsigned* bar; unsigned x; volatile LAS unsigned* st; };
__device__ __forceinline__ XcdBarrier xcd_barrier_post(unsigned* bar, volatile LAS unsigned* st) {
    XcdBarrier b; b.bar = bar; b.x = xb_xcc_id(); b.st = st;
    if (threadIdx.x == 0) (void)xb_add(&bar[XB_XCNT(b.x)], 1u);
    return b;
}
__device__ __forceinline__ void xcd_barrier_complete(unsigned* bar, unsigned x, unsigned& nloc, unsigned& nx) {
    const unsigned G = gridDim.x * gridDim.y * gridDim.z;
    unsigned sum, cnt, mine, sp = 0u;
    for (;;) {
        sum = 0u; cnt = 0u; mine = 0u;
#pragma unroll
        for (unsigned j = 0; j < 16; ++j) { const unsigned c = xb_ld(&bar[XB_XCNT(j)]); sum += c; cnt += (c > 0u) ? 1u : 0u; mine = (j == x) ? c : mine; }
        if (sum == G) break;
        __builtin_amdgcn_s_sleep(1);
        if ((++sp & 255u) == 0u) { if (xb_ld(&bar[XB_TMO])) break; if (sp > XB_SPIN_CAP) { atomicAdd(&bar[XB_TMO], 1u); break; } }
    }
    nloc = mine > 0u ? mine : 1u; nx = cnt > 0u ? cnt : 1u;
}
__device__ __forceinline__ void xcd_barrier(const XcdBarrier& b) {
    asm volatile("s_waitcnt vmcnt(0)" ::: "memory");
    __syncthreads();
    if (threadIdx.x == 0) {
        unsigned* bar = b.bar;
        __builtin_amdgcn_s_waitcnt(0);
        unsigned nloc = b.st[0], nx = b.st[1];
        if (nloc == 0u) { xcd_barrier_complete(bar, b.x, nloc, nx); b.st[0] = nloc; b.st[1] = nx; }
        const unsigned old = xb_add(&bar[XB_XSUB(b.x)], 1u);
        const unsigned gen = old / nloc;
        if (old + 1u == (gen + 1u) * nloc) {
            __builtin_amdgcn_fence(__ATOMIC_RELEASE, "agent");
            asm volatile("s_waitcnt vmcnt(0)" ::: "memory");
            const unsigned og = xb_add(&bar[XB_TOP], 1u);
            const unsigned tg = og / nx;
            if (og + 1u == (tg + 1u) * nx) xb_add(&bar[XB_TOPGEN], 1u);
            else XB_SPIN(xb_ld(&bar[XB_TOPGEN]) == tg, bar);
            __builtin_amdgcn_fence(__ATOMIC_ACQUIRE, "agent");
            xb_add(&bar[XB_XGEN(b.x)], 1u);
            asm volatile("s_waitcnt vmcnt(0)" ::: "memory");
        } else {
            XB_SPIN(xb_ld(&bar[XB_XGEN(b.x)]) == gen, bar);
            __builtin_amdgcn_fence(__ATOMIC_ACQUIRE, "agent");
            asm volatile("s_waitcnt vmcnt(0)" ::: "memory");
        }
    }
    __syncthreads();
}

constexpr int MK_LDS = 147456;
constexpr int NWV = 8;
#ifndef MK_HI
#define MK_HI 16
#endif
#ifndef S5_NAIVE
#define S5_NAIVE 0
#endif
#ifndef USE_XBAR
#define USE_XBAR 1
#endif
#ifndef REPMASK
#define REPMASK 0x0
#endif
#define REPS(k) for (int rep_ = 0; rep_ <= ((REPMASK >> (k)) & 1); ++rep_)
struct MkArgs { const float* in[27]; float* out; unsigned char* ws; int ph_lo, ph_hi; };

__device__ __forceinline__ unsigned pk2(float lo, float hi) { return (unsigned)f2bf(lo) | ((unsigned)f2bf(hi) << 16); }
template <int MAP> __device__ __forceinline__ void transpose_item(const float* __restrict__ W, int K, int N, bf16_t* __restrict__ WT, LAS float* scr, int item, int lane) {
    const int nblk = N / 32, kb = item / nblk, nb = item % nblk, k0 = 64 * kb, n0 = 32 * nb;
#pragma unroll 8
    for (int i = 0; i < 32; ++i) { const int kk = 2 * i + (lane >> 5); scr[kk * 33 + (lane & 31)] = W[(size_t)(k0 + kk) * N + n0 + (lane & 31)]; }
    asm volatile("s_waitcnt lgkmcnt(0)" ::: "memory");
    const int c = lane & 7;
#pragma unroll
    for (int j = 0; j < 4; ++j) { const int n = (lane >> 3) + 8 * j; const LAS float* s = scr + (8 * c) * 33 + n;
        u32x4 o; o.x = pk2(s[0 * 33], s[1 * 33]); o.y = pk2(s[2 * 33], s[3 * 33]); o.z = pk2(s[4 * 33], s[5 * 33]); o.w = pk2(s[6 * 33], s[7 * 33]);
        int dr = n0 + n; if (MAP == 1) { const int cc = dr >= DFF ? dr - DFF : dr; dr = (cc >> 7) * 256 + (dr >= DFF ? 128 : 0) + (cc & 127); }
        if (MAP == 2) { const int cc = dr & 1023; dr = (cc >> 7) * 256 + (dr >= 1024 ? 128 : 0) + (cc & 127); }
        *(u32x4*)(WT + (size_t)dr * K + k0 + 8 * c) = o; }
    asm volatile("s_waitcnt lgkmcnt(0)" ::: "memory");
}
__device__ __forceinline__ void norm_mod_rows4(const float* __restrict__ src, const float* __restrict__ w, const float* __restrict__ sh, const float* __restrict__ sc, bf16_t* __restrict__ dst, int lane) {
    f32x4 v[4][4]; float ss[4];
#pragma unroll
    for (int r = 0; r < 4; ++r)
#pragma unroll
        for (int j = 0; j < 4; ++j) v[r][j] = *(const f32x4*)(src + (size_t)r * DM + j * 256 + lane * 4);
#pragma unroll
    for (int r = 0; r < 4; ++r) { float s = 0.f;
#pragma unroll
        for (int j = 0; j < 4; ++j) s += (v[r][j][0] * v[r][j][0] + v[r][j][1] * v[r][j][1]) + (v[r][j][2] * v[r][j][2] + v[r][j][3] * v[r][j][3]);
        ss[r] = s; }
#pragma unroll
    for (int o = 1; o < 64; o <<= 1) {
#pragma unroll
        for (int r = 0; r < 4; ++r) ss[r] += __shfl_xor(ss[r], o); }
#pragma unroll
    for (int r = 0; r < 4; ++r) ss[r] = rsqrtf(ss[r] * (1.f / DM) + EPS);
#pragma unroll
    for (int j = 0; j < 4; ++j) { const int k = j * 256 + lane * 4; const f32x4 ww = *(const f32x4*)(w + k), s1 = *(const f32x4*)(sc + k) + 1.f, s0 = *(const f32x4*)(sh + k);
#pragma unroll
        for (int r = 0; r < 4; ++r) { const f32x4 y = (v[r][j] * ss[r] * ww) * s1 + s0; u32x2 o; o.x = pk2(y[0], y[1]); o.y = pk2(y[2], y[3]); *(u32x2*)(dst + (size_t)r * DM + k) = o; } }
}
__device__ __forceinline__ float xf_id(float v) { return v; }
struct EpiAfast {
    static constexpr bool PERM = true;
    bf16_t *Q, *Kb, *Vb, *Ucat, *SG; const float *qnw, *knw; LAS float* SS;
    __device__ __forceinline__ void operator()(const f32x4 (&acc)[2][2][4][2], const pg8::Unit& u, int wr, int wc, int fr, int fq) const {
        using namespace pg8;
        const int row0 = u.pm * BM + wr * 64 + fr, cl = wc * 32 + 8 * fq;
        const bool lat = u.pm < ML / 256;
        if (u.pn < 5) {
            const bool isq = u.pn < 4; const float* nw = isq ? qnw : knw;
#pragma unroll
            for (int ai = 0; ai < 2; ++ai)
#pragma unroll
                for (int m = 0; m < 4; ++m)
#pragma unroll
                    for (int bj = 0; bj < 2; ++bj) { const f32x4 v0 = acc[ai][bj][m][0], v1 = acc[ai][bj][m][1];
                        float s = (v0[0] * v0[0] + v0[1] * v0[1]) + (v0[2] * v0[2] + v0[3] * v0[3]) + (v1[0] * v1[0] + v1[1] * v1[1]) + (v1[2] * v1[2] + v1[3] * v1[3]);
                        s += __shfl_xor(s, 16); s += __shfl_xor(s, 32);
                        if (fq == 0) SS[((ai * HALF + wr * 64 + m * 16 + fr) * 2 + bj) * 4 + wc] = s; }
            asm volatile("s_waitcnt lgkmcnt(0)" ::: "memory"); __builtin_amdgcn_s_barrier(); asm volatile("" ::: "memory");
            const f32x4 w0 = *(const f32x4*)(nw + cl), w1 = *(const f32x4*)(nw + cl + 4);
            float invf[4];
#pragma unroll
            for (int e = 0; e < 4; ++e) invf[e] = exp2f(-(float)(2 * (((cl >> 1) + e) & 31)) * (13.287712379549449f / 64.f));
#pragma unroll
            for (int ai = 0; ai < 2; ++ai)
#pragma unroll
                for (int m = 0; m < 4; ++m) { const int row = row0 + ai * HALF + m * 16;
                    float cs[4], sn[4];
                    if (lat) { const int t = row % SEQ; const float coord = (wc < 2) ? (float)(t >> 6) : (float)(t & 63);
#pragma unroll
                        for (int e = 0; e < 4; ++e) { const float ang = coord * invf[e]; cs[e] = __cosf(ang); sn[e] = __sinf(ang); } }
                    else {
#pragma unroll
                        for (int e = 0; e < 4; ++e) { cs[e] = 1.f; sn[e] = 0.f; } }
                    bf16_t* rp = isq ? Q + (size_t)row * 1024 + u.pn * 256 + cl
                                     : Kb + ((size_t)(lat ? (row / SEQ) * LKV + LC + (row % SEQ) : ((row - ML) / LC) * LKV + ((row - ML) % LC))) * 256 + cl;
#pragma unroll
                    for (int bj = 0; bj < 2; ++bj) {
                        const f32x4 p = *(const LAS f32x4*)(SS + ((ai * HALF + wr * 64 + m * 16 + fr) * 2 + bj) * 4);
                        const float rs = rsqrtf(((p[0] + p[1]) + (p[2] + p[3])) * (1.f / 128.f) + EPS);
                        const f32x4 y0 = acc[ai][bj][m][0] * rs * w0, y1 = acc[ai][bj][m][1] * rs * w1;
                        u32x4 w; w.x = cvt_pk_bf16(y0[0] * cs[0] - y0[1] * sn[0], y0[0] * sn[0] + y0[1] * cs[0]); w.y = cvt_pk_bf16(y0[2] * cs[1] - y0[3] * sn[1], y0[2] * sn[1] + y0[3] * cs[1]);
                        w.z = cvt_pk_bf16(y1[0] * cs[2] - y1[1] * sn[2], y1[0] * sn[2] + y1[1] * cs[2]); w.w = cvt_pk_bf16(y1[2] * cs[3] - y1[3] * sn[3], y1[2] * sn[3] + y1[3] * cs[3]);
                        *(u32x4*)(rp + bj * 128) = w; } }
        }
        else if (u.pn == 5) {
            EPI_ROWS_BF16(Vb + ((size_t)(lat ? (row / SEQ) * LKV + LC + (row % SEQ) : ((row - ML) / LC) * LKV + ((row - ML) % LC))) * 256 + cl, 128, xf_id); }
        else if (u.pn < 8) { const int ch0 = (u.pn - 6) * 256 + cl;
            if (lat) { EPI_ROWS_BF16(Ucat + ucat_idx(row / SEQ, row % SEQ, ch0), (size_t)8 * UROWS * KCAT, xf_id); }
            else { EPI_ROWS_BF16(Ucat + ucat_ctx_idx((row - ML) / LC, (row - ML) % LC, ch0), (size_t)8 * UROWS * KCAT, xf_id); } }
        else { EPI_ROWS_BF16(SG + (size_t)row * 2048 + (u.pn - 8) * 256 + cl, 128, sigmoidf_); }
    }
};
struct EpiStoreFast {
    static constexpr bool PERM = true; bf16_t* O; int ldo;
    __device__ __forceinline__ void operator()(const f32x4 (&acc)[2][2][4][2], const pg8::Unit& u, int wr, int wc, int fr, int fq) const {
        using namespace pg8; const int row0 = u.pm * BM + wr * 64 + fr, cl = u.pn * BM + wc * 32 + 8 * fq;
        EPI_ROWS_BF16(O + (size_t)row * ldo + cl, 128, xf_id);
    }
};
__device__ __forceinline__ void unpack8(const u32x4 w, float (&f)[8]) {
    f[0] = __uint_as_float(w.x << 16); f[1] = __uint_as_float(w.x & 0xffff0000u); f[2] = __uint_as_float(w.y << 16); f[3] = __uint_as_float(w.y & 0xffff0000u);
    f[4] = __uint_as_float(w.z << 16); f[5] = __uint_as_float(w.z & 0xffff0000u); f[6] = __uint_as_float(w.w << 16); f[7] = __uint_as_float(w.w & 0xffff0000u);
}
struct EpiGluPair {
    static constexpr bool PERM = true; const bf16_t* SG; bf16_t* PS;
    __device__ __forceinline__ void operator()(const f32x4 (&acc)[2][2][4][2], const pg8::Unit& u, int wr, int wc, int fr, int fq) const {
        using namespace pg8; const int row0 = u.pm * BM + wr * 64 + fr, c0 = u.pn * 128 + wc * 32 + 8 * fq;
#pragma unroll
        for (int ai = 0; ai < 2; ++ai)
#pragma unroll
            for (int m = 0; m < 4; ++m) { const int row = row0 + ai * HALF + m * 16; float gs[8], r[8];
                unpack8(*(const u32x4*)(SG + (size_t)row * 2048 + 1024 + c0), gs);
#pragma unroll
                for (int j = 0; j < 8; ++j) { const float av = (j < 4) ? acc[ai][0][m][0][j & 3] : acc[ai][0][m][1][j & 3], bv = (j < 4) ? acc[ai][1][m][0][j & 3] : acc[ai][1][m][1][j & 3]; r[j] = gs[j] * av * sigmoidf_(bv); }
                u32x4 w; w.x = cvt_pk_bf16(r[0], r[1]); w.y = cvt_pk_bf16(r[2], r[3]); w.z = cvt_pk_bf16(r[4], r[5]); w.w = cvt_pk_bf16(r[6], r[7]);
                *(u32x4*)(PS + (size_t)row * 1024 + c0) = w; }
    }
};
struct EpiMergeFast {
    static constexpr bool PERM = true; const bf16_t *SG, *GLU; bf16_t* MG;
    __device__ __forceinline__ void operator()(const f32x4 (&acc)[2][2][4][2], const pg8::Unit& u, int wr, int wc, int fr, int fq) const {
        using namespace pg8; const int row0 = u.pm * BM + wr * 64 + fr, cl = u.pn * BM + wc * 32 + 8 * fq;
#pragma unroll
        for (int ai = 0; ai < 2; ++ai)
#pragma unroll
            for (int m = 0; m < 4; ++m) { const int row = row0 + ai * HALF + m * 16;
#pragma unroll
                for (int bj = 0; bj < 2; ++bj) { const size_t o2 = (size_t)row * 2048 + cl + bj * 128;
                    float ga[8], ps[8], r[8];
                    unpack8(*(const u32x4*)(SG + o2), ga); unpack8(*(const u32x4*)(GLU + (size_t)row * 1024 + cl + bj * 128), ps);
#pragma unroll
                    for (int j = 0; j < 8; ++j) { const float v = (j < 4) ? acc[ai][bj][m][0][j & 3] : acc[ai][bj][m][1][j & 3]; r[j] = ga[j] * v + ps[j]; }
                    u32x4 w; w.x = cvt_pk_bf16(r[0], r[1]); w.y = cvt_pk_bf16(r[2], r[3]); w.z = cvt_pk_bf16(r[4], r[5]); w.w = cvt_pk_bf16(r[6], r[7]);
                    *(u32x4*)(MG + (size_t)row * 1024 + cl + bj * 128) = w; } }
    }
};
struct EpiResidFast {
    static constexpr bool PERM = false; const float* base; float* out; const float* gate;
    __device__ __forceinline__ void operator()(const f32x4 (&acc)[2][2][4][2], const pg8::Unit& u, int wr, int wc, int fr, int fq) const {
        using namespace pg8; const int row0 = u.pm * BM + wr * 64 + fr, col0 = u.pn * BM + wc * 32 + 4 * fq;
        const float* gp = gate + (size_t)((u.pm * BM) / SEQ) * 6144 + col0;
        f32x4 gv[2][2];
#pragma unroll
        for (int bj = 0; bj < 2; ++bj)
#pragma unroll
            for (int n = 0; n < 2; ++n) gv[bj][n] = *(const f32x4*)(gp + bj * HALF + n * 16);
#pragma unroll
        for (int ai = 0; ai < 2; ++ai)
#pragma unroll
            for (int m = 0; m < 4; ++m) { const size_t off = (size_t)(row0 + ai * HALF + m * 16) * 1024 + col0;
#pragma unroll
                for (int bj = 0; bj < 2; ++bj)
#pragma unroll
                    for (int n = 0; n < 2; ++n) { const f32x4 bs = *(const f32x4*)(base + off + bj * HALF + n * 16); *(f32x4*)(out + off + bj * HALF + n * 16) = bs + gv[bj][n] * acc[ai][bj][m][n]; }
                asm volatile("" ::: "memory"); }
    }
};
template <int CTRL> __device__ __forceinline__ float dppf(float x) { return __builtin_bit_cast(float, __builtin_amdgcn_update_dpp(0, __builtin_bit_cast(int, x), CTRL, 0xf, 0xf, false)); }
struct EpiUpConv {
    static constexpr bool PERM = true;
    bf16_t* A; float* HALO; const float* cw; const float* cb; LAS float* Bd; LAS float* Pm;
    __device__ __forceinline__ void operator()(const f32x4 (&acc)[2][2][4][2], const pg8::Unit& u, int wr, int wc, int fr, int fq) const {
        using namespace pg8;
        const int x0 = wc * 32 + 8 * fq;
        if (fr == 0) {
#pragma unroll
            for (int ai = 0; ai < 2; ++ai)
#pragma unroll
                for (int bj = 0; bj < 2; ++bj)
#pragma unroll
                    for (int n = 0; n < 2; ++n) *(LAS f32x4*)(Bd + (ai * 4 + wr * 2) * 256 + bj * 128 + x0 + 4 * n) = acc[ai][bj][0][n]; }
        if (fr == 15) {
#pragma unroll
            for (int ai = 0; ai < 2; ++ai)
#pragma unroll
                for (int bj = 0; bj < 2; ++bj)
#pragma unroll
                    for (int n = 0; n < 2; ++n) *(LAS f32x4*)(Bd + (ai * 4 + wr * 2 + 1) * 256 + bj * 128 + x0 + 4 * n) = acc[ai][bj][3][n]; }
        {
          const int p = wr * 4 + wc, xx = (fq * 16 + fr) * 2, c = u.pn * 128 + xx;
          const float* sp = p < 3 ? cw + p * NUP + c : p == 3 ? cb + c : p < 7 ? cw + (p - 4) * NUP + DFF + c : cb + DFF + c;
          const f32x2 v = *(const f32x2*)sp; Pm[p * 128 + xx] = v.x; Pm[p * 128 + xx + 1] = v.y; }
        asm volatile("s_waitcnt lgkmcnt(0)" ::: "memory"); __builtin_amdgcn_s_barrier(); asm volatile("" ::: "memory");
        const int cbase = u.pn * 128 + x0;
        float* hz = HALO + ((size_t)(u.pm * 22 + u.pn) * 4) * 256;
#pragma unroll
        for (int ai = 0; ai < 2; ++ai) {
            const int blk = 2 * ai + wr;
            const LAS float* pbp = Bd + (((blk - 1) >> 1) * 4 + ((blk - 1) & 1) * 2 + 1) * 256 + x0;
            const LAS float* nbp = Bd + (((blk + 1) >> 1) * 4 + ((blk + 1) & 1) * 2) * 256 + x0;
#pragma unroll
            for (int n = 0; n < 2; ++n) {
                const int c = cbase + 4 * n;
                const LAS float* pp = Pm + x0 + 4 * n;
                float o[4][4];
#pragma unroll
                for (int j = 0; j < 4; ++j) {
                    const float w0v = pp[j], w1v = pp[128 + j], w2v = pp[256 + j], bv = pp[384 + j], w0g = pp[512 + j], w1g = pp[640 + j], w2g = pp[768 + j], bg = pp[896 + j];
                    float pbv = 0.f, pbg = 0.f, nbv = 0.f, nbg = 0.f;
                    if (blk > 0) { pbv = pbp[4 * n + j]; pbg = pbp[128 + 4 * n + j]; }
                    if (blk < 3) { nbv = nbp[4 * n + j]; nbg = nbp[128 + 4 * n + j]; }
                    float zv[4], zg[4], rv[4], rg[4], lv[4], lg[4];
#pragma unroll
                    for (int m = 0; m < 4; ++m) { zv[m] = acc[ai][0][m][n][j]; zg[m] = acc[ai][1][m][n][j]; rv[m] = dppf<0x121>(zv[m]); rg[m] = dppf<0x121>(zg[m]); lv[m] = dppf<0x12F>(zv[m]); lg[m] = dppf<0x12F>(zg[m]); }
#pragma unroll
                    for (int m = 0; m < 4; ++m) {
                        const float pv = fr > 0 ? rv[m] : (m > 0 ? rv[m > 0 ? m - 1 : 0] : pbv), pg = fr > 0 ? rg[m] : (m > 0 ? rg[m > 0 ? m - 1 : 0] : pbg);
                        const float nv = fr < 15 ? lv[m] : (m < 3 ? lv[m < 3 ? m + 1 : 3] : nbv), ng = fr < 15 ? lg[m] : (m < 3 ? lg[m < 3 ? m + 1 : 3] : nbg);
                        const float cv = w0v * pv + w1v * zv[m] + w2v * nv + bv, cg = w0g * pg + w1g * zg[m] + w2g * ng + bg;
                        if (m == 0 && blk == 0 && fr == 0) { hz[0 * 256 + x0 + 4 * n + j] = zv[0]; hz[0 * 256 + 128 + x0 + 4 * n + j] = zg[0]; hz[2 * 256 + x0 + 4 * n + j] = cv; hz[2 * 256 + 128 + x0 + 4 * n + j] = cg; }
                        if (m == 3 && blk == 3 && fr == 15) { hz[1 * 256 + x0 + 4 * n + j] = zv[3]; hz[1 * 256 + 128 + x0 + 4 * n + j] = zg[3]; hz[3 * 256 + x0 + 4 * n + j] = cv; hz[3 * 256 + 128 + x0 + 4 * n + j] = cg; }
                        o[m][j] = siluf_(cg) * cv; }
                }
#pragma unroll
                for (int m = 0; m < 4; ++m) { const int row = u.pm * BM + ai * HALF + wr * 64 + m * 16 + fr; u32x2 w; w.x = cvt_pk_bf16(o[m][0], o[m][1]); w.y = cvt_pk_bf16(o[m][2], o[m][3]);
                    *(u32x2*)(A + (size_t)row * DFF + c) = w; }
                asm volatile("" ::: "memory");
            }
        }
    }
};
__device__ __forceinline__ void conv_fix_panel(int pm, const float* __restrict__ HALO, const float* __restrict__ cw, bf16_t* __restrict__ A, int tid) {
#pragma unroll
    for (int rk = 0; rk < 2; ++rk) {
        if (rk == 0 ? (pm & 7) == 0 : (pm & 7) == 7) continue;
        const int nb = rk == 0 ? pm - 1 : pm + 1;
        for (int c = tid; c < DFF; c += NWV * 64) { const int pn = c >> 7, x = c & 127;
            const float* hp = HALO + ((size_t)(pm * 22 + pn) * 4 + 2 + rk) * 256; const float* hn = HALO + ((size_t)(nb * 22 + pn) * 4 + (rk == 0 ? 1 : 0)) * 256;
            const float wv = cw[(rk == 0 ? 0 : 2) * NUP + c], wg = cw[(rk == 0 ? 0 : 2) * NUP + DFF + c];
            const float val = hp[x] + wv * hn[x], gate = hp[128 + x] + wg * hn[128 + x];
            A[(size_t)(pm * 256 + (rk == 0 ? 0 : 255)) * DFF + c] = f2bf(siluf_(gate) * val); }
    }
}
__device__ __forceinline__ int sidx(int d, int ri, int n) { return d * 128 + ri * 64 + n; }
__device__ __forceinline__ void s5_tables_block(const S5In& P, int g, int qr, bf16_t* __restrict__ W1, bf16_t* __restrict__ B3, float* __restrict__ A32, LAS unsigned char* lds, int tid) {
    LAS float* BBs = (LAS float*)lds;
    LAS float* PWs = BBs + 4096;
    LAS float* CCs = PWs + 66 * 130;
    LAS float* KT = CCs + 32 * 130;
    if (tid < 128) {
        const int d = tid >> 6, n = tid & 63, dg = d * NG + g;
        const float dt = expf(P.ldt[dg]), lr = P.lre[dg * NS + n], li = P.lim[dg * NS + n];
        const float mag = expf(lr * dt), ang = li * dt, are = mag * cosf(ang), aim = mag * sinf(ang);
        const float den = lr * lr + li * li, nr = are - 1.f, ni = aim, fre = (nr * lr + ni * li) / den, fim = (ni * lr - nr * li) / den;
#pragma unroll
        for (int q = 0; q < PG; ++q) { const float br = P.bre[((size_t)dg * NS + n) * PG + q], bi = P.bim[((size_t)dg * NS + n) * PG + q];
            BBs[((d * 64 + n) * 16 + q) * 2] = fre * br - fim * bi; BBs[((d * 64 + n) * 16 + q) * 2 + 1] = fre * bi + fim * br; }
        double pr = 1.0, pi = 0.0; const double ar = (double)are, ai = (double)aim;
        for (int k = 0; k <= 32; ++k) { PWs[(d * 33 + k) * 130 + n * 2] = (float)pr; PWs[(d * 33 + k) * 130 + n * 2 + 1] = (float)pi; const double t0 = pr * ar - pi * ai, t1 = pr * ai + pi * ar; pr = t0; pi = t1; }
        if (qr == 0) { A32[(dg * NS + n) * 2] = PWs[(d * 33 + 32) * 130 + n * 2]; A32[(dg * NS + n) * 2 + 1] = PWs[(d * 33 + 32) * 130 + n * 2 + 1]; }
    }
    for (int i = tid; i < 2048; i += 512) { const int d = i >> 10, p = (i >> 6) & 15, n = i & 63; CCs[(i >> 6) * 130 + (i & 63) * 2] = P.cre[((size_t)(d * NG + g) * PG + p) * NS + n]; CCs[(i >> 6) * 130 + (i & 63) * 2 + 1] = P.cim[((size_t)(d * NG + g) * PG + p) * NS + n]; }
    __syncthreads();
    for (int it = tid; it < 2 * 32 * 16; it += 512) { const int d = it >> 9, lag = (it >> 4) & 31, p = it & 15; float acc[16];
#pragma unroll
        for (int q = 0; q < 16; ++q) acc[q] = 0.f;
        for (int n = 0; n < 64; ++n) { const float cr = CCs[(d * 16 + p) * 130 + n * 2], ci = CCs[(d * 16 + p) * 130 + n * 2 + 1], pr = PWs[(d * 33 + lag) * 130 + n * 2], pi = PWs[(d * 33 + lag) * 130 + n * 2 + 1];
            const float xr = cr * pr - ci * pi, xi = cr * pi + ci * pr; const LAS float* bb = BBs + ((d * 64 + n) * 16) * 2;
#pragma unroll
            for (int q = 0; q < 16; ++q) acc[q] += xr * bb[2 * q] - xi * bb[2 * q + 1]; }
#pragma unroll
        for (int q = 0; q < 16; ++q) KT[(d * 32 + lag) * 260 + p * 16 + q] = acc[q]; }
    __syncthreads();
    for (int ch = tid; ch < 128 * 96; ch += 512) { const int r = ch / 96, cc = ch % 96, j = qr * 8 + (r >> 4), p = r & 15; float v[8];
        if (cc < 64) { const int i = cc >> 1, q0 = (cc & 1) * 8, lag = j - i;
#pragma unroll
            for (int e = 0; e < 8; ++e) { const int q = q0 + e; float x;
                if (lag > 0) x = KT[lag * 260 + p * 16 + q]; else if (lag < 0) x = KT[(32 - lag) * 260 + p * 16 + q];
                else x = KT[p * 16 + q] + KT[32 * 260 + p * 16 + q] + (q == p ? P.dsk[g * PG + p] : 0.f);
                v[e] = x; } }
        else { const int s0 = (cc - 64) * 8, d = s0 >> 7, ri = (s0 >> 6) & 1, n0 = s0 & 63, k = d == 0 ? j + 1 : 32 - j;
#pragma unroll
            for (int e = 0; e < 8; ++e) { const int n = n0 + e; const float cr = CCs[(d * 16 + p) * 130 + n * 2], ci = CCs[(d * 16 + p) * 130 + n * 2 + 1], pr = PWs[(d * 33 + k) * 130 + n * 2], pi = PWs[(d * 33 + k) * 130 + n * 2 + 1];
                v[e] = ri == 0 ? (cr * pr - ci * pi) : -(cr * pi + ci * pr); } }
        u32x4 w; w.x = pk2(v[0], v[1]); w.y = pk2(v[2], v[3]); w.z = pk2(v[4], v[5]); w.w = pk2(v[6], v[7]);
        *(u32x4*)(B3 + ((size_t)(g * 512 + j * 16 + p)) * KCAT + cc * 8) = w; }
    { const int d = qr >> 1, ri = qr & 1;
      for (int ch = tid; ch < 64 * 64; ch += 512) { const int n = ch >> 6, cc = ch & 63, i = cc >> 1, q0 = (cc & 1) * 8, k = d == 0 ? 31 - i : i; float v[8];
          const float pr = PWs[(d * 33 + k) * 130 + n * 2], pi = PWs[(d * 33 + k) * 130 + n * 2 + 1];
#pragma unroll
          for (int e = 0; e < 8; ++e) { const float br = BBs[((d * 64 + n) * 16 + q0 + e) * 2], bi = BBs[((d * 64 + n) * 16 + q0 + e) * 2 + 1]; v[e] = ri == 0 ? (pr * br - pi * bi) : (pr * bi + pi * br); }
          u32x4 w; w.x = pk2(v[0], v[1]); w.y = pk2(v[2], v[3]); w.z = pk2(v[4], v[5]); w.w = pk2(v[6], v[7]);
          *(u32x4*)(W1 + ((size_t)(g * 256 + qr * 64 + n)) * 512 + cc * 8) = w; } }
    __syncthreads();
}
struct EpiS1 {
    static constexpr bool PERM = false; float* L;
    __device__ __forceinline__ void operator()(const f32x4 (&acc)[2][2][4][2], const pg8::Unit& u, int wr, int wc, int fr, int fq) const {
        using namespace pg8; const int row0 = u.pm * BM + wr * 64 + fr, col0 = wc * 32 + 4 * fq;
#pragma unroll
        for (int ai = 0; ai < 2; ++ai)
#pragma unroll
            for (int m = 0; m < 4; ++m) { float* rp = L + ((size_t)u.grp * UROWS + row0 + ai * HALF + m * 16) * 256 + col0;
#pragma unroll
                for (int bj = 0; bj < 2; ++bj)
#pragma unroll
                    for (int n = 0; n < 2; ++n) *(f32x4*)(rp + bj * HALF + n * 16) = acc[ai][bj][m][n]; }
    }
};
struct EpiS3 {
    static constexpr bool PERM = true; bf16_t* SSM;
    __device__ __forceinline__ void operator()(const f32x4 (&acc)[2][2][4][2], const pg8::Unit& u, int wr, int wc, int fr, int fq) const {
        using namespace pg8; const int row0 = u.pm * BM + wr * 64 + fr, cl = u.pn * BM + wc * 32 + 8 * fq;
        EPI_ROWS_BF16(SSM + ((size_t)(u.grp * 1024 + row)) * 512 + cl, 128, gelu_tanh);
    }
};
struct OrderS1 { int G, c; __device__ __forceinline__ bool next(int i, pg8::Unit& u) const { const int L = i * G + c; if (L >= NG * 5) return false; u.grp = L / 5; u.pm = L % 5; u.pn = 0; return true; } };
struct OrderOne { pg8::Unit u0; __device__ __forceinline__ bool next(int i, pg8::Unit& u) const { if (i != 0) return false; u = u0; return true; } };
template <int MODE> struct EpiResNorm {
    static constexpr bool PERM = false;
    const float* base; float* out; const float* gate; const float* fw; unsigned* xs; unsigned* cnt; LAS float* P;
    bf16_t* H2; const float* sh; const float* sc;
    __device__ __forceinline__ void operator()(f32x4 (&acc)[2][2][4][2], const pg8::Unit& u, int wr, int wc, int fr, int fq) const {
        using namespace pg8; const int row0 = u.pm * BM + wr * 64 + fr, col0 = u.pn * BM + wc * 32 + 4 * fq;
        const int wid = wr * 4 + wc, lane = fq * 16 + fr;
        { const float* gp = gate + (size_t)((u.pm * BM) / SEQ) * 6144 + col0; f32x4 gv[2][2];
#pragma unroll
          for (int bj = 0; bj < 2; ++bj)
#pragma unroll
              for (int n = 0; n < 2; ++n) gv[bj][n] = *(const f32x4*)(gp + bj * HALF + n * 16);
#pragma unroll
          for (int ai = 0; ai < 2; ++ai)
#pragma unroll
              for (int m = 0; m < 4; ++m) { const size_t off = (size_t)(row0 + ai * HALF + m * 16) * 1024 + col0; float s = 0.f;
#pragma unroll
                  for (int bj = 0; bj < 2; ++bj)
#pragma unroll
                      for (int n = 0; n < 2; ++n) { const f32x4 x = *(const f32x4*)(base + off + bj * HALF + n * 16) + gv[bj][n] * acc[ai][bj][m][n]; acc[ai][bj][m][n] = x; s += (x[0] * x[0] + x[1] * x[1]) + (x[2] * x[2] + x[3] * x[3]);
                          if (MODE == 1) *(f32x4*)(out + off + bj * HALF + n * 16) = x; }
                  s += __shfl_xor(s, 16); s += __shfl_xor(s, 32);
                  if (fq == 0) P[(ai * HALF + wr * 64 + m * 16 + fr) * 4 + wc] = s; } }
        asm volatile("s_waitcnt lgkmcnt(0)" ::: "memory"); __builtin_amdgcn_s_barrier(); asm volatile("" ::: "memory");
        const int prow = wid * 32 + (lane & 31);
        if (lane < 32) { const f32x4 p = *(const LAS f32x4*)(P + prow * 4);
            __hip_atomic_store(xs + ((size_t)(u.pm * BM + prow)) * 4 + u.pn, __float_as_uint((p[0] + p[1]) + (p[2] + p[3])), __ATOMIC_RELAXED, __HIP_MEMORY_SCOPE_AGENT); }
        asm volatile("s_waitcnt vmcnt(0)" ::: "memory");
        if (lane == 0) __hip_atomic_fetch_add(cnt + 64 * u.pm, 1u, __ATOMIC_RELAXED, __HIP_MEMORY_SCOPE_AGENT);
        if (wid == 0) {
            unsigned spins = 0;
            while ((unsigned)__builtin_amdgcn_readfirstlane(__hip_atomic_load(cnt + 64 * u.pm, __ATOMIC_RELAXED, __HIP_MEMORY_SCOPE_AGENT)) < 32u) { __builtin_amdgcn_s_sleep(2); if (++spins > (1u << 22)) break; }
            __builtin_amdgcn_fence(__ATOMIC_ACQUIRE, "agent");
        }
        asm volatile("s_waitcnt vmcnt(0) lgkmcnt(0)" ::: "memory"); __builtin_amdgcn_s_barrier(); asm volatile("" ::: "memory");
        if (lane < 32) { const unsigned* sl = xs + ((size_t)(u.pm * BM + prow)) * 4; float t = 0.f;
#pragma unroll
            for (int k = 0; k < 4; ++k) t += __uint_as_float(__hip_atomic_load(sl + k, __ATOMIC_RELAXED, __HIP_MEMORY_SCOPE_AGENT));
            P[1024 + prow] = rsqrtf(t * (1.f / DM) + EPS); }
        asm volatile("s_waitcnt lgkmcnt(0)" ::: "memory"); __builtin_amdgcn_s_barrier(); asm volatile("" ::: "memory");
        if (MODE == 0) {
            f32x4 fv[2][2];
#pragma unroll
            for (int bj = 0; bj < 2; ++bj)
#pragma unroll
                for (int n = 0; n < 2; ++n) fv[bj][n] = *(const f32x4*)(fw + col0 + bj * HALF + n * 16);
#pragma unroll
            for (int ai = 0; ai < 2; ++ai)
#pragma unroll
                for (int m = 0; m < 4; ++m) { const int r = ai * HALF + wr * 64 + m * 16 + fr; const float rs = P[1024 + r]; const size_t off = (size_t)(u.pm * BM + r) * 1024 + col0;
#pragma unroll
                    for (int bj = 0; bj < 2; ++bj)
#pragma unroll
                        for (int n = 0; n < 2; ++n) *(f32x4*)(out + off + bj * HALF + n * 16) = acc[ai][bj][m][n] * rs * fv[bj][n]; }
        } else {
            float rsv[2][4];
#pragma unroll
            for (int ai = 0; ai < 2; ++ai)
#pragma unroll
                for (int m = 0; m < 4; ++m) rsv[ai][m] = P[1024 + ai * HALF + wr * 64 + m * 16 + fr];
            const size_t mo = (size_t)((u.pm * BM) / SEQ) * 6144 + col0;
#pragma unroll
            for (int bj = 0; bj < 2; ++bj)
#pragma unroll
                for (int n = 0; n < 2; ++n) { const int cc = bj * HALF + n * 16; const f32x4 ww = *(const f32x4*)(fw + col0 + cc), s1 = *(const f32x4*)(sc + mo + cc) + 1.f, s0 = *(const f32x4*)(sh + mo + cc);
#pragma unroll
                    for (int ai = 0; ai < 2; ++ai)
#pragma unroll
                        for (int m = 0; m < 4; ++m) { const f32x4 y = (acc[ai][bj][m][n] * rsv[ai][m] * ww) * s1 + s0; u32x2 w; w.x = cvt_pk_bf16(y[0], y[1]); w.y = cvt_pk_bf16(y[2], y[3]);
                            *(u32x2*)(H2 + (size_t)(row0 + ai * HALF + m * 16) * 1024 + col0 + cc) = w; }
                    asm volatile("" ::: "memory"); }
        }
    }
};
struct OrderRect { pg8::StaticOrder so; __device__ __forceinline__ bool next(int i, pg8::Unit& u) const { return so.next(i, u); } };
struct OrderA {
    pg8::StaticOrder so;
    __device__ __forceinline__ bool next(int i, pg8::Unit& u) const {
        if (so.next(i, u)) return true;
        const long L = (long)i * so.G + so.c - so.nwg; if (L < 0 || L >= 64) return false;
        u.pm = 128 + (int)(L >> 2); u.pn = 4 + (int)(L & 3); u.grp = 0; return true;
    }
};

__global__ void __launch_bounds__(NWV * 64, 2) mk_fwd(MkArgs a) {
    extern __shared__ __attribute__((aligned(16))) unsigned char lds_raw[];
    LAS unsigned char* lds = (LAS unsigned char*)lds_raw;
#if !USE_XBAR
    cg::grid_group grid = cg::this_grid();
#endif
    const int tid0 = threadIdx.x, wave = __builtin_amdgcn_readfirstlane(tid0 >> 6);
#define PHASE_IDS const int tid = opaque_tid(wave), lane = tid & 63; (void)tid; (void)lane
    const int G = gridDim.x, bx = blockIdx.x;
    const int gw = bx * NWV + wave, NGW = G * NWV;
    unsigned char* ws = a.ws;
#define mod ((float*)(ws + WS_MOD))
#define WTin ((bf16_t*)(ws + WS_WIN))
#define WTbr ((bf16_t*)(ws + WS_WBR))
#define WTglu ((bf16_t*)(ws + WS_WGLU))
#define WTout ((bf16_t*)(ws + WS_WOUT))
#define WTup ((bf16_t*)(ws + WS_WUP))
#define WTdn ((bf16_t*)(ws + WS_WDN))
#define H ((bf16_t*)(ws + WS_H))
#define Q ((bf16_t*)(ws + WS_Q))
#define Kb ((bf16_t*)(ws + WS_K))
#define Vb ((bf16_t*)(ws + WS_V))
#define Ucat ((bf16_t*)(ws + WS_UCAT))
#define Uctx Ucat
#define SG ((bf16_t*)(ws + WS_SG))
#define O ((bf16_t*)(ws + WS_O))
#define SSM ((bf16_t*)(ws + WS_SSM))
#define GLU ((bf16_t*)(ws + WS_GLU))
#define MG ((bf16_t*)(ws + WS_MG))
#define H2 ((bf16_t*)(ws + WS_H2))
#define Ab ((bf16_t*)(ws + WS_A))
#define Ytmp ((float*)(ws + WS_YTMP))
    float* const out = a.out;
    const int lo = a.ph_lo, hi = a.ph_hi;
    volatile LAS unsigned* bst = (volatile LAS unsigned*)(lds + MK_LDS - 16);
    if (tid0 < 2) bst[tid0] = 0u;
    __syncthreads();
    XcdBarrier xbar = xcd_barrier_post((unsigned*)(ws + WS_CTL), bst);
#define IN(k) (lo <= (k) && (k) < hi)
#if USE_XBAR
#define SEAM(k) do { if (IN(k) && IN((k) + 1)) xcd_barrier(xbar); } while (0)
#else
#define SEAM(k) do { if (IN(k) && IN((k) + 1)) grid.sync(); } while (0)
#endif

    if (IN(0)) REPS(0) { PHASE_IDS;
        if (bx < 96) REPS(16) {
            LAS float* sc = (LAS float*)lds;
            LAS float* red = (LAS float*)(lds + 17 * 1024 * 4);
            for (int i = tid; i < 17 * 1024; i += NWV * 64) { const int r = i >> 10, k = i & 1023; sc[i] = siluf_(r < NB ? a.in[1][(size_t)r * DM + k] : a.in[3][k]); }
            __syncthreads();
            const int col = bx * 64 + lane; float acc[17];
#pragma unroll
            for (int r = 0; r < 17; ++r) acc[r] = 0.f;
            const float* wm = a.in[4];
            for (int k = wave * 128; k < wave * 128 + 128; ++k) { const float w = wm[(size_t)k * 6144 + col];
#pragma unroll
                for (int r = 0; r < 17; ++r) acc[r] = fmaf(sc[r * 1024 + k], w, acc[r]); }
#pragma unroll
            for (int r = 0; r < 17; ++r) red[(wave * 17 + r) * 64 + lane] = acc[r];
            __syncthreads();
            for (int i = tid; i < 17 * 64; i += NWV * 64) { const int r = i >> 6, cc = i & 63; float s = a.in[5][bx * 64 + cc];
#pragma unroll
                for (int w = 0; w < 8; ++w) s += red[(w * 17 + r) * 64 + cc];
                mod[(size_t)r * 6144 + bx * 64 + cc] = s; }
            __syncthreads();
        }
        if (bx >= 96 && bx < 96 + 128 || (G < 224 && bx < 96)) {
            S5In s5{a.in[12], a.in[13], a.in[14], a.in[15], a.in[16], a.in[17], a.in[18], a.in[19]};
            const int first = (G >= 224) ? bx - 96 : bx, step = (G >= 224) ? 128 : (G < 96 ? G : 96);
            REPS(17) for (int it = first; it < 128; it += step) s5_tables_block(s5, it >> 2, it & 3, (bf16_t*)((char*)a.out + OUT_W1), (bf16_t*)((char*)a.out + OUT_B3), (float*)(ws + WS_A32), lds, tid);
        }
        LAS float* scr = (LAS float*)(lds + wave * 16384);
        constexpr int I_IN = (DM / 64) * (DIN / 32), I_SQ = (DM / 64) * (DM / 32), I_GLU = (512 / 64) * (2048 / 32), I_UP = (DM / 64) * (NUP / 32), I_DN = (DFF / 64) * (DM / 32);
        constexpr int NITEMS = I_IN + 2 * I_SQ + I_GLU + I_UP + I_DN;
        REPS(18) for (int it = gw; it < NITEMS; it += NGW) {
            int r = it;
            if (r < I_IN) { transpose_item<0>(a.in[8], DM, DIN, WTin, scr, r, lane); continue; } r -= I_IN;
            if (r < I_SQ) { transpose_item<0>(a.in[11], DM, DM, WTbr, scr, r, lane); continue; } r -= I_SQ;
            if (r < I_GLU) { transpose_item<2>(a.in[20], 512, 2048, WTglu, scr, r, lane); continue; } r -= I_GLU;
            if (r < I_SQ) { transpose_item<0>(a.in[21], DM, DM, WTout, scr, r, lane); continue; } r -= I_SQ;
            if (r < I_UP) { transpose_item<1>(a.in[22], DM, NUP, WTup, scr, r, lane); continue; } r -= I_UP;
            transpose_item<0>(a.in[25], DFF, DM, WTdn, scr, r, lane);
        }
    }
    SEAM(0);
    if (IN(1)) REPS(1) { PHASE_IDS;
        for (int L = bx; L < 64; L += G) {
            const int r0 = ML + 256 * (L >> 2);
            for (int r = r0 + 4 * wave; r < r0 + 256; r += 4 * NWV) norm_mod_rows4(a.in[2] + (size_t)(r - ML) * DM, a.in[6], mod + (size_t)NB * 6144, mod + (size_t)NB * 6144 + 1024, H + (size_t)r * DM, lane);
            asm volatile("s_waitcnt vmcnt(0)" ::: "memory"); __syncthreads();
            pg8::Gemm g{H, WTin, DM, DM, DM, 0, 0, 0}; OrderOne S{{128 + (L >> 2), 4 + (L & 3), 0}}; EpiAfast E{Q, Kb, Vb, Ucat, SG, a.in[9], a.in[10], (LAS float*)(lds + 131072)};
            pg8::gemm_phase<EpiAfast, OrderOne>(lds, g, S, E, wave);
        }
        { const int nb = G > 64 ? G - 64 : G, ib = G > 64 ? bx - 64 : bx;
          if (ib >= 0) for (int r = 4 * (ib * NWV + wave); r < ML; r += 4 * nb * NWV) { const int mb = r / SEQ; norm_mod_rows4(a.in[0] + (size_t)r * DM, a.in[6], mod + (size_t)mb * 6144, mod + (size_t)mb * 6144 + 1024, H + (size_t)r * DM, lane); } }
    }
    SEAM(1);
    if (IN(2)) REPS(2) {
        pg8::Gemm g{H, WTin, DM, DM, DM, 0, 0, 0}; OrderRect S; S.so.init(ML / 256, DIN / 256, G, bx);
        EpiAfast E{Q, Kb, Vb, Ucat, SG, a.in[9], a.in[10], (LAS float*)(lds + 131072)};
        pg8::gemm_phase<EpiAfast, OrderRect>(lds, g, S, E, wave);
    }
    SEAM(2);
    if (IN(4)) REPS(4) {
#if !S5_NAIVE
        { pg8::Gemm g{Ucat, (const bf16_t*)((char*)a.out + OUT_W1), KCAT, 512, 512, (size_t)UROWS * KCAT * 2, (size_t)256 * 512 * 2, 0}; OrderS1 S{G, bx}; EpiS1 E{(float*)((char*)a.out + OUT_L)}; pg8::gemm_phase<EpiS1, OrderS1>(lds, g, S, E, wave); }
#endif
        const int nrounds = (NB * 2 * 32 + G - 1) / G;
        for (int i = 0; i < nrounds; ++i) {
            int unit; if (G == 256) { const int bk = i * 8 + (bx & 7), s = bx >> 3; unit = bk * 32 + s; } else unit = i * G + bx;
            if (unit >= NB * 2 * 32) break;
            const int bk = unit >> 5, s = unit & 31, b = bk >> 1, kvh = bk & 1, h = kvh * 4 + (s >> 3), qb = s & 7;
            const size_t q0 = ((size_t)b * SEQ + (size_t)qb * 256) * 1024 + h * 128, k0 = (size_t)b * LKV * 256 + kvh * 128;
            att::attn_dense_body(Q + q0, Kb + k0, Vb + k0, O + q0, LKV, (char*)lds_raw, wave);
        }
    }
    SEAM(4);
    if (IN(5)) REPS(5) { PHASE_IDS;
#if S5_NAIVE
        S5In s5{a.in[12], a.in[13], a.in[14], a.in[15], a.in[16], a.in[17], a.in[18], a.in[19]};
        for (int it = bx * 2 + wave; wave < 2 && it < NB * NG; it += G * 2) s5_naive_wave(s5, Ucat, Uctx, Ytmp, SSM, lane, it & 31, it >> 5);
#else
        const float* Lb = (const float*)((char*)a.out + OUT_L); const float* A32 = (const float*)(ws + WS_A32);
        for (int un = bx; un < 256; un += G) {
            const int g = un >> 3, pm = (un >> 1) & 3, pn = un & 1;
            REPS(19) { const int bl = tid >> 7, d = (tid >> 6) & 1, n = tid & 63, b = pm * 4 + bl;
              const float ar = A32[((d * NG + g) * NS + n) * 2], ai = A32[((d * NG + g) * NS + n) * 2 + 1];
              const float* Lg = Lb + (size_t)g * UROWS * 256 + sidx(d, 0, n); bf16_t* Sg = Ucat + (size_t)g * UROWS * KCAT + 512 + sidx(d, 0, n);
              float sr = 0.f, si = 0.f;
              { float lr[8], li[8];
#pragma unroll
                for (int i = 0; i < 8; ++i) { const int row = 1024 + b * 8 + (d == 0 ? i : 7 - i); lr[i] = Lg[(size_t)row * 256]; li[i] = Lg[(size_t)row * 256 + 64]; }
#pragma unroll
                for (int i = 0; i < 8; ++i) { const float t0 = ar * sr - ai * si + lr[i], t1 = ar * si + ai * sr + li[i]; sr = t0; si = t1; } }
#pragma unroll 1
              for (int i0 = 0; i0 < 64; i0 += 32) { float lr[32], li[32];
#pragma unroll
                  for (int i = 0; i < 32; ++i) { const int row = b * 64 + (d == 0 ? i0 + i : 63 - i0 - i); lr[i] = Lg[(size_t)row * 256]; li[i] = Lg[(size_t)row * 256 + 64]; }
#pragma unroll
                  for (int i = 0; i < 32; ++i) { const int row = b * 64 + (d == 0 ? i0 + i : 63 - i0 - i);
                      Sg[(size_t)row * KCAT] = f2bf(sr); Sg[(size_t)row * KCAT + 64] = f2bf(si);
                      const float t0 = ar * sr - ai * si + lr[i], t1 = ar * si + ai * sr + li[i]; sr = t0; si = t1; } }
              asm volatile("s_waitcnt vmcnt(0)" ::: "memory"); __syncthreads(); }
            pg8::Gemm gm{Ucat, (const bf16_t*)((char*)a.out + OUT_B3), KCAT, KCAT, KCAT, (size_t)UROWS * KCAT * 2, (size_t)512 * KCAT * 2, 0}; OrderOne S{{pm, pn, g}}; EpiS3 E{SSM};
            REPS(20) pg8::gemm_phase<EpiS3, OrderOne>(lds, gm, S, E, wave);
        }
#endif
    }
    SEAM(5);
    if (IN(6)) REPS(6) { pg8::Gemm g{SSM, WTglu, 512, 512, 512, 0, 0, 1}; OrderRect S; S.so.init(ML / 256, 2048 / 256, G, bx); EpiGluPair E{SG, GLU}; pg8::gemm_phase<EpiGluPair, OrderRect>(lds, g, S, E, wave); }
    SEAM(6);
    if (IN(7)) REPS(7) { pg8::Gemm g{O, WTbr, DM, DM, DM, 0, 0, 0}; OrderRect S; S.so.init(ML / 256, DM / 256, G, bx); EpiMergeFast E{SG, GLU, MG}; pg8::gemm_phase<EpiMergeFast, OrderRect>(lds, g, S, E, wave); }
    SEAM(7);
    if (IN(8)) REPS(8) { pg8::Gemm g{MG, WTout, DM, DM, DM, 0, 0, 0}; OrderRect S; S.so.init(ML / 256, DM / 256, G, bx); EpiResNorm<1> E{a.in[0], out, mod + 2048, a.in[7], (unsigned*)(ws + WS_XS2), (unsigned*)(ws + WS_CTL + 65536), (LAS float*)(lds + 131072), H2, mod + 3072, mod + 4096}; pg8::gemm_phase<EpiResNorm<1>, OrderRect>(lds, g, S, E, wave); }
    SEAM(8);
    if (IN(10)) REPS(10) { pg8::Gemm g{H2, WTup, DM, DM, DM, 0, 0, 0}; OrderRect S; S.so.init(ML / 256, NUP / 256, G, bx);
        EpiUpConv E{Ab, (float*)(ws + WS_HALO), a.in[23], a.in[24], (LAS float*)(lds + 131072), (LAS float*)(lds + 131072 + 8192)}; pg8::gemm_phase<EpiUpConv, OrderRect>(lds, g, S, E, wave); }
    SEAM(10);
    if (IN(14)) { PHASE_IDS; pg8::Gemm g{Ab, WTdn, DFF, DFF, DFF, 0, 0, 0}; OrderRect S; S.so.init(ML / 256, DM / 256, G, bx);
        { pg8::Unit u; for (int i = 0; S.next(i, u); ++i) conv_fix_panel(u.pm, (const float*)(ws + WS_HALO), a.in[23], Ab, tid); asm volatile("s_waitcnt vmcnt(0)" ::: "memory"); __syncthreads(); }
        EpiResNorm<0> E{out, out, mod + 5120, a.in[26], (unsigned*)(ws + WS_XS), (unsigned*)(ws + WS_CTL + 16384), (LAS float*)(lds + 131072), nullptr, nullptr, nullptr}; pg8::gemm_phase<EpiResNorm<0>, OrderRect>(lds, g, S, E, wave); }
#undef IN
#undef SEAM
#undef mod
#undef WTin
#undef WTbr
#undef WTglu
#undef WTout
#undef WTup
#undef WTdn
#undef H
#undef Q
#undef Kb
#undef Vb
#undef Ucat
#undef Uctx
#undef SG
#undef O
#undef SSM
#undef GLU
#undef MG
#undef H2
#undef Ab
#undef Ytmp
}

extern "C" void kernel_launch(void* const* d_in, const int* in_sizes, int n_in, void* d_out, int out_size, void* d_ws, size_t ws_size, hipStream_t stream) {
    static int grid_blocks = 0;
    if (grid_blocks == 0) {
        if (n_in != 27 || in_sizes[0] != ML * DM || out_size != ML * DM || ws_size < WS_NEED) {
            fprintf(stderr, "kernel_launch: unexpected shapes: n_in %d in0 %d out %d ws %zu (need >= %zu)\n", n_in, n_in > 0 ? in_sizes[0] : -1, out_size, ws_size, (size_t)WS_NEED); grid_blocks = -1; return; }
        int dev = 0, cus = 0, per_cu = 0;
        if (hipGetDevice(&dev) != hipSuccess || hipDeviceGetAttribute(&cus, hipDeviceAttributeMultiprocessorCount, dev) != hipSuccess) { fprintf(stderr, "kernel_launch: device query failed\n"); grid_blocks = -1; return; }
        if (hipFuncSetAttribute((const void*)mk_fwd, hipFuncAttributeMaxDynamicSharedMemorySize, MK_LDS) != hipSuccess) { fprintf(stderr, "kernel_launch: hipFuncSetAttribute(mk_fwd) failed\n"); grid_blocks = -1; return; }
        if (hipOccupancyMaxActiveBlocksPerMultiprocessor(&per_cu, (const void*)mk_fwd, NWV * 64, MK_LDS) != hipSuccess || per_cu < 1) { fprintf(stderr, "kernel_launch: occupancy query says %d blocks/CU\n", per_cu); grid_blocks = -1; return; }
        grid_blocks = cus;
    }
    if (grid_blocks < 0) return;
    if (hipMemsetAsync((char*)d_ws + WS_CTL, 0, 131072, stream) != hipSuccess) fprintf(stderr, "kernel_launch: memset failed\n");
    MkArgs a{};
    for (int i = 0; i < 27; ++i) a.in[i] = (const float*)d_in[i];
    a.out = (float*)d_out; a.ws = (unsigned char*)d_ws; a.ph_lo = 0; a.ph_hi = 16;
    void* args[] = {&a};
    hipError_t e = hipLaunchCooperativeKernel((const void*)mk_fwd, dim3(grid_blocks), dim3(NWV * 64), args, MK_LDS, stream);
    if (e != hipSuccess) fprintf(stderr, "kernel_launch: cooperative launch failed: %s (grid %d)\n", hipGetErrorString(e), grid_blocks);
}
```

```cpp
#include <hip/hip_runtime.h>
#include <cstdio>
#include <cstdint>

typedef unsigned short bf16_t;
typedef short bf16x8 __attribute__((ext_vector_type(8)));
typedef short s16x4 __attribute__((ext_vector_type(4)));
typedef float f32x4 __attribute__((ext_vector_type(4)));
typedef float f32x16 __attribute__((ext_vector_type(16)));
typedef unsigned u32x4 __attribute__((ext_vector_type(4)));
typedef unsigned u32x2 __attribute__((ext_vector_type(2)));
typedef float f32x2 __attribute__((ext_vector_type(2)));

constexpr int NB = 16, SEQ = 2048, DM = 1024, LC = 256, LKV = LC + SEQ;
constexpr int ML = NB * SEQ, MC = NB * LC, MT = ML + MC;
constexpr int DIN = 4096, DFF = 2816, NUP = 2 * DFF;
constexpr int NG = 32, NS = 64, PG = 16;
constexpr int TCH = 32, NCH = SEQ / TCH, KCAT = TCH * PG + 256;
constexpr int UROWS = 1280;
constexpr float EPS = 1e-6f;

constexpr size_t MiB = 1u << 20;
constexpr size_t WS_CTL = 0, WS_MOD = 1 * MiB;
constexpr size_t WS_WIN = 16 * MiB, WS_WBR = 24 * MiB, WS_WGLU = 26 * MiB, WS_WOUT = 28 * MiB, WS_WUP = 30 * MiB, WS_WDN = 41 * MiB;
constexpr size_t WS_H = 48 * MiB;
constexpr size_t WS_Q = 120 * MiB;
constexpr size_t WS_K = 184 * MiB;
constexpr size_t WS_V = 202 * MiB;
constexpr size_t WS_UCAT = 220 * MiB;
constexpr size_t WS_SG = 280 * MiB;
constexpr size_t WS_O = 408 * MiB;
constexpr size_t WS_SSM = 472 * MiB;
constexpr size_t WS_A32 = 2 * MiB;
constexpr size_t OUT_W1 = 0, OUT_B3 = 8 * MiB, OUT_L = 32 * MiB;
constexpr size_t WS_YTMP = 48 * MiB;
constexpr size_t WS_GLU = 48 * MiB;
constexpr size_t WS_MG = 184 * MiB;
constexpr size_t WS_H2 = 48 * MiB;
constexpr size_t WS_A = 112 * MiB;
constexpr size_t WS_HALO = 288 * MiB;
constexpr size_t WS_XS = 300 * MiB;
constexpr size_t WS_XS2 = 301 * MiB;
constexpr size_t WS_NEED = 512 * MiB;

__device__ __forceinline__ int opaque_tid(int wave) { int t = wave * 64 + (int)__builtin_amdgcn_mbcnt_hi(~0u, __builtin_amdgcn_mbcnt_lo(~0u, 0u)); asm volatile("" : "+v"(t)); return t; }
__device__ __forceinline__ float bf2f(bf16_t v) { return __uint_as_float(((unsigned)v) << 16); }
__device__ __forceinline__ bf16_t f2bf(float f) { unsigned u = __float_as_uint(f); u += 0x7fffu + ((u >> 16) & 1u); return (bf16_t)(u >> 16); }
__device__ __forceinline__ float sigmoidf_(float x) { return 1.f / (1.f + __expf(-x)); }
__device__ __forceinline__ float siluf_(float x) { return x / (1.f + __expf(-x)); }
__device__ __forceinline__ float gelu_tanh(float x) { const float u = 0.7978845608028654f * (x + 0.044715f * x * x * x); return x / (1.f + __expf(-2.f * u)); }
__device__ __forceinline__ float wave_sum(float v) {
#pragma unroll
    for (int o = 1; o < 64; o <<= 1) v += __shfl_xor(v, o);
    return v;
}
__device__ __forceinline__ size_t ucat_idx(int b, int t, int ch) { const int g = ch >> 4, q = ch & 15, c = t >> 5, j = t & 31; return ((size_t)(g * UROWS + b * NCH + c)) * KCAT + j * PG + q; }
__device__ __forceinline__ size_t ucat_ctx_idx(int b, int tc, int ch) { const int g = ch >> 4, q = ch & 15, c = tc >> 5, j = tc & 31; return ((size_t)(g * UROWS + 1024 + b * 8 + c)) * KCAT + j * PG + q; }

__device__ __forceinline__ void qk_norm_rope_row(bf16_t* p, const float* __restrict__ w, int pos, int lane) {
    const unsigned raw = *(const unsigned*)(p + 2 * lane);
    const float v0 = bf2f((bf16_t)(raw & 0xffff)), v1 = bf2f((bf16_t)(raw >> 16));
    const float rs = rsqrtf(wave_sum(v0 * v0 + v1 * v1) * (1.f / 128.f) + EPS);
    float y0 = v0 * rs * w[2 * lane], y1 = v1 * rs * w[2 * lane + 1];
    if (pos >= 0) {
        const float coord = (lane < 32) ? (float)(pos >> 6) : (float)(pos & 63);
        const float invf = exp2f(-(float)(2 * (lane & 31)) * (13.287712379549449f / 64.f));
        const float ang = coord * invf; const float cs = cosf(ang), sn = sinf(ang);
        const float o0 = y0 * cs - y1 * sn, o1 = y0 * sn + y1 * cs; y0 = o0; y1 = o1;
    }
    *(unsigned*)(p + 2 * lane) = (unsigned)f2bf(y0) | ((unsigned)f2bf(y1) << 16);
}
namespace att {
constexpr int D = 128, NW = 8, QBLK = 32, KVBLK = 64;
constexpr float SCALE = 0.088388347648318440f;
constexpr float THR = 8.f;
constexpr int LDQ = 1024, LDK = 256, LDO = 1024;
constexpr size_t SHM_V = KVBLK * D * 2, SHM_K = KVBLK * D * 2, SHM_ATTN = 2 * SHM_V + 2 * SHM_K + NW * 64 * 4;
#define KSWZ(row, colB) ((row) * 256 + ((colB) ^ (((row) & 7) << 4)))
#define SBAR() __builtin_amdgcn_sched_barrier(0)
__device__ __forceinline__ int crow(int r, int hi) { return (r & 3) + 8 * (r >> 2) + 4 * hi; }
__device__ __forceinline__ unsigned cvtpk(float lo, float hi) { unsigned r; asm volatile("v_cvt_pk_bf16_f32 %0, %1, %2" : "=v"(r) : "v"(lo), "v"(hi)); return r; }
__device__ __forceinline__ void partialSM(f32x16& p0, f32x16& p1, float& m_reg, float& mn, float& alpha) {
    constexpr float C = SCALE * 1.4426950408889634f;
    float pmax = p0[0]; for (int r = 1; r < 16; ++r) pmax = fmaxf(pmax, p0[r]); for (int r = 0; r < 16; ++r) pmax = fmaxf(pmax, p1[r]);
    { auto rr = __builtin_amdgcn_permlane32_swap(__float_as_uint(pmax), __float_as_uint(pmax), false, false);
      pmax = fmaxf(__uint_as_float(rr[0]), __uint_as_float(rr[1])); }
    if (__builtin_expect(__all(pmax - m_reg <= THR / SCALE), 1)) { mn = m_reg; alpha = 1.f; }
    else { mn = fmaxf(m_reg, pmax); alpha = __builtin_amdgcn_exp2f((m_reg - mn) * C); m_reg = mn; }
    float mnC = -mn * C;
    for (int r = 0; r < 16; ++r) p0[r] = fmaf(p0[r], C, mnC); for (int r = 0; r < 16; ++r) p1[r] = fmaf(p1[r], C, mnC);
    for (int r = 0; r < 16; ++r) p0[r] = __builtin_amdgcn_exp2f(p0[r]);
}
__device__ __forceinline__ void finishSM(f32x16& p0, f32x16& p1, float alpha, float& l_reg, bf16x8& pa0, bf16x8& pa1, bf16x8& pa2, bf16x8& pa3) {
    for (int r = 0; r < 16; ++r) p1[r] = __builtin_amdgcn_exp2f(p1[r]);
    float ps = 0; for (int r = 0; r < 16; ++r) ps += p0[r]; for (int r = 0; r < 16; ++r) ps += p1[r];
    { auto rr = __builtin_amdgcn_permlane32_swap(__float_as_uint(ps), __float_as_uint(ps), false, false);
      ps = __uint_as_float(rr[0]) + __uint_as_float(rr[1]); }
    l_reg = l_reg * alpha + ps;
#define PK4(P, BASE, OUT) do { unsigned a0 = cvtpk(P[BASE + 0], P[BASE + 1]), a1 = cvtpk(P[BASE + 2], P[BASE + 3]);   \
    unsigned b0 = cvtpk(P[BASE + 4], P[BASE + 5]), b1 = cvtpk(P[BASE + 6], P[BASE + 7]);                              \
    auto r0 = __builtin_amdgcn_permlane32_swap(a0, b0, false, false); auto r1 = __builtin_amdgcn_permlane32_swap(a1, b1, false, false); \
    u32x4 w = {r0[0], r1[0], r0[1], r1[1]}; OUT = *reinterpret_cast<bf16x8*>(&w); } while (0)
    PK4(p0, 0, pa0); PK4(p0, 8, pa1); PK4(p1, 0, pa2); PK4(p1, 8, pa3);
#undef PK4
}
__device__ __forceinline__ void qkt(f32x16& p0, f32x16& p1, const bf16_t* Ks, const bf16x8* qr, int r32, int hi) {
    p0 = f32x16{}; p1 = f32x16{};
    for (int d0 = 0; d0 < 8; ++d0) { int cb = (d0 * 16 + hi * 8) * 2;
        bf16x8 b0 = *reinterpret_cast<const bf16x8*>((const char*)Ks + KSWZ(r32, cb));
        bf16x8 b1 = *reinterpret_cast<const bf16x8*>((const char*)Ks + KSWZ(32 + r32, cb));
        p0 = __builtin_amdgcn_mfma_f32_32x32x16_bf16(b0, qr[d0], p0, 0, 0, 0);
        p1 = __builtin_amdgcn_mfma_f32_32x32x16_bf16(b1, qr[d0], p1, 0, 0, 0); }
}
__device__ __forceinline__ int v_st(int k, int c) { const int kk = (k & ~0xC) | ((k & 4) << 1) | ((k & 8) >> 1); return ((kk >> 3) * 4 + (c >> 5)) * 512 + ((kk & 7) * 32 + (c & 31)) * 2; }
__device__ __forceinline__ int v_rd_base(int lane) { return ((lane & 3) << 3) | (((lane >> 2) & 3) << 6) | (((lane >> 4) & 1) << 5) | (((lane >> 5) & 1) << 8); }
constexpr int v_rd_off(int d0, int ks, int half) { return d0 * 512 + ks * 4096 + half * 2048; }
template <int OFF> __device__ __forceinline__ s16x4 tr_read(int vb) {
    s16x4 r; asm volatile("ds_read_b64_tr_b16 %0, %1 offset:%2" : "=&v"(r) : "v"(vb), "i"(OFF) : "memory"); return r;
}
template <int D0> __device__ __forceinline__ void pv_one(f32x16& od, int vb, bf16x8 pa0, bf16x8 pa1, bf16x8 pa2, bf16x8 pa3) {
    const s16x4 l0 = tr_read<v_rd_off(D0, 0, 0)>(vb), h0 = tr_read<v_rd_off(D0, 0, 1)>(vb), l1 = tr_read<v_rd_off(D0, 1, 0)>(vb), h1 = tr_read<v_rd_off(D0, 1, 1)>(vb);
    const s16x4 l2 = tr_read<v_rd_off(D0, 2, 0)>(vb), h2 = tr_read<v_rd_off(D0, 2, 1)>(vb), l3 = tr_read<v_rd_off(D0, 3, 0)>(vb), h3 = tr_read<v_rd_off(D0, 3, 1)>(vb);
    asm volatile("s_waitcnt lgkmcnt(0)" ::: "memory"); SBAR();
#define PK(L, H) (bf16x8){L[0], L[1], L[2], L[3], H[0], H[1], H[2], H[3]}
    od = __builtin_amdgcn_mfma_f32_32x32x16_bf16(pa0, PK(l0, h0), od, 0, 0, 0);
    od = __builtin_amdgcn_mfma_f32_32x32x16_bf16(pa1, PK(l1, h1), od, 0, 0, 0);
    od = __builtin_amdgcn_mfma_f32_32x32x16_bf16(pa2, PK(l2, h2), od, 0, 0, 0);
    od = __builtin_amdgcn_mfma_f32_32x32x16_bf16(pa3, PK(l3, h3), od, 0, 0, 0);
#undef PK
}
__device__ __forceinline__ void pv_d0(f32x16* o, int vb, bf16x8 pa0, bf16x8 pa1, bf16x8 pa2, bf16x8 pa3) {
    pv_one<0>(o[0], vb, pa0, pa1, pa2, pa3); pv_one<1>(o[1], vb, pa0, pa1, pa2, pa3); pv_one<2>(o[2], vb, pa0, pa1, pa2, pa3); pv_one<3>(o[3], vb, pa0, pa1, pa2, pa3);
}
__device__ __forceinline__ void attn_dense_body(const bf16_t* __restrict__ Qb, const bf16_t* __restrict__ Kh, const bf16_t* __restrict__ Vh, bf16_t* __restrict__ Ob, int seq, char* lds, int wave_id) {
    const int tid = opaque_tid(wave_id), wid = tid >> 6, lane = tid & 63, r32 = lane & 31, hi = lane >> 5;
    bf16_t* V_lds = (bf16_t*)lds; bf16_t* K_lds = (bf16_t*)(lds + 2 * SHM_V);
    float* ws = (float*)(lds + 2 * SHM_V + 2 * SHM_K) + wid * 64; float* li_l = ws; float* al_l = ws + 32;
    float m_reg = -1e30f, l_reg = 0; f32x16 o[4] = {}; bf16x8 qr[8];
    const bf16_t* Qw = Qb + (long)(wid * QBLK + r32) * LDQ + hi * 8;
#pragma unroll
    for (int d0 = 0; d0 < 8; ++d0) qr[d0] = *reinterpret_cast<const bf16x8*>(Qw + d0 * 16);
    const int sr = tid >> 4, sc = (tid & 15) * 8, vst0 = v_st(sr, sc), vst1 = v_st(32 + sr, sc);
    const int vb0 = (int)(uintptr_t)V_lds + v_rd_base(lane);
    struct { bf16x8 vs0, vs1, ks0, ks1; } sr_[2];
#define SLOAD(i, k0) do { sr_[i].vs0 = *reinterpret_cast<const bf16x8*>(&Vh[(long)((k0) + sr) * LDK + sc]); sr_[i].vs1 = *reinterpret_cast<const bf16x8*>(&Vh[(long)((k0) + 32 + sr) * LDK + sc]); \
    sr_[i].ks0 = *reinterpret_cast<const bf16x8*>(&Kh[(long)((k0) + sr) * LDK + sc]); sr_[i].ks1 = *reinterpret_cast<const bf16x8*>(&Kh[(long)((k0) + 32 + sr) * LDK + sc]); } while (0)
#define SWRITE(b, i) do { *(bf16x8*)((char*)V_lds + (b) * SHM_V + vst0) = sr_[i].vs0;          \
    *(bf16x8*)((char*)V_lds + (b) * SHM_V + vst1) = sr_[i].vs1; int kc = sc * 2;               \
    *(bf16x8*)((char*)K_lds + (b) * SHM_K + KSWZ(sr, kc)) = sr_[i].ks0;                       \
    *(bf16x8*)((char*)K_lds + (b) * SHM_K + KSWZ(32 + sr, kc)) = sr_[i].ks1; } while (0)
#define SWAIT() asm volatile("s_waitcnt vmcnt(4)" ::: "memory")
#define RESC(a) do { if (__any((a) < 1.f)) { if (hi == 0) al_l[r32] = (a); asm volatile("s_waitcnt lgkmcnt(0)" ::: "memory"); \
    for (int d = 0; d < 4; ++d) for (int r = 0; r < 16; ++r) o[d][r] *= al_l[crow(r, hi)]; } } while (0)
    f32x16 pA0, pA1, pB0, pB1; float mnA, mnB, alA, alB; bf16x8 pa0, pa1, pa2, pa3; const int NT = seq / KVBLK;
    constexpr int SE = 0, SO = 1;
    SLOAD(SE, 0); asm volatile("s_waitcnt vmcnt(0)" ::: "memory"); SWRITE(0, SE); __syncthreads();
    qkt(pA0, pA1, K_lds, qr, r32, hi); partialSM(pA0, pA1, m_reg, mnA, alA);
    SLOAD(SO, KVBLK); if (2 < NT) SLOAD(SE, 2 * KVBLK);
    SWAIT(); SWRITE(1, SO); __syncthreads();
    for (int j = 1; j + 1 < NT; j += 2) {
        SBAR(); qkt(pB0, pB1, (bf16_t*)((char*)K_lds + SHM_K), qr, r32, hi);
        finishSM(pA0, pA1, alA, l_reg, pa0, pa1, pa2, pa3); SBAR();
        SLOAD(SO, (j + 2) * KVBLK); SBAR();
        pv_d0(o, vb0, pa0, pa1, pa2, pa3); partialSM(pB0, pB1, m_reg, mnB, alB);
        __syncthreads(); SWAIT(); SWRITE(0, SE);
        RESC(alB); __syncthreads();
        SBAR(); qkt(pA0, pA1, K_lds, qr, r32, hi);
        finishSM(pB0, pB1, alB, l_reg, pa0, pa1, pa2, pa3); SBAR();
        if (j + 3 < NT) SLOAD(SE, (j + 3) * KVBLK); SBAR();
        pv_d0(o, vb0 + (int)SHM_V, pa0, pa1, pa2, pa3); partialSM(pA0, pA1, m_reg, mnA, alA);
        __syncthreads(); SWAIT(); SWRITE(1, SO);
        RESC(alA); __syncthreads();
    }
    SBAR(); qkt(pB0, pB1, (bf16_t*)((char*)K_lds + SHM_K), qr, r32, hi);
    finishSM(pA0, pA1, alA, l_reg, pa0, pa1, pa2, pa3); SBAR();
    pv_d0(o, vb0, pa0, pa1, pa2, pa3); partialSM(pB0, pB1, m_reg, mnB, alB);
    __syncthreads(); RESC(alB);
    finishSM(pB0, pB1, alB, l_reg, pa0, pa1, pa2, pa3); SBAR();
    pv_d0(o, vb0 + (int)SHM_V, pa0, pa1, pa2, pa3);
    { const int tid2 = opaque_tid(wave_id), lane2 = tid2 & 63, r32b = lane2 & 31, hib = lane2 >> 5;
      float* li2 = (float*)(lds + 2 * SHM_V + 2 * SHM_K) + wave_id * 64;
      if (hib == 0) li2[r32b] = l_reg; asm volatile("s_waitcnt lgkmcnt(0)" ::: "memory");
      float rli[16];
#pragma unroll
      for (int r = 0; r < 16; ++r) rli[r] = __builtin_amdgcn_rcpf(li2[crow(r, hib)]);
      bf16_t* Ow = Ob + (long)(wave_id * QBLK) * LDO;
#pragma unroll
      for (int r = 0; r < 16; ++r) { int orow = crow(r, hib);
          for (int d0 = 0; d0 < 4; ++d0) Ow[(long)orow * LDO + d0 * 32 + r32b] = f2bf(o[d0][r] * rli[r]); } }
    __syncthreads();
#undef SLOAD
#undef SWRITE
#undef SWAIT
#undef RESC
}
}

struct S5In { const float *lre, *lim, *ldt, *bre, *bim, *cre, *cim, *dsk; };
__device__ __forceinline__ void s5_naive_wave(const S5In& P, const bf16_t* __restrict__ Ucat, const bf16_t* __restrict__ Uctx, float* __restrict__ Ytmp, bf16_t* __restrict__ SSM, int n, int g, int b) {
    const float dskip = P.dsk[g * PG + (n & 15)];
    for (int dir = 0; dir < 2; ++dir) {
        const int dg = dir * NG + g;
        const float dt = expf(P.ldt[dg]), lr = P.lre[dg * NS + n], li = P.lim[dg * NS + n];
        const float mag = expf(lr * dt), ang = li * dt, are = mag * cosf(ang), aim = mag * sinf(ang);
        const float den = lr * lr + li * li, nr = are - 1.f, ni = aim, fre = (nr * lr + ni * li) / den, fim = (ni * lr - nr * li) / den;
        float bbr[PG], bbi[PG], cr[PG], ci[PG];
#pragma unroll
        for (int p = 0; p < PG; ++p) { const float br = P.bre[((size_t)dg * NS + n) * PG + p], bi = P.bim[((size_t)dg * NS + n) * PG + p];
            bbr[p] = fre * br - fim * bi; bbi[p] = fre * bi + fim * br; cr[p] = P.cre[((size_t)dg * PG + p) * NS + n]; ci[p] = P.cim[((size_t)dg * PG + p) * NS + n]; }
        float sre = 0.f, sim = 0.f;
        for (int i = 0; i < LC; ++i) { const int tc = dir == 0 ? i : LC - 1 - i;
            const bf16_t* upc = Ucat + ucat_ctx_idx(b, tc, g * PG); const bf16x8 u0 = *(const bf16x8*)upc, u1 = *(const bf16x8*)(upc + 8);
            float bur = 0.f, bui = 0.f;
#pragma unroll
            for (int p = 0; p < 8; ++p) { const float ua = bf2f((bf16_t)u0[p]), ub = bf2f((bf16_t)u1[p]); bur += bbr[p] * ua + bbr[p + 8] * ub; bui += bbi[p] * ua + bbi[p + 8] * ub; }
            const float nre = are * sre - aim * sim + bur, nim = are * sim + aim * sre + bui; sre = nre; sim = nim; }
        for (int i = 0; i < SEQ; ++i) { const int t = dir == 0 ? i : SEQ - 1 - i;
            const bf16_t* up = Ucat + ucat_idx(b, t, g * PG);
            const bf16x8 u0 = *(const bf16x8*)up, u1 = *(const bf16x8*)(up + 8);
            float uu[PG]; float bur = 0.f, bui = 0.f;
#pragma unroll
            for (int p = 0; p < 8; ++p) { uu[p] = bf2f((bf16_t)u0[p]); uu[p + 8] = bf2f((bf16_t)u1[p]); }
#pragma unroll
            for (int p = 0; p < PG; ++p) { bur += bbr[p] * uu[p]; bui += bbi[p] * uu[p]; }
            const float nre = are * sre - aim * sim + bur, nim = are * sim + aim * sre + bui; sre = nre; sim = nim;
            float mine = 0.f, myu = 0.f;
#pragma unroll
            for (int p = 0; p < PG; ++p) { const float y = wave_sum(cr[p] * sre - ci[p] * sim); if (n == p) { mine = y; myu = uu[p]; } }
            if (n < PG) { const size_t oi = ((size_t)(b * SEQ + t)) * 512 + g * PG + n;
                if (dir == 0) Ytmp[oi] = myu * dskip + mine;
                else SSM[oi] = f2bf(gelu_tanh(Ytmp[oi] + mine)); }
        }
    }
}

#include <hip/hip_cooperative_groups.h>
namespace cg = cooperative_groups;
#define LAS __attribute__((address_space(3)))
#define GAS __attribute__((address_space(1)))

namespace pg8 {
constexpr int BM = 256, BK = 64, HALF = 128, HTB = HALF * BK * 2, STAGE_BYTES = 8 * HTB, NXCD = 8, WGM = 8;
__host__ __device__ __forceinline__ int lds_byte(int r, int c) { const int st = (r >> 4) * 2 + (c >> 5), rr = r & 15, cc = c & 31, ob = rr * 64 + cc * 2; return st * 1024 + (ob ^ (((ob >> 9) & 1) << 5)); }
__host__ __device__ __forceinline__ void stage_rc(int b, int& R, int& C) { const int st = b / 1024, sb = b % 1024, swz = sb ^ (((sb >> 9) & 1) << 5); R = (st >> 1) * 16 + swz / 64; C = (st & 1) * 32 + (swz % 64) / 2; }
__host__ __device__ __forceinline__ int perm32(int rho) { const int n = rho >> 4, i = rho & 15; return 8 * (i >> 2) + 4 * n + (i & 3); }
struct Unit { int pm, pn, grp; };
struct Gemm { const bf16_t* A; const bf16_t* Bt; int lda, ldb, K; size_t a_grp, b_grp; int amode; };
struct StaticOrder {
    int nM, nN, nwg, G, c;
    __device__ __forceinline__ void init(int nM_, int nN_, int G_, int c_) { nM = nM_; nN = nN_; nwg = nM * nN; G = G_; c = c_; }
    __device__ __forceinline__ bool next(int i, Unit& u) const {
        const long L = (long)i * G + c; if (L >= nwg) return false;
        int wgid = (int)L; { const int q = nwg / NXCD, r = nwg % NXCD, xcd = wgid % NXCD, off = wgid / NXCD; wgid = (xcd < r ? xcd * (q + 1) : r * (q + 1) + (xcd - r) * q) + off; }
        const int nig = WGM * nN, gid = wgid / nig, fm = gid * WGM, gsz = (nM - fm) < WGM ? (nM - fm) : WGM;
        u.pm = fm + ((wgid % nig) % gsz); u.pn = (wgid % nig) / gsz; u.grp = 0; return true;
    }
};
__device__ __forceinline__ unsigned cvt_pk_bf16(float lo, float hi) { unsigned r; asm volatile("v_cvt_pk_bf16_f32 %0, %1, %2" : "=v"(r) : "v"(lo), "v"(hi)); return r; }
#define EPI_ROWS_BF16(ROWPTR, BJSTRIDE, XF) do { \
    _Pragma("unroll") for (int ai = 0; ai < 2; ++ai) _Pragma("unroll") for (int m = 0; m < 4; ++m) { const int row = row0 + ai * HALF + m * 16; bf16_t* rp = (ROWPTR); \
        _Pragma("unroll") for (int bj = 0; bj < 2; ++bj) { f32x4 v0 = acc[ai][bj][m][0], v1 = acc[ai][bj][m][1]; \
            _Pragma("unroll") for (int j = 0; j < 4; ++j) { v0[j] = XF(v0[j]); v1[j] = XF(v1[j]); } \
            u32x4 w; w.x = cvt_pk_bf16(v0[0], v0[1]); w.y = cvt_pk_bf16(v0[2], v0[3]); w.z = cvt_pk_bf16(v1[0], v1[1]); w.w = cvt_pk_bf16(v1[2], v1[3]); \
            *(u32x4*)(rp + (size_t)bj * (BJSTRIDE)) = w; } } } while (0)
template <class Epi, class Sched, bool ALIGN_EPI = true, bool SP2 = true>
__device__ __forceinline__ void gemm_phase(LAS unsigned char* lds, const Gemm g, const Sched& S, const Epi& E, int wave_id) {
    const int tid = opaque_tid(wave_id), wid = __builtin_amdgcn_readfirstlane(tid >> 6), lane = tid & 63, wr = wid >> 2, wc = wid & 3, fr = lane & 15, fq = lane >> 4;
    const int K = g.K, nt = K / BK;
    unsigned voffA[2], voffB[2];
#pragma unroll
    for (int i = 0; i < 2; ++i) { int R, C; stage_rc(tid * 16 + i * 8192, R, C); const int Rb = Epi::PERM ? ((R & ~31) + perm32(R & 31)) : R;
        voffA[i] = g.amode == 1 ? (unsigned)((((C >> 4) * 1024 + (R >> 5)) * 512 + (R & 31) * 16 + (C & 15)) * 2) : (unsigned)(R * g.lda + C) * 2u; voffB[i] = (unsigned)(Rb * g.ldb + C) * 2u; }
    const size_t kstep = (size_t)(BK * 2), kstepA = g.amode == 1 ? (size_t)4 * 1024 * 512 * 2 : kstep;
    const size_t hstepA = g.amode == 1 ? (size_t)4 * 512 * 2 : (size_t)HALF * g.lda * 2, hstepB = (size_t)HALF * g.ldb * 2;
    const size_t tstepA = 2 * hstepA, tstepB = 2 * hstepB;
    const unsigned ldsw = (unsigned)wid * 1024u;
    const int aoff = lds_byte(wr * 64 + fr, fq * 8), boff = lds_byte(wc * 32 + fr, fq * 8);
#define PG8_SA(b, h) (((b) * 2 + (h)) * HTB)
#define PG8_SB(b, h) ((4 + (b) * 2 + (h)) * HTB)
#define PG8_STAGE(bufoff, gbase, voff) do { _Pragma("unroll") for (int _i = 0; _i < 2; ++_i) \
        __builtin_amdgcn_global_load_lds((const unsigned*)((const char*)(gbase) + (voff)[_i]), (LAS unsigned*)(lds + (bufoff) + ldsw + _i * 8192), 16, 0, 0); } while (0)
#define PG8_LDA(dst, b, h) do { _Pragma("unroll") for (int m = 0; m < 4; ++m) _Pragma("unroll") for (int k = 0; k < 2; ++k) dst[m][k] = *(const LAS bf16x8*)(lds + PG8_SA(b, h) + aoff + m * 2048 + k * 1024); } while (0)
#define PG8_LDB(dst, b, h) do { _Pragma("unroll") for (int n = 0; n < 2; ++n) _Pragma("unroll") for (int k = 0; k < 2; ++k) dst[n][k] = *(const LAS bf16x8*)(lds + PG8_SB(b, h) + boff + n * 2048 + k * 1024); } while (0)
#define PG8_MMA(ai, bj, At, Bt) do { __builtin_amdgcn_s_setprio(1); _Pragma("unroll") for (int m = 0; m < 4; ++m) _Pragma("unroll") for (int n = 0; n < 2; ++n) _Pragma("unroll") for (int k = 0; k < 2; ++k) \
        acc[ai][bj][m][n] = __builtin_amdgcn_mfma_f32_16x16x32_bf16(Bt[n][k], At[m][k], acc[ai][bj][m][n], 0, 0, 0); __builtin_amdgcn_s_setprio(0); } while (0)
#define PG8_WAIT_V(n) asm volatile("s_waitcnt vmcnt(" #n ")" ::: "memory")
#define PG8_WAIT_L(n) asm volatile("s_waitcnt lgkmcnt(" #n ")" ::: "memory")
#define PG8_BAR __builtin_amdgcn_s_barrier()
#define PG8_SCHED __builtin_amdgcn_sched_barrier(0)
    Unit cur, nxt; int ui = 0;
    if (!S.next(0, cur)) return;
    f32x4 acc[2][2][4][2];
#pragma unroll
    for (int a = 0; a < 2; ++a)
#pragma unroll
        for (int b = 0; b < 2; ++b)
#pragma unroll
            for (int m = 0; m < 4; ++m)
#pragma unroll
                for (int n = 0; n < 2; ++n) acc[a][b][m][n] = (f32x4){0.f, 0.f, 0.f, 0.f};
    bf16x8 At[4][2], B0[2][2], B1[2][2];
    const char* cA = (const char*)g.A + (size_t)cur.grp * g.a_grp + (size_t)cur.pm * tstepA; const char* cB = (const char*)g.Bt + (size_t)cur.grp * g.b_grp + (size_t)cur.pn * tstepB;
    typename Epi::Pre pre = E.pre(cur, wid, lane);
    if constexpr (SP2) {
        PG8_STAGE(PG8_SB(0, 0), cB, voffB); PG8_STAGE(PG8_SB(0, 1), cB + hstepB, voffB); PG8_STAGE(PG8_SA(0, 0), cA, voffA); PG8_STAGE(PG8_SA(0, 1), cA + hstepA, voffA);
        if (wr == 1) PG8_BAR;
        PG8_WAIT_V(2); PG8_BAR;
        PG8_STAGE(PG8_SB(1, 0), cB + kstep, voffB); PG8_STAGE(PG8_SA(1, 0), cA + kstepA, voffA); PG8_STAGE(PG8_SB(1, 1), cB + hstepB + kstep, voffB);
        PG8_WAIT_V(6); PG8_BAR;
    } else {
        PG8_STAGE(PG8_SB(0, 0), cB, voffB); PG8_STAGE(PG8_SA(0, 0), cA, voffA); PG8_STAGE(PG8_SB(0, 1), cB + hstepB, voffB); PG8_STAGE(PG8_SA(0, 1), cA + hstepA, voffA);
        if (wr == 1) PG8_BAR;
        PG8_WAIT_V(4); PG8_BAR;
        PG8_STAGE(PG8_SB(1, 0), cB + kstep, voffB); PG8_STAGE(PG8_SA(1, 0), cA + kstepA, voffA); PG8_STAGE(PG8_SB(1, 1), cB + hstepB + kstep, voffB);
        PG8_WAIT_V(6); PG8_BAR;
    }
    for (;;) {
        const bool has_next = S.next(ui + 1, nxt);
        const char* nA = has_next ? (const char*)g.A + (size_t)nxt.grp * g.a_grp + (size_t)nxt.pm * tstepA : cA; const char* nB = has_next ? (const char*)g.Bt + (size_t)nxt.grp * g.b_grp + (size_t)nxt.pn * tstepB : cB;
        for (int t = 0; t < nt; t += 2) {
            const bool last = (t == nt - 2);
            const char* a1 = cA + (size_t)(t + 1) * kstepA;
            const char* a2 = last ? nA : cA + (size_t)(t + 2) * kstepA; const char* b2 = last ? nB : cB + (size_t)(t + 2) * kstep;
            const char* a3 = a2 + kstepA; const char* b3 = b2 + kstep;
            if constexpr (SP2) {
            PG8_LDB(B0, 0, 0); PG8_LDB(B1, 0, 1); PG8_SCHED; PG8_LDA(At, 0, 0); PG8_STAGE(PG8_SA(1, 1), a1 + hstepA, voffA);
            PG8_WAIT_V(8); PG8_WAIT_L(0); PG8_BAR; PG8_MMA(0, 0, At, B0); PG8_MMA(0, 1, At, B1); PG8_BAR; PG8_SCHED;
            PG8_LDA(At, 0, 1); PG8_STAGE(PG8_SB(0, 0), b2, voffB); PG8_STAGE(PG8_SB(0, 1), b2 + hstepB, voffB); PG8_STAGE(PG8_SA(0, 0), a2, voffA);
            PG8_WAIT_V(8); PG8_WAIT_L(0); PG8_BAR; PG8_MMA(1, 0, At, B0); PG8_MMA(1, 1, At, B1); PG8_BAR; PG8_SCHED;
            PG8_LDB(B0, 1, 0); PG8_LDB(B1, 1, 1); PG8_SCHED; PG8_LDA(At, 1, 0); PG8_STAGE(PG8_SA(0, 1), a2 + hstepA, voffA);
            PG8_WAIT_V(8); PG8_WAIT_L(0); PG8_BAR; PG8_MMA(0, 0, At, B0); PG8_MMA(0, 1, At, B1); PG8_BAR; PG8_SCHED;
            PG8_LDA(At, 1, 1); PG8_STAGE(PG8_SB(1, 0), b3, voffB); PG8_STAGE(PG8_SB(1, 1), b3 + hstepB, voffB); PG8_STAGE(PG8_SA(1, 0), a3, voffA);
            PG8_WAIT_V(8); PG8_WAIT_L(0); PG8_BAR; PG8_MMA(1, 0, At, B0); PG8_MMA(1, 1, At, B1); PG8_BAR; PG8_SCHED;
            } else {
            PG8_LDB(B0, 0, 0); PG8_SCHED; PG8_LDA(At, 0, 0); PG8_STAGE(PG8_SA(1, 1), a1 + hstepA, voffA);
            PG8_WAIT_L(8); PG8_BAR; PG8_WAIT_L(0); PG8_MMA(0, 0, At, B0); PG8_BAR; PG8_SCHED;
            PG8_LDB(B1, 0, 1); PG8_STAGE(PG8_SB(0, 0), b2, voffB);
            PG8_BAR; PG8_WAIT_L(0); PG8_MMA(0, 1, At, B1); PG8_BAR;
            PG8_LDA(At, 0, 1); PG8_STAGE(PG8_SA(0, 0), a2, voffA);
            PG8_BAR; PG8_WAIT_L(0); PG8_MMA(1, 0, At, B0); PG8_BAR; PG8_SCHED;
            PG8_STAGE(PG8_SB(0, 1), b2 + hstepB, voffB);
            PG8_WAIT_V(6); PG8_BAR; PG8_MMA(1, 1, At, B1); PG8_BAR;
            PG8_LDB(B0, 1, 0); PG8_SCHED; PG8_LDA(At, 1, 0); PG8_STAGE(PG8_SA(0, 1), a2 + hstepA, voffA);
            PG8_WAIT_L(8); PG8_BAR; PG8_WAIT_L(0); PG8_MMA(0, 0, At, B0); PG8_BAR; PG8_SCHED;
            PG8_LDB(B1, 1, 1); PG8_STAGE(PG8_SB(1, 0), b3, voffB);
            PG8_BAR; PG8_WAIT_L(0); PG8_MMA(0, 1, At, B1); PG8_BAR;
            PG8_LDA(At, 1, 1); PG8_STAGE(PG8_SA(1, 0), a3, voffA);
            PG8_BAR; PG8_WAIT_L(0); PG8_MMA(1, 0, At, B0); PG8_BAR; PG8_SCHED;
            PG8_STAGE(PG8_SB(1, 1), b3 + hstepB, voffB);
            PG8_WAIT_V(6); PG8_BAR; PG8_MMA(1, 1, At, B1); PG8_BAR;
            }
        }
        if constexpr (ALIGN_EPI) { if (wr == 0) PG8_BAR; }
        E(acc, cur, wr, wc, fr, fq, pre);
        if (!has_next) break;
#pragma unroll
        for (int a = 0; a < 2; ++a)
#pragma unroll
            for (int b = 0; b < 2; ++b)
#pragma unroll
                for (int m = 0; m < 4; ++m)
#pragma unroll
                    for (int n = 0; n < 2; ++n) acc[a][b][m][n] = (f32x4){0.f, 0.f, 0.f, 0.f};
        cur = nxt; cA = nA; cB = nB; ++ui;
        pre = E.pre(cur, wid, lane);
        if constexpr (ALIGN_EPI) { if (wr == 1) PG8_BAR; }
    }
    PG8_WAIT_V(0);
    if constexpr (!ALIGN_EPI) { if (wr == 0) PG8_BAR; }
    PG8_BAR;
#undef PG8_SA
#undef PG8_SB
#undef PG8_STAGE
#undef PG8_LDA
#undef PG8_LDB
#undef PG8_MMA
#undef PG8_WAIT_V
#undef PG8_WAIT_L
#undef PG8_BAR
#undef PG8_SCHED
}
}

#define XB_TMO      128
#define XB_XCNT(j)  (256  + 64 * (j))
#define XB_XSUB(j)  (1280 + 64 * (j))
#define XB_XGEN(j)  (2304 + 64 * (j))
#define XB_TOP      3328
#define XB_TOPGEN   3392
#define XCD_BAR_WORDS 3456
#define XB_SPIN_CAP (1u << 18)
__device__ __forceinline__ unsigned xb_ld(unsigned* p)              { return __hip_atomic_load(p, __ATOMIC_RELAXED, __HIP_MEMORY_SCOPE_AGENT); }
__device__ __forceinline__ unsigned xb_add(unsigned* p, unsigned v) { return __hip_atomic_fetch_add(p, v, __ATOMIC_RELAXED, __HIP_MEMORY_SCOPE_AGENT); }
__device__ __forceinline__ unsigned xb_xcc_id() { return (unsigned)__builtin_amdgcn_s_getreg((3 << 11) | 20) & 0xFu; }
#define XB_SPIN(cond, bar) do { unsigned _sp = 0; while (cond) { __builtin_amdgcn_s_sleep(1); \
    if ((++_sp & 255u) == 0u) { if (xb_ld(&(bar)[XB_TMO])) break; if (_sp > XB_SPIN_CAP) { atomicAdd(&(bar)[XB_TMO], 1u); break; } } } } while (0)
struct XcdBarrier { unsigned* bar; unsigned x; volatile LAS unsigned* st; };
__device__ __forceinline__ XcdBarrier xcd_barrier_post(unsigned* bar, volatile LAS unsigned* st) {
    XcdBarrier b; b.bar = bar; b.x = xb_xcc_id(); b.st = st;
    if (threadIdx.x == 0) (void)xb_add(&bar[XB_XCNT(b.x)], 1u);
    return b;
}
__device__ __forceinline__ void xcd_barrier_complete(unsigned* bar, unsigned x, unsigned& nloc, unsigned& nx) {
    const unsigned G = gridDim.x * gridDim.y * gridDim.z;
    unsigned sum, cnt, mine, sp = 0u;
    for (;;) {
        sum = 0u; cnt = 0u; mine = 0u;
#pragma unroll
        for (unsigned j = 0; j < 16; ++j) { const unsigned c = xb_ld(&bar[XB_XCNT(j)]); sum += c; cnt += (c > 0u) ? 1u : 0u; mine = (j == x) ? c : mine; }
        if (sum == G) break;
        __builtin_amdgcn_s_sleep(1);
        if ((++sp & 255u) == 0u) { if (xb_ld(&bar[XB_TMO])) break; if (sp > XB_SPIN_CAP) { atomicAdd(&bar[XB_TMO], 1u); break; } }
    }
    nloc = mine > 0u ? mine : 1u; nx = cnt > 0u ? cnt : 1u;
}
__device__ __forceinline__ void xcd_barrier(const XcdBarrier& b) {
    asm volatile("s_waitcnt vmcnt(0)" ::: "memory");
    __syncthreads();
    if (threadIdx.x == 0) {
        unsigned* bar = b.bar;
        __builtin_amdgcn_s_waitcnt(0);
        unsigned nloc = b.st[0], nx = b.st[1];
        if (nloc == 0u) { xcd_barrier_complete(bar, b.x, nloc, nx); b.st[0] = nloc; b.st[1] = nx; }
        const unsigned old = xb_add(&bar[XB_XSUB(b.x)], 1u);
        const unsigned gen = old / nloc;
        if (old + 1u == (gen + 1u) * nloc) {
            __builtin_amdgcn_fence(__ATOMIC_RELEASE, "agent");
            asm volatile("s_waitcnt vmcnt(0)" ::: "memory");
            const unsigned og = xb_add(&bar[XB_TOP], 1u);
            const unsigned tg = og / nx;
            if (og + 1u == (tg + 1u) * nx) xb_add(&bar[XB_TOPGEN], 1u);
            else XB_SPIN(xb_ld(&bar[XB_TOPGEN]) == tg, bar);
            __builtin_amdgcn_fence(__ATOMIC_ACQUIRE, "agent");
            xb_add(&bar[XB_XGEN(b.x)], 1u);
            asm volatile("s_waitcnt vmcnt(0)" ::: "memory");
        } else {
            XB_SPIN(xb_ld(&bar[XB_XGEN(b.x)]) == gen, bar);
            __builtin_amdgcn_fence(__ATOMIC_ACQUIRE, "agent");
            asm volatile("s_waitcnt vmcnt(0)" ::: "memory");
        }
    }
    __syncthreads();
}

constexpr int MK_LDS = 147456;
constexpr int NWV = 8;
#ifndef MK_HI
#define MK_HI 16
#endif
#ifndef S5_NAIVE
#define S5_NAIVE 0
#endif
#ifndef USE_XBAR
#define USE_XBAR 1
#endif
#ifndef REPMASK
#define REPMASK 0x0
#endif
#define REPS(k) for (int rep_ = 0; rep_ <= ((REPMASK >> (k)) & 1); ++rep_)
struct MkArgs { const float* in[27]; float* out; unsigned char* ws; int ph_lo, ph_hi; };

__device__ __forceinline__ unsigned pk2(float lo, float hi) { return (unsigned)f2bf(lo) | ((unsigned)f2bf(hi) << 16); }
template <int MAP> __device__ __forceinline__ void transpose_item(const float* __restrict__ W, int K, int N, bf16_t* __restrict__ WT, LAS float* scr, int item, int lane) {
    const int nblk = N / 32, kb = item / nblk, nb = item % nblk, k0 = 64 * kb, n0 = 32 * nb;
#pragma unroll 8
    for (int i = 0; i < 32; ++i) { const int kk = 2 * i + (lane >> 5); scr[kk * 33 + (lane & 31)] = W[(size_t)(k0 + kk) * N + n0 + (lane & 31)]; }
    asm volatile("s_waitcnt lgkmcnt(0)" ::: "memory");
    const int c = lane & 7;
#pragma unroll
    for (int j = 0; j < 4; ++j) { const int n = (lane >> 3) + 8 * j; const LAS float* s = scr + (8 * c) * 33 + n;
        u32x4 o; o.x = pk2(s[0 * 33], s[1 * 33]); o.y = pk2(s[2 * 33], s[3 * 33]); o.z = pk2(s[4 * 33], s[5 * 33]); o.w = pk2(s[6 * 33], s[7 * 33]);
        int dr = n0 + n; if (MAP == 1) { const int cc = dr >= DFF ? dr - DFF : dr; dr = (cc >> 7) * 256 + (dr >= DFF ? 128 : 0) + (cc & 127); }
        if (MAP == 2) { const int cc = dr & 1023; dr = (cc >> 7) * 256 + (dr >= 1024 ? 128 : 0) + (cc & 127); }
        *(u32x4*)(WT + (size_t)dr * K + k0 + 8 * c) = o; }
    asm volatile("s_waitcnt lgkmcnt(0)" ::: "memory");
}
__device__ __forceinline__ void norm_mod_rows4(const float* __restrict__ src, const float* __restrict__ w, const float* __restrict__ sh, const float* __restrict__ sc, bf16_t* __restrict__ dst, int lane) {
    f32x4 v[4][4]; float ss[4];
#pragma unroll
    for (int r = 0; r < 4; ++r)
#pragma unroll
        for (int j = 0; j < 4; ++j) v[r][j] = *(const f32x4*)(src + (size_t)r * DM + j * 256 + lane * 4);
#pragma unroll
    for (int r = 0; r < 4; ++r) { float s = 0.f;
#pragma unroll
        for (int j = 0; j < 4; ++j) s += (v[r][j][0] * v[r][j][0] + v[r][j][1] * v[r][j][1]) + (v[r][j][2] * v[r][j][2] + v[r][j][3] * v[r][j][3]);
        ss[r] = s; }
#pragma unroll
    for (int o = 1; o < 64; o <<= 1) {
#pragma unroll
        for (int r = 0; r < 4; ++r) ss[r] += __shfl_xor(ss[r], o); }
#pragma unroll
    for (int r = 0; r < 4; ++r) ss[r] = rsqrtf(ss[r] * (1.f / DM) + EPS);
#pragma unroll
    for (int j = 0; j < 4; ++j) { const int k = j * 256 + lane * 4; const f32x4 ww = *(const f32x4*)(w + k), s1 = *(const f32x4*)(sc + k) + 1.f, s0 = *(const f32x4*)(sh + k);
#pragma unroll
        for (int r = 0; r < 4; ++r) { const f32x4 y = (v[r][j] * ss[r] * ww) * s1 + s0; u32x2 o; o.x = pk2(y[0], y[1]); o.y = pk2(y[2], y[3]); *(u32x2*)(dst + (size_t)r * DM + k) = o; } }
}
struct NoPre {};
#define EPI_NOPRE typedef NoPre Pre; __device__ __forceinline__ Pre pre(const pg8::Unit&, int, int) const { return Pre{}; }
__device__ __forceinline__ float xf_id(float v) { return v; }
struct EpiAfast {
    static constexpr bool PERM = true;
    EPI_NOPRE
    bf16_t *Q, *Kb, *Vb, *Ucat, *SG; const float *qnw, *knw; LAS float* SS;
    __device__ __forceinline__ void operator()(const f32x4 (&acc)[2][2][4][2], const pg8::Unit& u, int wr, int wc, int fr, int fq, const Pre& pre_) const {
        using namespace pg8;
        const int row0 = u.pm * BM + wr * 64 + fr, cl = wc * 32 + 8 * fq;
        const bool lat = u.pm < ML / 256;
        if (u.pn < 5) {
            const bool isq = u.pn < 4; const float* nw = isq ? qnw : knw;
#pragma unroll
            for (int ai = 0; ai < 2; ++ai)
#pragma unroll
                for (int m = 0; m < 4; ++m)
#pragma unroll
                    for (int bj = 0; bj < 2; ++bj) { const f32x4 v0 = acc[ai][bj][m][0], v1 = acc[ai][bj][m][1];
                        float s = (v0[0] * v0[0] + v0[1] * v0[1]) + (v0[2] * v0[2] + v0[3] * v0[3]) + (v1[0] * v1[0] + v1[1] * v1[1]) + (v1[2] * v1[2] + v1[3] * v1[3]);
                        s += __shfl_xor(s, 16); s += __shfl_xor(s, 32);
                        if (fq == 0) SS[((ai * HALF + wr * 64 + m * 16 + fr) * 2 + bj) * 4 + wc] = s; }
            asm volatile("s_waitcnt lgkmcnt(0)" ::: "memory"); __builtin_amdgcn_s_barrier(); asm volatile("" ::: "memory");
            const f32x4 w0 = *(const f32x4*)(nw + cl), w1 = *(const f32x4*)(nw + cl + 4);
            float invf[4];
#pragma unroll
            for (int e = 0; e < 4; ++e) invf[e] = exp2f(-(float)(2 * (((cl >> 1) + e) & 31)) * (13.287712379549449f / 64.f));
#pragma unroll
            for (int ai = 0; ai < 2; ++ai)
#pragma unroll
                for (int m = 0; m < 4; ++m) { const int row = row0 + ai * HALF + m * 16;
                    float cs[4], sn[4];
                    if (lat) { const int t = row % SEQ; const float coord = (wc < 2) ? (float)(t >> 6) : (float)(t & 63);
#pragma unroll
                        for (int e = 0; e < 4; ++e) { const float ang = coord * invf[e]; cs[e] = __cosf(ang); sn[e] = __sinf(ang); } }
                    else {
#pragma unroll
                        for (int e = 0; e < 4; ++e) { cs[e] = 1.f; sn[e] = 0.f; } }
                    bf16_t* rp = isq ? Q + (size_t)row * 1024 + u.pn * 256 + cl
                                     : Kb + ((size_t)(lat ? (row / SEQ) * LKV + LC + (row % SEQ) : ((row - ML) / LC) * LKV + ((row - ML) % LC))) * 256 + cl;
#pragma unroll
                    for (int bj = 0; bj < 2; ++bj) {
                        const f32x4 p = *(const LAS f32x4*)(SS + ((ai * HALF + wr * 64 + m * 16 + fr) * 2 + bj) * 4);
                        const float rs = rsqrtf(((p[0] + p[1]) + (p[2] + p[3])) * (1.f / 128.f) + EPS);
                        const f32x4 y0 = acc[ai][bj][m][0] * rs * w0, y1 = acc[ai][bj][m][1] * rs * w1;
                        u32x4 w; w.x = cvt_pk_bf16(y0[0] * cs[0] - y0[1] * sn[0], y0[0] * sn[0] + y0[1] * cs[0]); w.y = cvt_pk_bf16(y0[2] * cs[1] - y0[3] * sn[1], y0[2] * sn[1] + y0[3] * cs[1]);
                        w.z = cvt_pk_bf16(y1[0] * cs[2] - y1[1] * sn[2], y1[0] * sn[2] + y1[1] * cs[2]); w.w = cvt_pk_bf16(y1[2] * cs[3] - y1[3] * sn[3], y1[2] * sn[3] + y1[3] * cs[3]);
                        *(u32x4*)(rp + bj * 128) = w; } }
        }
        else if (u.pn == 5) {
            EPI_ROWS_BF16(Vb + ((size_t)(lat ? (row / SEQ) * LKV + LC + (row % SEQ) : ((row - ML) / LC) * LKV + ((row - ML) % LC))) * 256 + cl, 128, xf_id); }
        else if (u.pn < 8) { const int ch0 = (u.pn - 6) * 256 + cl;
            if (lat) { EPI_ROWS_BF16(Ucat + ucat_idx(row / SEQ, row % SEQ, ch0), (size_t)8 * UROWS * KCAT, xf_id); }
            else { EPI_ROWS_BF16(Ucat + ucat_ctx_idx((row - ML) / LC, (row - ML) % LC, ch0), (size_t)8 * UROWS * KCAT, xf_id); } }
        else { EPI_ROWS_BF16(SG + (size_t)row * 2048 + (u.pn - 8) * 256 + cl, 128, sigmoidf_); }
    }
};
struct EpiStoreFast {
    static constexpr bool PERM = true; bf16_t* O; int ldo;
    EPI_NOPRE
    __device__ __forceinline__ void operator()(const f32x4 (&acc)[2][2][4][2], const pg8::Unit& u, int wr, int wc, int fr, int fq, const Pre& pre_) const {
        using namespace pg8; const int row0 = u.pm * BM + wr * 64 + fr, cl = u.pn * BM + wc * 32 + 8 * fq;
        EPI_ROWS_BF16(O + (size_t)row * ldo + cl, 128, xf_id);
    }
};
__device__ __forceinline__ void unpack8(const u32x4 w, float (&f)[8]) {
    f[0] = __uint_as_float(w.x << 16); f[1] = __uint_as_float(w.x & 0xffff0000u); f[2] = __uint_as_float(w.y << 16); f[3] = __uint_as_float(w.y & 0xffff0000u);
    f[4] = __uint_as_float(w.z << 16); f[5] = __uint_as_float(w.z & 0xffff0000u); f[6] = __uint_as_float(w.w << 16); f[7] = __uint_as_float(w.w & 0xffff0000u);
}
struct EpiGluPair {
    static constexpr bool PERM = true; const bf16_t* SG; bf16_t* PS;
    EPI_NOPRE
    __device__ __forceinline__ void operator()(const f32x4 (&acc)[2][2][4][2], const pg8::Unit& u, int wr, int wc, int fr, int fq, const Pre& pre_) const {
        using namespace pg8; const int row0 = u.pm * BM + wr * 64 + fr, c0 = u.pn * 128 + wc * 32 + 8 * fq;
#pragma unroll
        for (int ai = 0; ai < 2; ++ai)
#pragma unroll
            for (int m = 0; m < 4; ++m) { const int row = row0 + ai * HALF + m * 16; float gs[8], r[8];
                unpack8(*(const u32x4*)(SG + (size_t)row * 2048 + 1024 + c0), gs);
#pragma unroll
                for (int j = 0; j < 8; ++j) { const float av = (j < 4) ? acc[ai][0][m][0][j & 3] : acc[ai][0][m][1][j & 3], bv = (j < 4) ? acc[ai][1][m][0][j & 3] : acc[ai][1][m][1][j & 3]; r[j] = gs[j] * av * sigmoidf_(bv); }
                u32x4 w; w.x = cvt_pk_bf16(r[0], r[1]); w.y = cvt_pk_bf16(r[2], r[3]); w.z = cvt_pk_bf16(r[4], r[5]); w.w = cvt_pk_bf16(r[6], r[7]);
                *(u32x4*)(PS + (size_t)row * 1024 + c0) = w; }
    }
};
struct EpiMergeFast {
    static constexpr bool PERM = true; const bf16_t *SG, *GLU; bf16_t* MG;
    EPI_NOPRE
    __device__ __forceinline__ void operator()(const f32x4 (&acc)[2][2][4][2], const pg8::Unit& u, int wr, int wc, int fr, int fq, const Pre& pre_) const {
        using namespace pg8; const int row0 = u.pm * BM + wr * 64 + fr, cl = u.pn * BM + wc * 32 + 8 * fq;
#pragma unroll
        for (int ai = 0; ai < 2; ++ai)
#pragma unroll
            for (int m = 0; m < 4; ++m) { const int row = row0 + ai * HALF + m * 16;
#pragma unroll
                for (int bj = 0; bj < 2; ++bj) { const size_t o2 = (size_t)row * 2048 + cl + bj * 128;
                    float ga[8], ps[8], r[8];
                    unpack8(*(const u32x4*)(SG + o2), ga); unpack8(*(const u32x4*)(GLU + (size_t)row * 1024 + cl + bj * 128), ps);
#pragma unroll
                    for (int j = 0; j < 8; ++j) { const float v = (j < 4) ? acc[ai][bj][m][0][j & 3] : acc[ai][bj][m][1][j & 3]; r[j] = ga[j] * v + ps[j]; }
                    u32x4 w; w.x = cvt_pk_bf16(r[0], r[1]); w.y = cvt_pk_bf16(r[2], r[3]); w.z = cvt_pk_bf16(r[4], r[5]); w.w = cvt_pk_bf16(r[6], r[7]);
                    *(u32x4*)(MG + (size_t)row * 1024 + cl + bj * 128) = w; } }
    }
};
struct EpiResidFast {
    static constexpr bool PERM = false; const float* base; float* out; const float* gate;
    EPI_NOPRE
    __device__ __forceinline__ void operator()(const f32x4 (&acc)[2][2][4][2], const pg8::Unit& u, int wr, int wc, int fr, int fq, const Pre& pre_) const {
        using namespace pg8; const int row0 = u.pm * BM + wr * 64 + fr, col0 = u.pn * BM + wc * 32 + 4 * fq;
        const float* gp = gate + (size_t)((u.pm * BM) / SEQ) * 6144 + col0;
        f32x4 gv[2][2];
#pragma unroll
        for (int bj = 0; bj < 2; ++bj)
#pragma unroll
            for (int n = 0; n < 2; ++n) gv[bj][n] = *(const f32x4*)(gp + bj * HALF + n * 16);
#pragma unroll
        for (int ai = 0; ai < 2; ++ai)
#pragma unroll
            for (int m = 0; m < 4; ++m) { const size_t off = (size_t)(row0 + ai * HALF + m * 16) * 1024 + col0;
#pragma unroll
                for (int bj = 0; bj < 2; ++bj)
#pragma unroll
                    for (int n = 0; n < 2; ++n) { const f32x4 bs = *(const f32x4*)(base + off + bj * HALF + n * 16); *(f32x4*)(out + off + bj * HALF + n * 16) = bs + gv[bj][n] * acc[ai][bj][m][n]; }
                asm volatile("" ::: "memory"); }
    }
};
template <int CTRL> __device__ __forceinline__ float dppf(float x) { return __builtin_bit_cast(float, __builtin_amdgcn_update_dpp(0, __builtin_bit_cast(int, x), CTRL, 0xf, 0xf, false)); }
struct EpiUpConv {
    static constexpr bool PERM = true;
    struct Pre { f32x2 v; };
    __device__ __forceinline__ Pre pre(const pg8::Unit& u, int p, int lane) const { const int c = u.pn * 128 + lane * 2;
        const float* sp = p < 3 ? cw + p * NUP + c : p == 3 ? cb + c : p < 7 ? cw + (p - 4) * NUP + DFF + c : cb + DFF + c; Pre r; r.v = *(const f32x2*)sp; return r; }
    bf16_t* A; float* HALO; const float* cw; const float* cb; LAS float* Bd; LAS float* Pm;
    __device__ __forceinline__ void operator()(const f32x4 (&acc)[2][2][4][2], const pg8::Unit& u, int wr, int wc, int fr, int fq, const Pre& pre_) const {
        using namespace pg8;
        const int x0 = wc * 32 + 8 * fq;
        if (fr == 0) {
#pragma unroll
            for (int ai = 0; ai < 2; ++ai)
#pragma unroll
                for (int bj = 0; bj < 2; ++bj)
#pragma unroll
                    for (int n = 0; n < 2; ++n) *(LAS f32x4*)(Bd + (ai * 4 + wr * 2) * 256 + bj * 128 + x0 + 4 * n) = acc[ai][bj][0][n]; }
        if (fr == 15) {
#pragma unroll
            for (int ai = 0; ai < 2; ++ai)
#pragma unroll
                for (int bj = 0; bj < 2; ++bj)
#pragma unroll
                    for (int n = 0; n < 2; ++n) *(LAS f32x4*)(Bd + (ai * 4 + wr * 2 + 1) * 256 + bj * 128 + x0 + 4 * n) = acc[ai][bj][3][n]; }
        {
          const int p = wr * 4 + wc, xx = (fq * 16 + fr) * 2; Pm[p * 128 + xx] = pre_.v.x; Pm[p * 128 + xx + 1] = pre_.v.y; }
        asm volatile("s_waitcnt lgkmcnt(0)" ::: "memory"); __builtin_amdgcn_s_barrier(); asm volatile("" ::: "memory");
        const int cbase = u.pn * 128 + x0;
        float* hz = HALO + ((size_t)(u.pm * 22 + u.pn) * 4) * 256;
#pragma unroll
        for (int ai = 0; ai < 2; ++ai) {
            const int blk = 2 * ai + wr;
            const LAS float* pbp = Bd + (((blk - 1) >> 1) * 4 + ((blk - 1) & 1) * 2 + 1) * 256 + x0;
            const LAS float* nbp = Bd + (((blk + 1) >> 1) * 4 + ((blk + 1) & 1) * 2) * 256 + x0;
#pragma unroll
            for (int n = 0; n < 2; ++n) {
                const int c = cbase + 4 * n;
                const LAS float* pp = Pm + x0 + 4 * n;
                float o[4][4];
#pragma unroll
                for (int j = 0; j < 4; ++j) {
                    const float w0v = pp[j], w1v = pp[128 + j], w2v = pp[256 + j], bv = pp[384 + j], w0g = pp[512 + j], w1g = pp[640 + j], w2g = pp[768 + j], bg = pp[896 + j];
                    float pbv = 0.f, pbg = 0.f, nbv = 0.f, nbg = 0.f;
                    if (blk > 0) { pbv = pbp[4 * n + j]; pbg = pbp[128 + 4 * n + j]; }
                    if (blk < 3) { nbv = nbp[4 * n + j]; nbg = nbp[128 + 4 * n + j]; }
                    float zv[4], zg[4], rv[4], rg[4], lv[4], lg[4];
#pragma unroll
                    for (int m = 0; m < 4; ++m) { zv[m] = acc[ai][0][m][n][j]; zg[m] = acc[ai][1][m][n][j]; rv[m] = dppf<0x121>(zv[m]); rg[m] = dppf<0x121>(zg[m]); lv[m] = dppf<0x12F>(zv[m]); lg[m] = dppf<0x12F>(zg[m]); }
#pragma unroll
                    for (int m = 0; m < 4; ++m) {
                        const float pv = fr > 0 ? rv[m] : (m > 0 ? rv[m > 0 ? m - 1 : 0] : pbv), pg = fr > 0 ? rg[m] : (m > 0 ? rg[m > 0 ? m - 1 : 0] : pbg);
                        const float nv = fr < 15 ? lv[m] : (m < 3 ? lv[m < 3 ? m + 1 : 3] : nbv), ng = fr < 15 ? lg[m] : (m < 3 ? lg[m < 3 ? m + 1 : 3] : nbg);
                        const float cv = w0v * pv + w1v * zv[m] + w2v * nv + bv, cg = w0g * pg + w1g * zg[m] + w2g * ng + bg;
                        if (m == 0 && blk == 0 && fr == 0) { hz[0 * 256 + x0 + 4 * n + j] = zv[0]; hz[0 * 256 + 128 + x0 + 4 * n + j] = zg[0]; hz[2 * 256 + x0 + 4 * n + j] = cv; hz[2 * 256 + 128 + x0 + 4 * n + j] = cg; }
                        if (m == 3 && blk == 3 && fr == 15) { hz[1 * 256 + x0 + 4 * n + j] = zv[3]; hz[1 * 256 + 128 + x0 + 4 * n + j] = zg[3]; hz[3 * 256 + x0 + 4 * n + j] = cv; hz[3 * 256 + 128 + x0 + 4 * n + j] = cg; }
                        o[m][j] = siluf_(cg) * cv; }
                }
#pragma unroll
                for (int m = 0; m < 4; ++m) { const int row = u.pm * BM + ai * HALF + wr * 64 + m * 16 + fr; u32x2 w; w.x = cvt_pk_bf16(o[m][0], o[m][1]); w.y = cvt_pk_bf16(o[m][2], o[m][3]);
                    *(u32x2*)(A + (size_t)row * DFF + c) = w; }
                asm volatile("" ::: "memory");
            }
        }
    }
};
__device__ __forceinline__ void conv_fix_panel(int pm, const float* __restrict__ HALO, const float* __restrict__ cw, bf16_t* __restrict__ A, int tid) {
#pragma unroll
    for (int rk = 0; rk < 2; ++rk) {
        if (rk == 0 ? (pm & 7) == 0 : (pm & 7) == 7) continue;
        const int nb = rk == 0 ? pm - 1 : pm + 1;
        for (int c = tid; c < DFF; c += NWV * 64) { const int pn = c >> 7, x = c & 127;
            const float* hp = HALO + ((size_t)(pm * 22 + pn) * 4 + 2 + rk) * 256; const float* hn = HALO + ((size_t)(nb * 22 + pn) * 4 + (rk == 0 ? 1 : 0)) * 256;
            const float wv = cw[(rk == 0 ? 0 : 2) * NUP + c], wg = cw[(rk == 0 ? 0 : 2) * NUP + DFF + c];
            const float val = hp[x] + wv * hn[x], gate = hp[128 + x] + wg * hn[128 + x];
            A[(size_t)(pm * 256 + (rk == 0 ? 0 : 255)) * DFF + c] = f2bf(siluf_(gate) * val); }
    }
}
__device__ __forceinline__ int sidx(int d, int ri, int n) { return d * 128 + ri * 64 + n; }
__device__ __forceinline__ void s5_tables_block(const S5In& P, int g, int qr, bf16_t* __restrict__ W1, bf16_t* __restrict__ B3, float* __restrict__ A32, LAS unsigned char* lds, int tid) {
    LAS float* BBs = (LAS float*)lds;
    LAS float* PWs = BBs + 4096;
    LAS float* CCs = PWs + 66 * 130;
    LAS float* KT = CCs + 32 * 130;
    if (tid < 128) {
        const int d = tid >> 6, n = tid & 63, dg = d * NG + g;
        const float dt = expf(P.ldt[dg]), lr = P.lre[dg * NS + n], li = P.lim[dg * NS + n];
        const float mag = expf(lr * dt), ang = li * dt, are = mag * cosf(ang), aim = mag * sinf(ang);
        const float den = lr * lr + li * li, nr = are - 1.f, ni = aim, fre = (nr * lr + ni * li) / den, fim = (ni * lr - nr * li) / den;
#pragma unroll
        for (int q = 0; q < PG; ++q) { const float br = P.bre[((size_t)dg * NS + n) * PG + q], bi = P.bim[((size_t)dg * NS + n) * PG + q];
            BBs[((d * 64 + n) * 16 + q) * 2] = fre * br - fim * bi; BBs[((d * 64 + n) * 16 + q) * 2 + 1] = fre * bi + fim * br; }
        double pr = 1.0, pi = 0.0; const double ar = (double)are, ai = (double)aim;
        for (int k = 0; k <= 32; ++k) { PWs[(d * 33 + k) * 130 + n * 2] = (float)pr; PWs[(d * 33 + k) * 130 + n * 2 + 1] = (float)pi; const double t0 = pr * ar - pi * ai, t1 = pr * ai + pi * ar; pr = t0; pi = t1; }
        if (qr == 0) { A32[(dg * NS + n) * 2] = PWs[(d * 33 + 32) * 130 + n * 2]; A32[(dg * NS + n) * 2 + 1] = PWs[(d * 33 + 32) * 130 + n * 2 + 1]; }
    }
    for (int i = tid; i < 2048; i += 512) { const int d = i >> 10, p = (i >> 6) & 15, n = i & 63; CCs[(i >> 6) * 130 + (i & 63) * 2] = P.cre[((size_t)(d * NG + g) * PG + p) * NS + n]; CCs[(i >> 6) * 130 + (i & 63) * 2 + 1] = P.cim[((size_t)(d * NG + g) * PG + p) * NS + n]; }
    __syncthreads();
    REPS(22) { const int d = tid >> 8, lagA = (tid >> 4) & 15, p = tid & 15; float accA[16], accB[16];
#pragma unroll
        for (int q = 0; q < 16; ++q) { accA[q] = 0.f; accB[q] = 0.f; }
        const LAS float* cp = CCs + (d * 16 + p) * 130; const LAS float* pa = PWs + (d * 33 + lagA) * 130; const LAS float* pb = PWs + (d * 33 + lagA + 16) * 130;
#pragma unroll 2
        for (int n = 0; n < 64; ++n) { const float cr = cp[2 * n], ci = cp[2 * n + 1], par = pa[2 * n], pai = pa[2 * n + 1], pbr = pb[2 * n], pbi = pb[2 * n + 1];
            const float xr = cr * par - ci * pai, xi = cr * pai + ci * par, yr = cr * pbr - ci * pbi, yi = cr * pbi + ci * pbr; const LAS float* bb = BBs + ((d * 64 + n) * 16) * 2;
#pragma unroll
            for (int q = 0; q < 16; ++q) { const float br = bb[2 * q], bi = bb[2 * q + 1]; accA[q] += xr * br - xi * bi; accB[q] += yr * br - yi * bi; } }
#pragma unroll
        for (int q = 0; q < 16; ++q) { KT[(d * 32 + lagA) * 260 + p * 16 + q] = accA[q]; KT[(d * 32 + lagA + 16) * 260 + p * 16 + q] = accB[q]; } }
    __syncthreads();
    for (int ch = tid; ch < 128 * 96; ch += 512) { const int r = ch / 96, cc = ch % 96, j = qr * 8 + (r >> 4), p = r & 15; float v[8];
        if (cc < 64) { const int i = cc >> 1, q0 = (cc & 1) * 8, lag = j - i;
#pragma unroll
            for (int e = 0; e < 8; ++e) { const int q = q0 + e; float x;
                if (lag > 0) x = KT[lag * 260 + p * 16 + q]; else if (lag < 0) x = KT[(32 - lag) * 260 + p * 16 + q];
                else x = KT[p * 16 + q] + KT[32 * 260 + p * 16 + q] + (q == p ? P.dsk[g * PG + p] : 0.f);
                v[e] = x; } }
        else { const int s0 = (cc - 64) * 8, d = s0 >> 7, ri = (s0 >> 6) & 1, n0 = s0 & 63, k = d == 0 ? j + 1 : 32 - j;
#pragma unroll
            for (int e = 0; e < 8; ++e) { const int n = n0 + e; const float cr = CCs[(d * 16 + p) * 130 + n * 2], ci = CCs[(d * 16 + p) * 130 + n * 2 + 1], pr = PWs[(d * 33 + k) * 130 + n * 2], pi = PWs[(d * 33 + k) * 130 + n * 2 + 1];
                v[e] = ri == 0 ? (cr * pr - ci * pi) : -(cr * pi + ci * pr); } }
        u32x4 w; w.x = pk2(v[0], v[1]); w.y = pk2(v[2], v[3]); w.z = pk2(v[4], v[5]); w.w = pk2(v[6], v[7]);
        *(u32x4*)(B3 + ((size_t)(g * 512 + j * 16 + p)) * KCAT + cc * 8) = w; }
    { const int d = qr >> 1, ri = qr & 1;
      for (int ch = tid; ch < 64 * 64; ch += 512) { const int n = ch >> 6, cc = ch & 63, i = cc >> 1, q0 = (cc & 1) * 8, k = d == 0 ? 31 - i : i; float v[8];
          const float pr = PWs[(d * 33 + k) * 130 + n * 2], pi = PWs[(d * 33 + k) * 130 + n * 2 + 1];
#pragma unroll
          for (int e = 0; e < 8; ++e) { const float br = BBs[((d * 64 + n) * 16 + q0 + e) * 2], bi = BBs[((d * 64 + n) * 16 + q0 + e) * 2 + 1]; v[e] = ri == 0 ? (pr * br - pi * bi) : (pr * bi + pi * br); }
          u32x4 w; w.x = pk2(v[0], v[1]); w.y = pk2(v[2], v[3]); w.z = pk2(v[4], v[5]); w.w = pk2(v[6], v[7]);
          *(u32x4*)(W1 + ((size_t)(g * 256 + qr * 64 + n)) * 512 + cc * 8) = w; } }
    __syncthreads();
}
struct EpiS1 {
    static constexpr bool PERM = false; float* L;
    EPI_NOPRE
    __device__ __forceinline__ void operator()(const f32x4 (&acc)[2][2][4][2], const pg8::Unit& u, int wr, int wc, int fr, int fq, const Pre& pre_) const {
        using namespace pg8; const int row0 = u.pm * BM + wr * 64 + fr, col0 = wc * 32 + 4 * fq;
#pragma unroll
        for (int ai = 0; ai < 2; ++ai)
#pragma unroll
            for (int m = 0; m < 4; ++m) { float* rp = L + ((size_t)u.grp * UROWS + row0 + ai * HALF + m * 16) * 256 + col0;
#pragma unroll
                for (int bj = 0; bj < 2; ++bj)
#pragma unroll
                    for (int n = 0; n < 2; ++n) *(f32x4*)(rp + bj * HALF + n * 16) = acc[ai][bj][m][n]; }
    }
};
struct EpiS3 {
    static constexpr bool PERM = true; bf16_t* SSM;
    EPI_NOPRE
    __device__ __forceinline__ void operator()(const f32x4 (&acc)[2][2][4][2], const pg8::Unit& u, int wr, int wc, int fr, int fq, const Pre& pre_) const {
        using namespace pg8; const int row0 = u.pm * BM + wr * 64 + fr, cl = u.pn * BM + wc * 32 + 8 * fq;
        EPI_ROWS_BF16(SSM + ((size_t)(u.grp * 1024 + row)) * 512 + cl, 128, gelu_tanh);
    }
};
struct OrderS1 { int G, c; __device__ __forceinline__ bool next(int i, pg8::Unit& u) const { const int L = i * G + c; if (L >= NG * 5) return false; u.grp = L / 5; u.pm = L % 5; u.pn = 0; return true; } };
struct OrderOne { pg8::Unit u0; __device__ __forceinline__ bool next(int i, pg8::Unit& u) const { if (i != 0) return false; u = u0; return true; } };
template <int MODE> struct EpiResNorm {
    static constexpr bool PERM = false;
    EPI_NOPRE
    const float* base; float* out; const float* gate; const float* fw; unsigned* xs; unsigned* cnt; LAS float* P;
    bf16_t* H2; const float* sh; const float* sc;
    __device__ __forceinline__ void operator()(f32x4 (&acc)[2][2][4][2], const pg8::Unit& u, int wr, int wc, int fr, int fq, const Pre& pre_) const {
        using namespace pg8; const int row0 = u.pm * BM + wr * 64 + fr, col0 = u.pn * BM + wc * 32 + 4 * fq;
        const int wid = wr * 4 + wc, lane = fq * 16 + fr;
        { const float* gp = gate + (size_t)((u.pm * BM) / SEQ) * 6144 + col0; f32x4 gv[2][2];
#pragma unroll
          for (int bj = 0; bj < 2; ++bj)
#pragma unroll
              for (int n = 0; n < 2; ++n) gv[bj][n] = *(const f32x4*)(gp + bj * HALF + n * 16);
#pragma unroll
          for (int ai = 0; ai < 2; ++ai)
#pragma unroll
              for (int m = 0; m < 4; ++m) { const size_t off = (size_t)(row0 + ai * HALF + m * 16) * 1024 + col0; float s = 0.f;
#pragma unroll
                  for (int bj = 0; bj < 2; ++bj)
#pragma unroll
                      for (int n = 0; n < 2; ++n) { const f32x4 x = *(const f32x4*)(base + off + bj * HALF + n * 16) + gv[bj][n] * acc[ai][bj][m][n]; acc[ai][bj][m][n] = x; s += (x[0] * x[0] + x[1] * x[1]) + (x[2] * x[2] + x[3] * x[3]);
                          if (MODE == 1) *(f32x4*)(out + off + bj * HALF + n * 16) = x; }
                  s += __shfl_xor(s, 16); s += __shfl_xor(s, 32);
                  if (fq == 0) P[(ai * HALF + wr * 64 + m * 16 + fr) * 4 + wc] = s; } }
        asm volatile("s_waitcnt lgkmcnt(0)" ::: "memory"); __builtin_amdgcn_s_barrier(); asm volatile("" ::: "memory");
        const int prow = wid * 32 + (lane & 31);
        if (lane < 32) { const f32x4 p = *(const LAS f32x4*)(P + prow * 4);
            __hip_atomic_store(xs + ((size_t)(u.pm * BM + prow)) * 4 + u.pn, __float_as_uint((p[0] + p[1]) + (p[2] + p[3])), __ATOMIC_RELAXED, __HIP_MEMORY_SCOPE_AGENT); }
        asm volatile("s_waitcnt vmcnt(0)" ::: "memory");
        if (lane == 0) __hip_atomic_fetch_add(cnt + 64 * u.pm, 1u, __ATOMIC_RELAXED, __HIP_MEMORY_SCOPE_AGENT);
        if (wid == 0) {
            unsigned spins = 0;
            while ((unsigned)__builtin_amdgcn_readfirstlane(__hip_atomic_load(cnt + 64 * u.pm, __ATOMIC_RELAXED, __HIP_MEMORY_SCOPE_AGENT)) < 32u) { __builtin_amdgcn_s_sleep(2); if (++spins > (1u << 22)) break; }
            __builtin_amdgcn_fence(__ATOMIC_ACQUIRE, "agent");
        }
        asm volatile("s_waitcnt vmcnt(0) lgkmcnt(0)" ::: "memory"); __builtin_amdgcn_s_barrier(); asm volatile("" ::: "memory");
        if (lane < 32) { const unsigned* sl = xs + ((size_t)(u.pm * BM + prow)) * 4; float t = 0.f;
#pragma unroll
            for (int k = 0; k < 4; ++k) t += __uint_as_float(__hip_atomic_load(sl + k, __ATOMIC_RELAXED, __HIP_MEMORY_SCOPE_AGENT));
            P[1024 + prow] = rsqrtf(t * (1.f / DM) + EPS); }
        asm volatile("s_waitcnt lgkmcnt(0)" ::: "memory"); __builtin_amdgcn_s_barrier(); asm volatile("" ::: "memory");
        if (MODE == 0) {
            f32x4 fv[2][2];
#pragma unroll
            for (int bj = 0; bj < 2; ++bj)
#pragma unroll
                for (int n = 0; n < 2; ++n) fv[bj][n] = *(const f32x4*)(fw + col0 + bj * HALF + n * 16);
#pragma unroll
            for (int ai = 0; ai < 2; ++ai)
#pragma unroll
                for (int m = 0; m < 4; ++m) { const int r = ai * HALF + wr * 64 + m * 16 + fr; const float rs = P[1024 + r]; const size_t off = (size_t)(u.pm * BM + r) * 1024 + col0;
#pragma unroll
                    for (int bj = 0; bj < 2; ++bj)
#pragma unroll
                        for (int n = 0; n < 2; ++n) *(f32x4*)(out + off + bj * HALF + n * 16) = acc[ai][bj][m][n] * rs * fv[bj][n]; }
        } else {
            float rsv[2][4];
#pragma unroll
            for (int ai = 0; ai < 2; ++ai)
#pragma unroll
                for (int m = 0; m < 4; ++m) rsv[ai][m] = P[1024 + ai * HALF + wr * 64 + m * 16 + fr];
            const size_t mo = (size_t)((u.pm * BM) / SEQ) * 6144 + col0;
#pragma unroll
            for (int bj = 0; bj < 2; ++bj)
#pragma unroll
                for (int n = 0; n < 2; ++n) { const int cc = bj * HALF + n * 16; const f32x4 ww = *(const f32x4*)(fw + col0 + cc), s1 = *(const f32x4*)(sc + mo + cc) + 1.f, s0 = *(const f32x4*)(sh + mo + cc);
#pragma unroll
                    for (int ai = 0; ai < 2; ++ai)
#pragma unroll
                        for (int m = 0; m < 4; ++m) { const f32x4 y = (acc[ai][bj][m][n] * rsv[ai][m] * ww) * s1 + s0; u32x2 w; w.x = cvt_pk_bf16(y[0], y[1]); w.y = cvt_pk_bf16(y[2], y[3]);
                            *(u32x2*)(H2 + (size_t)(row0 + ai * HALF + m * 16) * 1024 + col0 + cc) = w; }
                    asm volatile("" ::: "memory"); }
        }
    }
};
struct OrderRect { pg8::StaticOrder so; __device__ __forceinline__ bool next(int i, pg8::Unit& u) const { return so.next(i, u); } };
struct OrderA {
    pg8::StaticOrder so;
    __device__ __forceinline__ bool next(int i, pg8::Unit& u) const {
        if (so.next(i, u)) return true;
        const long L = (long)i * so.G + so.c - so.nwg; if (L < 0 || L >= 64) return false;
        u.pm = 128 + (int)(L >> 2); u.pn = 4 + (int)(L & 3); u.grp = 0; return true;
    }
};

__global__ void __launch_bounds__(NWV * 64, 2) mk_fwd(MkArgs a) {
    extern __shared__ __attribute__((aligned(16))) unsigned char lds_raw[];
    LAS unsigned char* lds = (LAS unsigned char*)lds_raw;
#if !USE_XBAR
    cg::grid_group grid = cg::this_grid();
#endif
    const int tid0 = threadIdx.x, wave = __builtin_amdgcn_readfirstlane(tid0 >> 6);
#define PHASE_IDS const int tid = opaque_tid(wave), lane = tid & 63; (void)tid; (void)lane
    const int G = gridDim.x, bx = blockIdx.x;
    const int gw = bx * NWV + wave, NGW = G * NWV;
    unsigned char* ws = a.ws;
#define mod ((float*)(ws + WS_MOD))
#define WTin ((bf16_t*)(ws + WS_WIN))
#define WTbr ((bf16_t*)(ws + WS_WBR))
#define WTglu ((bf16_t*)(ws + WS_WGLU))
#define WTout ((bf16_t*)(ws + WS_WOUT))
#define WTup ((bf16_t*)(ws + WS_WUP))
#define WTdn ((bf16_t*)(ws + WS_WDN))
#define H ((bf16_t*)(ws + WS_H))
#define Q ((bf16_t*)(ws + WS_Q))
#define Kb ((bf16_t*)(ws + WS_K))
#define Vb ((bf16_t*)(ws + WS_V))
#define Ucat ((bf16_t*)(ws + WS_UCAT))
#define Uctx Ucat
#define SG ((bf16_t*)(ws + WS_SG))
#define O ((bf16_t*)(ws + WS_O))
#define SSM ((bf16_t*)(ws + WS_SSM))
#define GLU ((bf16_t*)(ws + WS_GLU))
#define MG ((bf16_t*)(ws + WS_MG))
#define H2 ((bf16_t*)(ws + WS_H2))
#define Ab ((bf16_t*)(ws + WS_A))
#define Ytmp ((float*)(ws + WS_YTMP))
    float* const out = a.out;
    const int lo = a.ph_lo, hi = a.ph_hi;
    volatile LAS unsigned* bst = (volatile LAS unsigned*)(lds + MK_LDS - 16);
    if (tid0 < 2) bst[tid0] = 0u;
    __syncthreads();
    XcdBarrier xbar = xcd_barrier_post((unsigned*)(ws + WS_CTL), bst);
#define IN(k) (lo <= (k) && (k) < hi)
#if USE_XBAR
#define SEAM(k) do { if (IN(k) && IN((k) + 1)) xcd_barrier(xbar); } while (0)
#else
#define SEAM(k) do { if (IN(k) && IN((k) + 1)) grid.sync(); } while (0)
#endif

    if (IN(0)) REPS(0) { PHASE_IDS;
        if (bx < 96) REPS(16) {
            LAS float* sc = (LAS float*)lds;
            LAS float* red = (LAS float*)(lds + 17 * 1024 * 4);
            for (int i = tid; i < 17 * 1024; i += NWV * 64) { const int r = i >> 10, k = i & 1023; sc[i] = siluf_(r < NB ? a.in[1][(size_t)r * DM + k] : a.in[3][k]); }
            __syncthreads();
            const int col = bx * 64 + lane; float acc[17];
#pragma unroll
            for (int r = 0; r < 17; ++r) acc[r] = 0.f;
            const float* wm = a.in[4];
            for (int k = wave * 128; k < wave * 128 + 128; ++k) { const float w = wm[(size_t)k * 6144 + col];
#pragma unroll
                for (int r = 0; r < 17; ++r) acc[r] = fmaf(sc[r * 1024 + k], w, acc[r]); }
#pragma unroll
            for (int r = 0; r < 17; ++r) red[(wave * 17 + r) * 64 + lane] = acc[r];
            __syncthreads();
            for (int i = tid; i < 17 * 64; i += NWV * 64) { const int r = i >> 6, cc = i & 63; float s = a.in[5][bx * 64 + cc];
#pragma unroll
                for (int w = 0; w < 8; ++w) s += red[(w * 17 + r) * 64 + cc];
                mod[(size_t)r * 6144 + bx * 64 + cc] = s; }
            __syncthreads();
        }
        if (bx >= 96 && bx < 96 + 128 || (G < 224 && bx < 96)) {
            S5In s5{a.in[12], a.in[13], a.in[14], a.in[15], a.in[16], a.in[17], a.in[18], a.in[19]};
            const int first = (G >= 224) ? bx - 96 : bx, step = (G >= 224) ? 128 : (G < 96 ? G : 96);
            REPS(17) for (int it = first; it < 128; it += step) s5_tables_block(s5, it >> 2, it & 3, (bf16_t*)((char*)a.out + OUT_W1), (bf16_t*)((char*)a.out + OUT_B3), (float*)(ws + WS_A32), lds, tid);
        }
        LAS float* scr = (LAS float*)(lds + wave * 16384);
        constexpr int I_IN = (DM / 64) * (DIN / 32), I_SQ = (DM / 64) * (DM / 32), I_GLU = (512 / 64) * (2048 / 32), I_UP = (DM / 64) * (NUP / 32), I_DN = (DFF / 64) * (DM / 32);
        constexpr int NITEMS = I_IN + 2 * I_SQ + I_GLU + I_UP + I_DN;
        REPS(18) for (int it = gw; it < NITEMS; it += NGW) {
            int r = it;
            if (r < I_IN) { transpose_item<0>(a.in[8], DM, DIN, WTin, scr, r, lane); continue; } r -= I_IN;
            if (r < I_SQ) { transpose_item<0>(a.in[11], DM, DM, WTbr, scr, r, lane); continue; } r -= I_SQ;
            if (r < I_GLU) { transpose_item<2>(a.in[20], 512, 2048, WTglu, scr, r, lane); continue; } r -= I_GLU;
            if (r < I_SQ) { transpose_item<0>(a.in[21], DM, DM, WTout, scr, r, lane); continue; } r -= I_SQ;
            if (r < I_UP) { transpose_item<1>(a.in[22], DM, NUP, WTup, scr, r, lane); continue; } r -= I_UP;
            transpose_item<0>(a.in[25], DFF, DM, WTdn, scr, r, lane);
        }
    }
    SEAM(0);
    if (IN(1)) REPS(1) { PHASE_IDS;
        for (int L = bx; L < 64; L += G) {
            const int r0 = ML + 256 * (L >> 2);
            for (int r = r0 + 4 * wave; r < r0 + 256; r += 4 * NWV) norm_mod_rows4(a.in[2] + (size_t)(r - ML) * DM, a.in[6], mod + (size_t)NB * 6144, mod + (size_t)NB * 6144 + 1024, H + (size_t)r * DM, lane);
            asm volatile("s_waitcnt vmcnt(0)" ::: "memory"); __syncthreads();
            pg8::Gemm g{H, WTin, DM, DM, DM, 0, 0, 0}; OrderOne S{{128 + (L >> 2), 4 + (L & 3), 0}}; EpiAfast E{Q, Kb, Vb, Ucat, SG, a.in[9], a.in[10], (LAS float*)(lds + 131072)};
            pg8::gemm_phase<EpiAfast, OrderOne>(lds, g, S, E, wave);
        }
        { const int nb = G > 64 ? G - 64 : G, ib = G > 64 ? bx - 64 : bx;
          if (ib >= 0) for (int r = 4 * (ib * NWV + wave); r < ML; r += 4 * nb * NWV) { const int mb = r / SEQ; norm_mod_rows4(a.in[0] + (size_t)r * DM, a.in[6], mod + (size_t)mb * 6144, mod + (size_t)mb * 6144 + 1024, H + (size_t)r * DM, lane); } }
    }
    SEAM(1);
    if (IN(2)) REPS(2) {
        pg8::Gemm g{H, WTin, DM, DM, DM, 0, 0, 0}; OrderRect S; S.so.init(ML / 256, DIN / 256, G, bx);
        EpiAfast E{Q, Kb, Vb, Ucat, SG, a.in[9], a.in[10], (LAS float*)(lds + 131072)};
        pg8::gemm_phase<EpiAfast, OrderRect>(lds, g, S, E, wave);
    }
    SEAM(2);
    if (IN(4)) REPS(4) {
#if !S5_NAIVE
        { pg8::Gemm g{Ucat, (const bf16_t*)((char*)a.out + OUT_W1), KCAT, 512, 512, (size_t)UROWS * KCAT * 2, (size_t)256 * 512 * 2, 0}; OrderS1 S{G, bx}; EpiS1 E{(float*)((char*)a.out + OUT_L)}; pg8::gemm_phase<EpiS1, OrderS1>(lds, g, S, E, wave); }
#endif
        const int nrounds = (NB * 2 * 32 + G - 1) / G;
        for (int i = 0; i < nrounds; ++i) {
            int unit; if (G == 256) { const int bk = i * 8 + (bx & 7), s = bx >> 3; unit = bk * 32 + s; } else unit = i * G + bx;
            if (unit >= NB * 2 * 32) break;
            const int bk = unit >> 5, s = unit & 31, b = bk >> 1, kvh = bk & 1, h = kvh * 4 + (s >> 3), qb = s & 7;
            const size_t q0 = ((size_t)b * SEQ + (size_t)qb * 256) * 1024 + h * 128, k0 = (size_t)b * LKV * 256 + kvh * 128;
            att::attn_dense_body(Q + q0, Kb + k0, Vb + k0, O + q0, LKV, (char*)lds_raw, wave);
        }
    }
    SEAM(4);
    if (IN(5)) REPS(5) { PHASE_IDS;
#if S5_NAIVE
        S5In s5{a.in[12], a.in[13], a.in[14], a.in[15], a.in[16], a.in[17], a.in[18], a.in[19]};
        for (int it = bx * 2 + wave; wave < 2 && it < NB * NG; it += G * 2) s5_naive_wave(s5, Ucat, Uctx, Ytmp, SSM, lane, it & 31, it >> 5);
#else
        const float* Lb = (const float*)((char*)a.out + OUT_L); const float* A32 = (const float*)(ws + WS_A32);
        for (int un = bx; un < 256; un += G) {
            const int g = un >> 3, pm = (un >> 1) & 3, pn = un & 1;
            REPS(19) { const int bl = tid >> 7, d = (tid >> 6) & 1, n = tid & 63, b = pm * 4 + bl;
              const float ar = A32[((d * NG + g) * NS + n) * 2], ai = A32[((d * NG + g) * NS + n) * 2 + 1];
              const float* Lg = Lb + (size_t)g * UROWS * 256 + sidx(d, 0, n); bf16_t* Sg = Ucat + (size_t)g * UROWS * KCAT + 512 + sidx(d, 0, n);
              float sr = 0.f, si = 0.f;
              { float lr[8], li[8];
#pragma unroll
                for (int i = 0; i < 8; ++i) { const int row = 1024 + b * 8 + (d == 0 ? i : 7 - i); lr[i] = Lg[(size_t)row * 256]; li[i] = Lg[(size_t)row * 256 + 64]; }
#pragma unroll
                for (int i = 0; i < 8; ++i) { const float t0 = ar * sr - ai * si + lr[i], t1 = ar * si + ai * sr + li[i]; sr = t0; si = t1; } }
#pragma unroll 1
              for (int i0 = 0; i0 < 64; i0 += 32) { float lr[32], li[32];
#pragma unroll
                  for (int i = 0; i < 32; ++i) { const int row = b * 64 + (d == 0 ? i0 + i : 63 - i0 - i); lr[i] = Lg[(size_t)row * 256]; li[i] = Lg[(size_t)row * 256 + 64]; }
#pragma unroll
                  for (int i = 0; i < 32; ++i) { const int row = b * 64 + (d == 0 ? i0 + i : 63 - i0 - i);
                      Sg[(size_t)row * KCAT] = f2bf(sr); Sg[(size_t)row * KCAT + 64] = f2bf(si);
                      const float t0 = ar * sr - ai * si + lr[i], t1 = ar * si + ai * sr + li[i]; sr = t0; si = t1; } }
              asm volatile("s_waitcnt vmcnt(0)" ::: "memory"); __syncthreads(); }
            pg8::Gemm gm{Ucat, (const bf16_t*)((char*)a.out + OUT_B3), KCAT, KCAT, KCAT, (size_t)UROWS * KCAT * 2, (size_t)512 * KCAT * 2, 0}; OrderOne S{{pm, pn, g}}; EpiS3 E{SSM};
            REPS(20) pg8::gemm_phase<EpiS3, OrderOne>(lds, gm, S, E, wave);
        }
#endif
    }
    SEAM(5);
    if (IN(6)) REPS(6) { pg8::Gemm g{SSM, WTglu, 512, 512, 512, 0, 0, 1}; OrderRect S; S.so.init(ML / 256, 2048 / 256, G, bx); EpiGluPair E{SG, GLU}; pg8::gemm_phase<EpiGluPair, OrderRect>(lds, g, S, E, wave); }
    SEAM(6);
    if (IN(7)) REPS(7) { pg8::Gemm g{O, WTbr, DM, DM, DM, 0, 0, 0}; OrderRect S; S.so.init(ML / 256, DM / 256, G, bx); EpiMergeFast E{SG, GLU, MG}; pg8::gemm_phase<EpiMergeFast, OrderRect>(lds, g, S, E, wave); }
    SEAM(7);
    if (IN(8)) REPS(8) { pg8::Gemm g{MG, WTout, DM, DM, DM, 0, 0, 0}; OrderRect S; S.so.init(ML / 256, DM / 256, G, bx); EpiResNorm<1> E{a.in[0], out, mod + 2048, a.in[7], (unsigned*)(ws + WS_XS2), (unsigned*)(ws + WS_CTL + 65536), (LAS float*)(lds + 131072), H2, mod + 3072, mod + 4096}; pg8::gemm_phase<EpiResNorm<1>, OrderRect>(lds, g, S, E, wave); }
    SEAM(8);
    if (IN(10)) REPS(10) { pg8::Gemm g{H2, WTup, DM, DM, DM, 0, 0, 0}; OrderRect S; S.so.init(ML / 256, NUP / 256, G, bx);
        EpiUpConv E{Ab, (float*)(ws + WS_HALO), a.in[23], a.in[24], (LAS float*)(lds + 131072), (LAS float*)(lds + 131072 + 8192)}; pg8::gemm_phase<EpiUpConv, OrderRect>(lds, g, S, E, wave); }
    SEAM(10);
    if (IN(14)) { PHASE_IDS; pg8::Gemm g{Ab, WTdn, DFF, DFF, DFF, 0, 0, 0}; OrderRect S; S.so.init(ML / 256, DM / 256, G, bx);
        { pg8::Unit u; for (int i = 0; S.next(i, u); ++i) conv_fix_panel(u.pm, (const float*)(ws + WS_HALO), a.in[23], Ab, tid); asm volatile("s_waitcnt vmcnt(0)" ::: "memory"); __syncthreads(); }
        EpiResNorm<0> E{out, out, mod + 5120, a.in[26], (unsigned*)(ws + WS_XS), (unsigned*)(ws + WS_CTL + 16384), (LAS float*)(lds + 131072), nullptr, nullptr, nullptr}; pg8::gemm_phase<EpiResNorm<0>, OrderRect>(lds, g, S, E, wave); }
#undef IN
#undef SEAM
#undef mod
#undef WTin
#undef WTbr
#undef WTglu
#undef WTout
#undef WTup
#undef WTdn
#undef H
#undef Q
#undef Kb
#undef Vb
#undef Ucat
#undef Uctx
#undef SG
#undef O
#undef SSM
#undef GLU
#undef MG
#undef H2
#undef Ab
#undef Ytmp
}

extern "C" void kernel_launch(void* const* d_in, const int* in_sizes, int n_in, void* d_out, int out_size, void* d_ws, size_t ws_size, hipStream_t stream) {
    static int grid_blocks = 0;
    if (grid_blocks == 0) {
        if (n_in != 27 || in_sizes[0] != ML * DM || out_size != ML * DM || ws_size < WS_NEED) {
            fprintf(stderr, "kernel_launch: unexpected shapes: n_in %d in0 %d out %d ws %zu (need >= %zu)\n", n_in, n_in > 0 ? in_sizes[0] : -1, out_size, ws_size, (size_t)WS_NEED); grid_blocks = -1; return; }
        int dev = 0, cus = 0, per_cu = 0;
        if (hipGetDevice(&dev) != hipSuccess || hipDeviceGetAttribute(&cus, hipDeviceAttributeMultiprocessorCount, dev) != hipSuccess) { fprintf(stderr, "kernel_launch: device query failed\n"); grid_blocks = -1; return; }
        if (hipFuncSetAttribute((const void*)mk_fwd, hipFuncAttributeMaxDynamicSharedMemorySize, MK_LDS) != hipSuccess) { fprintf(stderr, "kernel_launch: hipFuncSetAttribute(mk_fwd) failed\n"); grid_blocks = -1; return; }
        if (hipOccupancyMaxActiveBlocksPerMultiprocessor(&per_cu, (const void*)mk_fwd, NWV * 64, MK_LDS) != hipSuccess || per_cu < 1) { fprintf(stderr, "kernel_launch: occupancy query says %d blocks/CU\n", per_cu); grid_blocks = -1; return; }
        grid_blocks = cus;
    }
    if (grid_blocks < 0) return;
    if (hipMemsetAsync((char*)d_ws + WS_CTL, 0, 131072, stream) != hipSuccess) fprintf(stderr, "kernel_launch: memset failed\n");
    MkArgs a{};
    for (int i = 0; i < 27; ++i) a.in[i] = (const float*)d_in[i];
    a.out = (float*)d_out; a.ws = (unsigned char*)d_ws; a.ph_lo = 0; a.ph_hi = 16;
    void* args[] = {&a};
    hipError_t e = hipLaunchCooperativeKernel((const void*)mk_fwd, dim3(grid_blocks), dim3(NWV * 64), args, MK_LDS, stream);
    if (e != hipSuccess) fprintf(stderr, "kernel_launch: cooperative launch failed: %s (grid %d)\n", hipGetErrorString(e), grid_blocks);
}
```

```cpp
#include <hip/hip_runtime.h>
#include <cstdio>
#include <cstdint>

typedef unsigned short bf16_t;
typedef short bf16x8 __attribute__((ext_vector_type(8)));
typedef short s16x4 __attribute__((ext_vector_type(4)));
typedef float f32x4 __attribute__((ext_vector_type(4)));
typedef float f32x16 __attribute__((ext_vector_type(16)));
typedef unsigned u32x4 __attribute__((ext_vector_type(4)));
typedef unsigned u32x2 __attribute__((ext_vector_type(2)));
typedef float f32x2 __attribute__((ext_vector_type(2)));

constexpr int NB = 16, SEQ = 2048, DM = 1024, LC = 256, LKV = LC + SEQ;
constexpr int ML = NB * SEQ, MC = NB * LC, MT = ML + MC;
constexpr int DIN = 4096, DFF = 2816, NUP = 2 * DFF;
constexpr int NG = 32, NS = 64, PG = 16;
constexpr int TCH = 32, NCH = SEQ / TCH, KCAT = TCH * PG + 256;
constexpr int UROWS = 1280;
constexpr float EPS = 1e-6f;

constexpr size_t MiB = 1u << 20;
constexpr size_t WS_CTL = 0, WS_MOD = 1 * MiB;
constexpr size_t WS_WIN = 16 * MiB, WS_WBR = 24 * MiB, WS_WGLU = 26 * MiB, WS_WOUT = 28 * MiB, WS_WUP = 30 * MiB, WS_WDN = 41 * MiB;
constexpr size_t WS_H = 48 * MiB;
constexpr size_t WS_Q = 120 * MiB;
constexpr size_t WS_K = 184 * MiB;
constexpr size_t WS_V = 202 * MiB;
constexpr size_t WS_UCAT = 220 * MiB;
constexpr size_t WS_SG = 280 * MiB;
constexpr size_t WS_O = 408 * MiB;
constexpr size_t WS_SSM = 472 * MiB;
constexpr size_t WS_A32 = 2 * MiB;
constexpr size_t OUT_W1 = 0, OUT_B3 = 8 * MiB, OUT_L = 32 * MiB;
constexpr size_t WS_YTMP = 48 * MiB;
constexpr size_t WS_GLU = 48 * MiB;
constexpr size_t WS_MG = 184 * MiB;
constexpr size_t WS_H2 = 48 * MiB;
constexpr size_t WS_A = 112 * MiB;
constexpr size_t WS_HALO = 288 * MiB;
constexpr size_t WS_XS = 300 * MiB;
constexpr size_t WS_XS2 = 301 * MiB;
constexpr size_t WS_NEED = 512 * MiB;

__device__ __forceinline__ int opaque_tid(int wave) { int t = wave * 64 + (int)__builtin_amdgcn_mbcnt_hi(~0u, __builtin_amdgcn_mbcnt_lo(~0u, 0u)); asm volatile("" : "+v"(t)); return t; }
__device__ __forceinline__ float bf2f(bf16_t v) { return __uint_as_float(((unsigned)v) << 16); }
typedef __bf16 bf16v2_t __attribute__((ext_vector_type(2)));
__device__ __forceinline__ unsigned pk2(float lo, float hi) { const f32x2 v = {lo, hi}; return __builtin_bit_cast(unsigned, __builtin_convertvector(v, bf16v2_t)); }
__device__ __forceinline__ bf16_t f2bf(float f) { return (bf16_t)(pk2(f, f) & 0xffffu); }
__device__ __forceinline__ float sigmoidf_(float x) { return __builtin_amdgcn_rcpf(1.f + __expf(-x)); }
__device__ __forceinline__ float siluf_(float x) { return x * __builtin_amdgcn_rcpf(1.f + __expf(-x)); }
__device__ __forceinline__ float gelu_tanh(float x) { const float u = 0.7978845608028654f * (x + 0.044715f * x * x * x); return x * __builtin_amdgcn_rcpf(1.f + __expf(-2.f * u)); }
__device__ __forceinline__ float wave_sum(float v) {
#pragma unroll
    for (int o = 1; o < 64; o <<= 1) v += __shfl_xor(v, o);
    return v;
}
__device__ __forceinline__ size_t ucat_idx(int b, int t, int ch) { const int g = ch >> 4, q = ch & 15, c = t >> 5, j = t & 31; return ((size_t)(g * UROWS + b * NCH + c)) * KCAT + j * PG + q; }
__device__ __forceinline__ size_t ucat_ctx_idx(int b, int tc, int ch) { const int g = ch >> 4, q = ch & 15, c = tc >> 5, j = tc & 31; return ((size_t)(g * UROWS + 1024 + b * 8 + c)) * KCAT + j * PG + q; }

__device__ __forceinline__ void qk_norm_rope_row(bf16_t* p, const float* __restrict__ w, int pos, int lane) {
    const unsigned raw = *(const unsigned*)(p + 2 * lane);
    const float v0 = bf2f((bf16_t)(raw & 0xffff)), v1 = bf2f((bf16_t)(raw >> 16));
    const float rs = rsqrtf(wave_sum(v0 * v0 + v1 * v1) * (1.f / 128.f) + EPS);
    float y0 = v0 * rs * w[2 * lane], y1 = v1 * rs * w[2 * lane + 1];
    if (pos >= 0) {
        const float coord = (lane < 32) ? (float)(pos >> 6) : (float)(pos & 63);
        const float invf = exp2f(-(float)(2 * (lane & 31)) * (13.287712379549449f / 64.f));
        const float ang = coord * invf; const float cs = cosf(ang), sn = sinf(ang);
        const float o0 = y0 * cs - y1 * sn, o1 = y0 * sn + y1 * cs; y0 = o0; y1 = o1;
    }
    *(unsigned*)(p + 2 * lane) = (unsigned)f2bf(y0) | ((unsigned)f2bf(y1) << 16);
}
namespace att {
constexpr int D = 128, NW = 8, QBLK = 32, KVBLK = 64;
constexpr float SCALE = 0.088388347648318440f;
constexpr float THR = 8.f;
#ifndef ATT_SDEPTH
#define ATT_SDEPTH 1
#endif
constexpr int LDQ = 1024, LDK = 256, LDO = 1024;
constexpr size_t SHM_V = KVBLK * D * 2, SHM_K = KVBLK * D * 2, SHM_ATTN = 2 * SHM_V + 2 * SHM_K + NW * 64 * 4;
#define KSWZ(row, colB) ((row) * 256 + ((colB) ^ (((row) & 7) << 4)))
#define SBAR() __builtin_amdgcn_sched_barrier(0)
__device__ __forceinline__ int crow(int r, int hi) { return (r & 3) + 8 * (r >> 2) + 4 * hi; }
__device__ __forceinline__ unsigned cvtpk(float lo, float hi) { unsigned r; asm volatile("v_cvt_pk_bf16_f32 %0, %1, %2" : "=v"(r) : "v"(lo), "v"(hi)); return r; }
__device__ __forceinline__ void partialSM(f32x16& p0, f32x16& p1, float& m_reg, float& mn, float& alpha) {
    constexpr float C = SCALE * 1.4426950408889634f;
    float pmax = p0[0]; for (int r = 1; r < 16; ++r) pmax = fmaxf(pmax, p0[r]); for (int r = 0; r < 16; ++r) pmax = fmaxf(pmax, p1[r]);
    { auto rr = __builtin_amdgcn_permlane32_swap(__float_as_uint(pmax), __float_as_uint(pmax), false, false);
      pmax = fmaxf(__uint_as_float(rr[0]), __uint_as_float(rr[1])); }
    if (__builtin_expect(__all(pmax - m_reg <= THR / SCALE), 1)) { mn = m_reg; alpha = 1.f; }
    else { mn = fmaxf(m_reg, pmax); alpha = __builtin_amdgcn_exp2f((m_reg - mn) * C); m_reg = mn; }
    float mnC = -mn * C;
    for (int r = 0; r < 16; ++r) p0[r] = fmaf(p0[r], C, mnC); for (int r = 0; r < 16; ++r) p1[r] = fmaf(p1[r], C, mnC);
    for (int r = 0; r < 16; ++r) p0[r] = __builtin_amdgcn_exp2f(p0[r]);
}
__device__ __forceinline__ void finishSM(f32x16& p0, f32x16& p1, float alpha, float& l_reg, bf16x8& pa0, bf16x8& pa1, bf16x8& pa2, bf16x8& pa3) {
    for (int r = 0; r < 16; ++r) p1[r] = __builtin_amdgcn_exp2f(p1[r]);
    float ps = 0; for (int r = 0; r < 16; ++r) ps += p0[r]; for (int r = 0; r < 16; ++r) ps += p1[r];
    { auto rr = __builtin_amdgcn_permlane32_swap(__float_as_uint(ps), __float_as_uint(ps), false, false);
      ps = __uint_as_float(rr[0]) + __uint_as_float(rr[1]); }
    l_reg = l_reg * alpha + ps;
#define PK4(P, BASE, OUT) do { unsigned a0 = cvtpk(P[BASE + 0], P[BASE + 1]), a1 = cvtpk(P[BASE + 2], P[BASE + 3]);   \
    unsigned b0 = cvtpk(P[BASE + 4], P[BASE + 5]), b1 = cvtpk(P[BASE + 6], P[BASE + 7]);                              \
    auto r0 = __builtin_amdgcn_permlane32_swap(a0, b0, false, false); auto r1 = __builtin_amdgcn_permlane32_swap(a1, b1, false, false); \
    u32x4 w = {r0[0], r1[0], r0[1], r1[1]}; OUT = *reinterpret_cast<bf16x8*>(&w); } while (0)
    PK4(p0, 0, pa0); PK4(p0, 8, pa1); PK4(p1, 0, pa2); PK4(p1, 8, pa3);
#undef PK4
}
__device__ __forceinline__ void qkt(f32x16& p0, f32x16& p1, const bf16_t* Ks, const bf16x8* qr, int r32, int hi) {
    p0 = f32x16{}; p1 = f32x16{};
    for (int d0 = 0; d0 < 8; ++d0) { int cb = (d0 * 16 + hi * 8) * 2;
        bf16x8 b0 = *reinterpret_cast<const bf16x8*>((const char*)Ks + KSWZ(r32, cb));
        bf16x8 b1 = *reinterpret_cast<const bf16x8*>((const char*)Ks + KSWZ(32 + r32, cb));
        p0 = __builtin_amdgcn_mfma_f32_32x32x16_bf16(b0, qr[d0], p0, 0, 0, 0);
        p1 = __builtin_amdgcn_mfma_f32_32x32x16_bf16(b1, qr[d0], p1, 0, 0, 0); }
}
__device__ __forceinline__ int v_st(int k, int c) { const int kk = (k & ~0xC) | ((k & 4) << 1) | ((k & 8) >> 1); return ((kk >> 3) * 4 + (c >> 5)) * 512 + ((kk & 7) * 32 + (c & 31)) * 2; }
__device__ __forceinline__ int v_rd_base(int lane) { return ((lane & 3) << 3) | (((lane >> 2) & 3) << 6) | (((lane >> 4) & 1) << 5) | (((lane >> 5) & 1) << 8); }
constexpr int v_rd_off(int d0, int ks, int half) { return d0 * 512 + ks * 4096 + half * 2048; }
template <int OFF> __device__ __forceinline__ s16x4 tr_read(int vb) {
    s16x4 r; asm volatile("ds_read_b64_tr_b16 %0, %1 offset:%2" : "=&v"(r) : "v"(vb), "i"(OFF) : "memory"); return r;
}
template <int D0> __device__ __forceinline__ void pv_one(f32x16& od, int vb, bf16x8 pa0, bf16x8 pa1, bf16x8 pa2, bf16x8 pa3) {
    const s16x4 l0 = tr_read<v_rd_off(D0, 0, 0)>(vb), h0 = tr_read<v_rd_off(D0, 0, 1)>(vb), l1 = tr_read<v_rd_off(D0, 1, 0)>(vb), h1 = tr_read<v_rd_off(D0, 1, 1)>(vb);
    const s16x4 l2 = tr_read<v_rd_off(D0, 2, 0)>(vb), h2 = tr_read<v_rd_off(D0, 2, 1)>(vb), l3 = tr_read<v_rd_off(D0, 3, 0)>(vb), h3 = tr_read<v_rd_off(D0, 3, 1)>(vb);
    asm volatile("s_waitcnt lgkmcnt(0)" ::: "memory"); SBAR();
#define PK(L, H) (bf16x8){L[0], L[1], L[2], L[3], H[0], H[1], H[2], H[3]}
    od = __builtin_amdgcn_mfma_f32_32x32x16_bf16(pa0, PK(l0, h0), od, 0, 0, 0);
    od = __builtin_amdgcn_mfma_f32_32x32x16_bf16(pa1, PK(l1, h1), od, 0, 0, 0);
    od = __builtin_amdgcn_mfma_f32_32x32x16_bf16(pa2, PK(l2, h2), od, 0, 0, 0);
    od = __builtin_amdgcn_mfma_f32_32x32x16_bf16(pa3, PK(l3, h3), od, 0, 0, 0);
#undef PK
}
__device__ __forceinline__ void pv_d0(f32x16* o, int vb, bf16x8 pa0, bf16x8 pa1, bf16x8 pa2, bf16x8 pa3) {
    pv_one<0>(o[0], vb, pa0, pa1, pa2, pa3); pv_one<1>(o[1], vb, pa0, pa1, pa2, pa3); pv_one<2>(o[2], vb, pa0, pa1, pa2, pa3); pv_one<3>(o[3], vb, pa0, pa1, pa2, pa3);
}
__device__ __forceinline__ void attn_dense_body(const bf16_t* __restrict__ Qb, const bf16_t* __restrict__ Kh, const bf16_t* __restrict__ Vh, bf16_t* __restrict__ Ob, int seq, char* lds, int wave_id) {
    const int tid = opaque_tid(wave_id), wid = tid >> 6, lane = tid & 63, r32 = lane & 31, hi = lane >> 5;
    bf16_t* V_lds = (bf16_t*)lds; bf16_t* K_lds = (bf16_t*)(lds + 2 * SHM_V);
    float* ws = (float*)(lds + 2 * SHM_V + 2 * SHM_K) + wid * 64; float* li_l = ws; float* al_l = ws + 32;
    float m_reg = -1e30f, l_reg = 0; f32x16 o[4] = {}; bf16x8 qr[8];
    const bf16_t* Qw = Qb + (long)(wid * QBLK + r32) * LDQ + hi * 8;
#pragma unroll
    for (int d0 = 0; d0 < 8; ++d0) qr[d0] = *reinterpret_cast<const bf16x8*>(Qw + d0 * 16);
    const int sr = tid >> 4, sc = (tid & 15) * 8, vst0 = v_st(sr, sc), vst1 = v_st(32 + sr, sc);
    const int vb0 = (int)(uintptr_t)V_lds + v_rd_base(lane);
    constexpr int SDEPTH = ATT_SDEPTH;
    struct { bf16x8 vs0, vs1, ks0, ks1; } sr_[SDEPTH];
#define SLOAD(i, k0) do { sr_[i].vs0 = *reinterpret_cast<const bf16x8*>(&Vh[(long)((k0) + sr) * LDK + sc]); sr_[i].vs1 = *reinterpret_cast<const bf16x8*>(&Vh[(long)((k0) + 32 + sr) * LDK + sc]); \
    sr_[i].ks0 = *reinterpret_cast<const bf16x8*>(&Kh[(long)((k0) + sr) * LDK + sc]); sr_[i].ks1 = *reinterpret_cast<const bf16x8*>(&Kh[(long)((k0) + 32 + sr) * LDK + sc]); } while (0)
#define SWRITE(b, i) do { *(bf16x8*)((char*)V_lds + (b) * SHM_V + vst0) = sr_[i].vs0;          \
    *(bf16x8*)((char*)V_lds + (b) * SHM_V + vst1) = sr_[i].vs1; int kc = sc * 2;               \
    *(bf16x8*)((char*)K_lds + (b) * SHM_K + KSWZ(sr, kc)) = sr_[i].ks0;                       \
    *(bf16x8*)((char*)K_lds + (b) * SHM_K + KSWZ(32 + sr, kc)) = sr_[i].ks1; } while (0)
#define SWAIT() do { if constexpr (SDEPTH == 2) asm volatile("s_waitcnt vmcnt(4)" ::: "memory"); else asm volatile("s_waitcnt vmcnt(0)" ::: "memory"); } while (0)
#define RESC(a) do { if (__any((a) < 1.f)) { if (hi == 0) al_l[r32] = (a); asm volatile("s_waitcnt lgkmcnt(0)" ::: "memory"); \
    for (int d = 0; d < 4; ++d) for (int r = 0; r < 16; ++r) o[d][r] *= al_l[crow(r, hi)]; } } while (0)
    f32x16 pA0, pA1, pB0, pB1; float mnA, mnB, alA, alB; bf16x8 pa0, pa1, pa2, pa3; const int NT = seq / KVBLK;
    constexpr int SE = 0, SO = SDEPTH - 1;
    SLOAD(SE, 0); asm volatile("s_waitcnt vmcnt(0)" ::: "memory"); SWRITE(0, SE); __syncthreads();
    qkt(pA0, pA1, K_lds, qr, r32, hi); partialSM(pA0, pA1, m_reg, mnA, alA);
    SLOAD(SO, KVBLK); if constexpr (SDEPTH == 2) { if (2 < NT) SLOAD(SE, 2 * KVBLK); }
    SWAIT(); SWRITE(1, SO); __syncthreads();
    for (int j = 1; j + 1 < NT; j += 2) {
        SBAR(); qkt(pB0, pB1, (bf16_t*)((char*)K_lds + SHM_K), qr, r32, hi);
        finishSM(pA0, pA1, alA, l_reg, pa0, pa1, pa2, pa3); SBAR();
        SLOAD(SO, (j + SDEPTH) * KVBLK); SBAR();
        pv_d0(o, vb0, pa0, pa1, pa2, pa3); partialSM(pB0, pB1, m_reg, mnB, alB);
        __syncthreads(); SWAIT(); SWRITE(0, SE);
        RESC(alB); __syncthreads();
        SBAR(); qkt(pA0, pA1, K_lds, qr, r32, hi);
        finishSM(pB0, pB1, alB, l_reg, pa0, pa1, pa2, pa3); SBAR();
        if (SDEPTH == 1 || j + 3 < NT) SLOAD(SE, (j + 1 + SDEPTH) * KVBLK); SBAR();
        pv_d0(o, vb0 + (int)SHM_V, pa0, pa1, pa2, pa3); partialSM(pA0, pA1, m_reg, mnA, alA);
        __syncthreads(); SWAIT(); SWRITE(1, SO);
        RESC(alA); __syncthreads();
    }
    SBAR(); qkt(pB0, pB1, (bf16_t*)((char*)K_lds + SHM_K), qr, r32, hi);
    finishSM(pA0, pA1, alA, l_reg, pa0, pa1, pa2, pa3); SBAR();
    pv_d0(o, vb0, pa0, pa1, pa2, pa3); partialSM(pB0, pB1, m_reg, mnB, alB);
    __syncthreads(); RESC(alB);
    finishSM(pB0, pB1, alB, l_reg, pa0, pa1, pa2, pa3); SBAR();
    pv_d0(o, vb0 + (int)SHM_V, pa0, pa1, pa2, pa3);
    { const int tid2 = opaque_tid(wave_id), lane2 = tid2 & 63, r32b = lane2 & 31, hib = lane2 >> 5;
      float* li2 = (float*)(lds + 2 * SHM_V + 2 * SHM_K) + wave_id * 64;
      if (hib == 0) li2[r32b] = l_reg; asm volatile("s_waitcnt lgkmcnt(0)" ::: "memory");
      float rli[16];
#pragma unroll
      for (int r = 0; r < 16; ++r) rli[r] = __builtin_amdgcn_rcpf(li2[crow(r, hib)]);
      bf16_t* Ow = Ob + (long)(wave_id * QBLK) * LDO;
#pragma unroll
      for (int r = 0; r < 16; ++r) { int orow = crow(r, hib);
          for (int d0 = 0; d0 < 4; ++d0) Ow[(long)orow * LDO + d0 * 32 + r32b] = f2bf(o[d0][r] * rli[r]); } }
    __syncthreads();
#undef SLOAD
#undef SWRITE
#undef SWAIT
#undef RESC
}
}

struct S5In { const float *lre, *lim, *ldt, *bre, *bim, *cre, *cim, *dsk; };
__device__ __forceinline__ void s5_naive_wave(const S5In& P, const bf16_t* __restrict__ Ucat, const bf16_t* __restrict__ Uctx, float* __restrict__ Ytmp, bf16_t* __restrict__ SSM, int n, int g, int b) {
    const float dskip = P.dsk[g * PG + (n & 15)];
    for (int dir = 0; dir < 2; ++dir) {
        const int dg = dir * NG + g;
        const float dt = expf(P.ldt[dg]), lr = P.lre[dg * NS + n], li = P.lim[dg * NS + n];
        const float mag = expf(lr * dt), ang = li * dt, are = mag * cosf(ang), aim = mag * sinf(ang);
        const float den = lr * lr + li * li, nr = are - 1.f, ni = aim, fre = (nr * lr + ni * li) / den, fim = (ni * lr - nr * li) / den;
        float bbr[PG], bbi[PG], cr[PG], ci[PG];
#pragma unroll
        for (int p = 0; p < PG; ++p) { const float br = P.bre[((size_t)dg * NS + n) * PG + p], bi = P.bim[((size_t)dg * NS + n) * PG + p];
            bbr[p] = fre * br - fim * bi; bbi[p] = fre * bi + fim * br; cr[p] = P.cre[((size_t)dg * PG + p) * NS + n]; ci[p] = P.cim[((size_t)dg * PG + p) * NS + n]; }
        float sre = 0.f, sim = 0.f;
        for (int i = 0; i < LC; ++i) { const int tc = dir == 0 ? i : LC - 1 - i;
            const bf16_t* upc = Ucat + ucat_ctx_idx(b, tc, g * PG); const bf16x8 u0 = *(const bf16x8*)upc, u1 = *(const bf16x8*)(upc + 8);
            float bur = 0.f, bui = 0.f;
#pragma unroll
            for (int p = 0; p < 8; ++p) { const float ua = bf2f((bf16_t)u0[p]), ub = bf2f((bf16_t)u1[p]); bur += bbr[p] * ua + bbr[p + 8] * ub; bui += bbi[p] * ua + bbi[p + 8] * ub; }
            const float nre = are * sre - aim * sim + bur, nim = are * sim + aim * sre + bui; sre = nre; sim = nim; }
        for (int i = 0; i < SEQ; ++i) { const int t = dir == 0 ? i : SEQ - 1 - i;
            const bf16_t* up = Ucat + ucat_idx(b, t, g * PG);
            const bf16x8 u0 = *(const bf16x8*)up, u1 = *(const bf16x8*)(up + 8);
            float uu[PG]; float bur = 0.f, bui = 0.f;
#pragma unroll
            for (int p = 0; p < 8; ++p) { uu[p] = bf2f((bf16_t)u0[p]); uu[p + 8] = bf2f((bf16_t)u1[p]); }
#pragma unroll
            for (int p = 0; p < PG; ++p) { bur += bbr[p] * uu[p]; bui += bbi[p] * uu[p]; }
            const float nre = are * sre - aim * sim + bur, nim = are * sim + aim * sre + bui; sre = nre; sim = nim;
            float mine = 0.f, myu = 0.f;
#pragma unroll
            for (int p = 0; p < PG; ++p) { const float y = wave_sum(cr[p] * sre - ci[p] * sim); if (n == p) { mine = y; myu = uu[p]; } }
            if (n < PG) { const size_t oi = ((size_t)(b * SEQ + t)) * 512 + g * PG + n;
                if (dir == 0) Ytmp[oi] = myu * dskip + mine;
                else SSM[oi] = f2bf(gelu_tanh(Ytmp[oi] + mine)); }
        }
    }
}

#include <hip/hip_cooperative_groups.h>
namespace cg = cooperative_groups;
#define LAS __attribute__((address_space(3)))
#define GAS __attribute__((address_space(1)))

namespace pg8 {
constexpr int BM = 256, BK = 64, HALF = 128, HTB = HALF * BK * 2, STAGE_BYTES = 8 * HTB, NXCD = 8, WGM = 8;
__host__ __device__ __forceinline__ int lds_byte(int r, int c) { const int st = (r >> 4) * 2 + (c >> 5), rr = r & 15, cc = c & 31, ob = rr * 64 + cc * 2; return st * 1024 + (ob ^ (((ob >> 9) & 1) << 5)); }
__host__ __device__ __forceinline__ void stage_rc(int b, int& R, int& C) { const int st = b / 1024, sb = b % 1024, swz = sb ^ (((sb >> 9) & 1) << 5); R = (st >> 1) * 16 + swz / 64; C = (st & 1) * 32 + (swz % 64) / 2; }
__host__ __device__ __forceinline__ int perm32(int rho) { const int n = rho >> 4, i = rho & 15; return 8 * (i >> 2) + 4 * n + (i & 3); }
struct Unit { int pm, pn, grp; };
struct Gemm { const bf16_t* A; const bf16_t* Bt; int lda, ldb, K; size_t a_grp, b_grp; int amode; };
struct StaticOrder {
    int nM, nN, nwg, G, c;
    __device__ __forceinline__ void init(int nM_, int nN_, int G_, int c_) { nM = nM_; nN = nN_; nwg = nM * nN; G = G_; c = c_; }
    __device__ __forceinline__ bool next(int i, Unit& u) const {
        const long L = (long)i * G + c; if (L >= nwg) return false;
        int wgid = (int)L; { const int q = nwg / NXCD, r = nwg % NXCD, xcd = wgid % NXCD, off = wgid / NXCD; wgid = (xcd < r ? xcd * (q + 1) : r * (q + 1) + (xcd - r) * q) + off; }
        const int nig = WGM * nN, gid = wgid / nig, fm = gid * WGM, gsz = (nM - fm) < WGM ? (nM - fm) : WGM;
        u.pm = fm + ((wgid % nig) % gsz); u.pn = (wgid % nig) / gsz; u.grp = 0; return true;
    }
};
__device__ __forceinline__ unsigned cvt_pk_bf16(float lo, float hi) { return pk2(lo, hi); }
#define EPI_ROWS_BF16(ROWPTR, BJSTRIDE, XF) do { \
    _Pragma("unroll") for (int ai = 0; ai < 2; ++ai) _Pragma("unroll") for (int m = 0; m < 4; ++m) { const int row = row0 + ai * HALF + m * 16; bf16_t* rp = (ROWPTR); \
        _Pragma("unroll") for (int bj = 0; bj < 2; ++bj) { f32x4 v0 = acc[ai][bj][m][0], v1 = acc[ai][bj][m][1]; \
            _Pragma("unroll") for (int j = 0; j < 4; ++j) { v0[j] = XF(v0[j]); v1[j] = XF(v1[j]); } \
            u32x4 w; w.x = cvt_pk_bf16(v0[0], v0[1]); w.y = cvt_pk_bf16(v0[2], v0[3]); w.z = cvt_pk_bf16(v1[0], v1[1]); w.w = cvt_pk_bf16(v1[2], v1[3]); \
            *(u32x4*)(rp + (size_t)bj * (BJSTRIDE)) = w; } } } while (0)
template <class Epi, class Sched, bool ALIGN_EPI = true, bool SP2 = true>
__device__ __forceinline__ void gemm_phase(LAS unsigned char* lds, const Gemm g, const Sched& S, const Epi& E, int wave_id) {
    const int tid = opaque_tid(wave_id), wid = __builtin_amdgcn_readfirstlane(tid >> 6), lane = tid & 63, wr = wid >> 2, wc = wid & 3, fr = lane & 15, fq = lane >> 4;
    const int K = g.K, nt = K / BK;
    unsigned voffA[2], voffB[2];
#pragma unroll
    for (int i = 0; i < 2; ++i) { int R, C; stage_rc(tid * 16 + i * 8192, R, C); const int Rb = Epi::PERM ? ((R & ~31) + perm32(R & 31)) : R;
        voffA[i] = g.amode == 1 ? (unsigned)((((C >> 4) * 1024 + (R >> 5)) * 512 + (R & 31) * 16 + (C & 15)) * 2) : g.amode == 2 ? (unsigned)((((R & ~63) | (4 * (R & 15) + ((R >> 4) & 3))) * g.lda + C) * 2) : (unsigned)(R * g.lda + C) * 2u; voffB[i] = (unsigned)(Rb * g.ldb + C) * 2u; }
    const size_t kstep = (size_t)(BK * 2), kstepA = g.amode == 1 ? (size_t)4 * 1024 * 512 * 2 : kstep;
    const size_t hstepA = g.amode == 1 ? (size_t)4 * 512 * 2 : (size_t)HALF * g.lda * 2, hstepB = (size_t)HALF * g.ldb * 2;
    const size_t tstepA = 2 * hstepA, tstepB = 2 * hstepB;
    const unsigned ldsw = (unsigned)wid * 1024u;
    const int aoff = lds_byte(wr * 64 + fr, fq * 8), boff = lds_byte(wc * 32 + fr, fq * 8);
#define PG8_SA(b, h) (((b) * 2 + (h)) * HTB)
#define PG8_SB(b, h) ((4 + (b) * 2 + (h)) * HTB)
#define PG8_STAGE(bufoff, gbase, voff) do { _Pragma("unroll") for (int _i = 0; _i < 2; ++_i) \
        __builtin_amdgcn_global_load_lds((const unsigned*)((const char*)(gbase) + (voff)[_i]), (LAS unsigned*)(lds + (bufoff) + ldsw + _i * 8192), 16, 0, 0); } while (0)
#define PG8_LDA(dst, b, h) do { _Pragma("unroll") for (int m = 0; m < 4; ++m) _Pragma("unroll") for (int k = 0; k < 2; ++k) dst[m][k] = *(const LAS bf16x8*)(lds + PG8_SA(b, h) + aoff + m * 2048 + k * 1024); } while (0)
#define PG8_LDB(dst, b, h) do { _Pragma("unroll") for (int n = 0; n < 2; ++n) _Pragma("unroll") for (int k = 0; k < 2; ++k) dst[n][k] = *(const LAS bf16x8*)(lds + PG8_SB(b, h) + boff + n * 2048 + k * 1024); } while (0)
#define PG8_MMA(ai, bj, At, Bt) do { __builtin_amdgcn_s_setprio(1); _Pragma("unroll") for (int m = 0; m < 4; ++m) _Pragma("unroll") for (int n = 0; n < 2; ++n) _Pragma("unroll") for (int k = 0; k < 2; ++k) \
        acc[ai][bj][m][n] = __builtin_amdgcn_mfma_f32_16x16x32_bf16(Bt[n][k], At[m][k], acc[ai][bj][m][n], 0, 0, 0); __builtin_amdgcn_s_setprio(0); } while (0)
#define PG8_WAIT_V(n) asm volatile("s_waitcnt vmcnt(" #n ")" ::: "memory")
#define PG8_WAIT_L(n) asm volatile("s_waitcnt lgkmcnt(" #n ")" ::: "memory")
#define PG8_BAR __builtin_amdgcn_s_barrier()
#define PG8_SCHED __builtin_amdgcn_sched_barrier(0)
    Unit cur, nxt; int ui = 0;
    if (!S.next(0, cur)) return;
    f32x4 acc[2][2][4][2];
#pragma unroll
    for (int a = 0; a < 2; ++a)
#pragma unroll
        for (int b = 0; b < 2; ++b)
#pragma unroll
            for (int m = 0; m < 4; ++m)
#pragma unroll
                for (int n = 0; n < 2; ++n) acc[a][b][m][n] = (f32x4){0.f, 0.f, 0.f, 0.f};
    bf16x8 At[4][2], B0[2][2], B1[2][2];
    const char* cA = (const char*)g.A + (size_t)cur.grp * g.a_grp + (size_t)cur.pm * tstepA; const char* cB = (const char*)g.Bt + (size_t)cur.grp * g.b_grp + (size_t)cur.pn * tstepB;
    typename Epi::Pre pre = E.pre(cur, wid, lane);
    if constexpr (SP2) {
        PG8_STAGE(PG8_SB(0, 0), cB, voffB); PG8_STAGE(PG8_SB(0, 1), cB + hstepB, voffB); PG8_STAGE(PG8_SA(0, 0), cA, voffA); PG8_STAGE(PG8_SA(0, 1), cA + hstepA, voffA);
        if (wr == 1) PG8_BAR;
        PG8_WAIT_V(2); PG8_BAR;
        PG8_STAGE(PG8_SB(1, 0), cB + kstep, voffB); PG8_STAGE(PG8_SA(1, 0), cA + kstepA, voffA); PG8_STAGE(PG8_SB(1, 1), cB + hstepB + kstep, voffB);
        PG8_WAIT_V(6); PG8_BAR;
    } else {
        PG8_STAGE(PG8_SB(0, 0), cB, voffB); PG8_STAGE(PG8_SA(0, 0), cA, voffA); PG8_STAGE(PG8_SB(0, 1), cB + hstepB, voffB); PG8_STAGE(PG8_SA(0, 1), cA + hstepA, voffA);
        if (wr == 1) PG8_BAR;
        PG8_WAIT_V(4); PG8_BAR;
        PG8_STAGE(PG8_SB(1, 0), cB + kstep, voffB); PG8_STAGE(PG8_SA(1, 0), cA + kstepA, voffA); PG8_STAGE(PG8_SB(1, 1), cB + hstepB + kstep, voffB);
        PG8_WAIT_V(6); PG8_BAR;
    }
    for (;;) {
        const bool has_next = S.next(ui + 1, nxt);
        const char* nA = has_next ? (const char*)g.A + (size_t)nxt.grp * g.a_grp + (size_t)nxt.pm * tstepA : cA; const char* nB = has_next ? (const char*)g.Bt + (size_t)nxt.grp * g.b_grp + (size_t)nxt.pn * tstepB : cB;
        for (int t = 0; t < nt; t += 2) {
            const bool last = (t == nt - 2);
            const char* a1 = cA + (size_t)(t + 1) * kstepA;
            const char* a2 = last ? nA : cA + (size_t)(t + 2) * kstepA; const char* b2 = last ? nB : cB + (size_t)(t + 2) * kstep;
            const char* a3 = a2 + kstepA; const char* b3 = b2 + kstep;
            if constexpr (SP2) {
            PG8_LDB(B0, 0, 0); PG8_LDB(B1, 0, 1); PG8_SCHED; PG8_LDA(At, 0, 0); PG8_STAGE(PG8_SA(1, 1), a1 + hstepA, voffA);
            PG8_WAIT_V(8); PG8_WAIT_L(0); PG8_BAR; PG8_MMA(0, 0, At, B0); PG8_MMA(0, 1, At, B1); PG8_BAR; PG8_SCHED;
            PG8_LDA(At, 0, 1); PG8_STAGE(PG8_SB(0, 0), b2, voffB); PG8_STAGE(PG8_SB(0, 1), b2 + hstepB, voffB); PG8_STAGE(PG8_SA(0, 0), a2, voffA);
            PG8_WAIT_V(8); PG8_WAIT_L(0); PG8_BAR; PG8_MMA(1, 0, At, B0); PG8_MMA(1, 1, At, B1); PG8_BAR; PG8_SCHED;
            PG8_LDB(B0, 1, 0); PG8_LDB(B1, 1, 1); PG8_SCHED; PG8_LDA(At, 1, 0); PG8_STAGE(PG8_SA(0, 1), a2 + hstepA, voffA);
            PG8_WAIT_V(8); PG8_WAIT_L(0); PG8_BAR; PG8_MMA(0, 0, At, B0); PG8_MMA(0, 1, At, B1); PG8_BAR; PG8_SCHED;
            PG8_LDA(At, 1, 1); PG8_STAGE(PG8_SB(1, 0), b3, voffB); PG8_STAGE(PG8_SB(1, 1), b3 + hstepB, voffB); PG8_STAGE(PG8_SA(1, 0), a3, voffA);
            PG8_WAIT_V(8); PG8_WAIT_L(0); PG8_BAR; PG8_MMA(1, 0, At, B0); PG8_MMA(1, 1, At, B1); PG8_BAR; PG8_SCHED;
            } else {
            PG8_LDB(B0, 0, 0); PG8_SCHED; PG8_LDA(At, 0, 0); PG8_STAGE(PG8_SA(1, 1), a1 + hstepA, voffA);
            PG8_WAIT_L(8); PG8_BAR; PG8_WAIT_L(0); PG8_MMA(0, 0, At, B0); PG8_BAR; PG8_SCHED;
            PG8_LDB(B1, 0, 1); PG8_STAGE(PG8_SB(0, 0), b2, voffB);
            PG8_BAR; PG8_WAIT_L(0); PG8_MMA(0, 1, At, B1); PG8_BAR;
            PG8_LDA(At, 0, 1); PG8_STAGE(PG8_SA(0, 0), a2, voffA);
            PG8_BAR; PG8_WAIT_L(0); PG8_MMA(1, 0, At, B0); PG8_BAR; PG8_SCHED;
            PG8_STAGE(PG8_SB(0, 1), b2 + hstepB, voffB);
            PG8_WAIT_V(6); PG8_BAR; PG8_MMA(1, 1, At, B1); PG8_BAR;
            PG8_LDB(B0, 1, 0); PG8_SCHED; PG8_LDA(At, 1, 0); PG8_STAGE(PG8_SA(0, 1), a2 + hstepA, voffA);
            PG8_WAIT_L(8); PG8_BAR; PG8_WAIT_L(0); PG8_MMA(0, 0, At, B0); PG8_BAR; PG8_SCHED;
            PG8_LDB(B1, 1, 1); PG8_STAGE(PG8_SB(1, 0), b3, voffB);
            PG8_BAR; PG8_WAIT_L(0); PG8_MMA(0, 1, At, B1); PG8_BAR;
            PG8_LDA(At, 1, 1); PG8_STAGE(PG8_SA(1, 0), a3, voffA);
            PG8_BAR; PG8_WAIT_L(0); PG8_MMA(1, 0, At, B0); PG8_BAR; PG8_SCHED;
            PG8_STAGE(PG8_SB(1, 1), b3 + hstepB, voffB);
            PG8_WAIT_V(6); PG8_BAR; PG8_MMA(1, 1, At, B1); PG8_BAR;
            }
        }
        if constexpr (ALIGN_EPI) { if (wr == 0) PG8_BAR; }
        E(acc, cur, wr, wc, fr, fq, pre);
        if (!has_next) break;
#pragma unroll
        for (int a = 0; a < 2; ++a)
#pragma unroll
            for (int b = 0; b < 2; ++b)
#pragma unroll
                for (int m = 0; m < 4; ++m)
#pragma unroll
                    for (int n = 0; n < 2; ++n) acc[a][b][m][n] = (f32x4){0.f, 0.f, 0.f, 0.f};
        cur = nxt; cA = nA; cB = nB; ++ui;
        pre = E.pre(cur, wid, lane);
        if constexpr (ALIGN_EPI) { if (wr == 1) PG8_BAR; }
    }
    PG8_WAIT_V(0);
    if constexpr (!ALIGN_EPI) { if (wr == 0) PG8_BAR; }
    PG8_BAR;
#undef PG8_SA
#undef PG8_SB
#undef PG8_STAGE
#undef PG8_LDA
#undef PG8_LDB
#undef PG8_MMA
#undef PG8_WAIT_V
#undef PG8_WAIT_L
#undef PG8_BAR
#undef PG8_SCHED
}
}

#define XB_TMO      128
#define XB_XCNT(j)  (256  + 64 * (j))
#define XB_XSUB(j)  (1280 + 64 * (j))
#define XB_XGEN(j)  (2304 + 64 * (j))
#define XB_TOP      3328
#define XB_TOPGEN   3392
#define XCD_BAR_WORDS 3456
#define XB_SPIN_CAP (1u << 18)
__device__ __forceinline__ unsigned xb_ld(unsigned* p)              { return __hip_atomic_load(p, __ATOMIC_RELAXED, __HIP_MEMORY_SCOPE_AGENT); }
__device__ __forceinline__ unsigned xb_add(unsigned* p, unsigned v) { return __hip_atomic_fetch_add(p, v, __ATOMIC_RELAXED, __HIP_MEMORY_SCOPE_AGENT); }
__device__ __forceinline__ unsigned xb_xcc_id() { return (unsigned)__builtin_amdgcn_s_getreg((3 << 11) | 20) & 0xFu; }
#define XB_SPIN(cond, bar) do { unsigned _sp = 0; while (cond) { __builtin_amdgcn_s_sleep(1); \
    if ((++_sp & 255u) == 0u) { if (xb_ld(&(bar)[XB_TMO])) break; if (_sp > XB_SPIN_CAP) { atomicAdd(&(bar)[XB_TMO], 1u); break; } } } } while (0)
struct XcdBarrier { unsigned* bar; unsigned x; volatile LAS unsigned* st; };
__device__ __forceinline__ XcdBarrier xcd_barrier_post(unsigned* bar, volatile LAS unsigned* st) {
    XcdBarrier b; b.bar = bar; b.x = xb_xcc_id(); b.st = st;
    if (threadIdx.x == 0) (void)xb_add(&bar[XB_XCNT(b.x)], 1u);
    return b;
}
__device__ __forceinline__ void xcd_barrier_complete(unsigned* bar, unsigned x, unsigned& nloc, unsigned& nx) {
    const unsigned G = gridDim.x * gridDim.y * gridDim.z;
    unsigned sum, cnt, mine, sp = 0u;
    for (;;) {
        sum = 0u; cnt = 0u; mine = 0u;
#pragma unroll
        for (unsigned j = 0; j < 16; ++j) { const unsigned c = xb_ld(&bar[XB_XCNT(j)]); sum += c; cnt += (c > 0u) ? 1u : 0u; mine = (j == x) ? c : mine; }
        if (sum == G) break;
        __builtin_amdgcn_s_sleep(1);
        if ((++sp & 255u) == 0u) { if (xb_ld(&bar[XB_TMO])) break; if (sp > XB_SPIN_CAP) { atomicAdd(&bar[XB_TMO], 1u); break; } }
    }
    nloc = mine > 0u ? mine : 1u; nx = cnt > 0u ? cnt : 1u;
}
__device__ __forceinline__ void xcd_barrier(const XcdBarrier& b) {
    asm volatile("s_waitcnt vmcnt(0)" ::: "memory");
    __syncthreads();
    if (threadIdx.x == 0) {
        unsigned* bar = b.bar;
        __builtin_amdgcn_s_waitcnt(0);
        unsigned nloc = b.st[0], nx = b.st[1];
        if (nloc == 0u) { xcd_barrier_complete(bar, b.x, nloc, nx); b.st[0] = nloc; b.st[1] = nx; }
        const unsigned old = xb_add(&bar[XB_XSUB(b.x)], 1u);
        const unsigned gen = old / nloc;
        if (old + 1u == (gen + 1u) * nloc) {
            __builtin_amdgcn_fence(__ATOMIC_RELEASE, "agent");
            asm volatile("s_waitcnt vmcnt(0)" ::: "memory");
            const unsigned og = xb_add(&bar[XB_TOP], 1u);
            const unsigned tg = og / nx;
            if (og + 1u == (tg + 1u) * nx) xb_add(&bar[XB_TOPGEN], 1u);
            else XB_SPIN(xb_ld(&bar[XB_TOPGEN]) == tg, bar);
            __builtin_amdgcn_fence(__ATOMIC_ACQUIRE, "agent");
            xb_add(&bar[XB_XGEN(b.x)], 1u);
            asm volatile("s_waitcnt vmcnt(0)" ::: "memory");
        } else {
            XB_SPIN(xb_ld(&bar[XB_XGEN(b.x)]) == gen, bar);
            __builtin_amdgcn_fence(__ATOMIC_ACQUIRE, "agent");
            asm volatile("s_waitcnt vmcnt(0)" ::: "memory");
        }
    }
    __syncthreads();
}

constexpr int MK_LDS = 147456;
constexpr int NWV = 8;
#ifndef MK_HI
#define MK_HI 16
#endif
#ifndef S5_NAIVE
#define S5_NAIVE 0
#endif
#ifndef USE_XBAR
#define USE_XBAR 1
#endif
#ifndef REPMASK
#define REPMASK 0x0
#endif
#define REPS(k) for (int rep_ = 0; rep_ <= ((REPMASK >> (k)) & 1); ++rep_)
struct MkArgs { const float* in[27]; float* out; unsigned char* ws; int ph_lo, ph_hi; };

template <int MAP> __device__ __forceinline__ void transpose_item(const float* __restrict__ W, int K, int N, bf16_t* __restrict__ WT, LAS float* scr, int item, int lane) {
    const int nblk = N / 32, kb = item / nblk, nb = item % nblk, k0 = 64 * kb, n0 = 32 * nb;
#pragma unroll 8
    for (int i = 0; i < 32; ++i) { const int kk = 2 * i + (lane >> 5); scr[kk * 33 + (lane & 31)] = W[(size_t)(k0 + kk) * N + n0 + (lane & 31)]; }
    asm volatile("s_waitcnt lgkmcnt(0)" ::: "memory");
    const int c = lane & 7;
#pragma unroll
    for (int j = 0; j < 4; ++j) { const int n = (lane >> 3) + 8 * j; const LAS float* s = scr + (8 * c) * 33 + n;
        u32x4 o; o.x = pk2(s[0 * 33], s[1 * 33]); o.y = pk2(s[2 * 33], s[3 * 33]); o.z = pk2(s[4 * 33], s[5 * 33]); o.w = pk2(s[6 * 33], s[7 * 33]);
        int dr = n0 + n; if (MAP == 1) { const int cc = dr >= DFF ? dr - DFF : dr; dr = (cc >> 7) * 256 + (dr >= DFF ? 128 : 0) + (cc & 127); }
        if (MAP == 2) { const int cc = dr & 1023; dr = (cc >> 7) * 256 + (dr >= 1024 ? 128 : 0) + (cc & 127); }
        *(u32x4*)(WT + (size_t)dr * K + k0 + 8 * c) = o; }
    asm volatile("s_waitcnt lgkmcnt(0)" ::: "memory");
}
__device__ __forceinline__ void norm_mod_rows4(const float* __restrict__ src, const float* __restrict__ w, const float* __restrict__ sh, const float* __restrict__ sc, bf16_t* __restrict__ dst, int lane) {
    f32x4 v[4][4]; float ss[4];
#pragma unroll
    for (int r = 0; r < 4; ++r)
#pragma unroll
        for (int j = 0; j < 4; ++j) v[r][j] = *(const f32x4*)(src + (size_t)r * DM + j * 256 + lane * 4);
#pragma unroll
    for (int r = 0; r < 4; ++r) { float s = 0.f;
#pragma unroll
        for (int j = 0; j < 4; ++j) s += (v[r][j][0] * v[r][j][0] + v[r][j][1] * v[r][j][1]) + (v[r][j][2] * v[r][j][2] + v[r][j][3] * v[r][j][3]);
        ss[r] = s; }
#pragma unroll
    for (int o = 1; o < 64; o <<= 1) {
#pragma unroll
        for (int r = 0; r < 4; ++r) ss[r] += __shfl_xor(ss[r], o); }
#pragma unroll
    for (int r = 0; r < 4; ++r) ss[r] = rsqrtf(ss[r] * (1.f / DM) + EPS);
#pragma unroll
    for (int j = 0; j < 4; ++j) { const int k = j * 256 + lane * 4; const f32x4 ww = *(const f32x4*)(w + k), s1 = *(const f32x4*)(sc + k) + 1.f, s0 = *(const f32x4*)(sh + k);
#pragma unroll
        for (int r = 0; r < 4; ++r) { const f32x4 y = (v[r][j] * ss[r] * ww) * s1 + s0; u32x2 o; o.x = pk2(y[0], y[1]); o.y = pk2(y[2], y[3]); *(u32x2*)(dst + (size_t)r * DM + k) = o; } }
}
struct NoPre {};
#define EPI_NOPRE typedef NoPre Pre; __device__ __forceinline__ Pre pre(const pg8::Unit&, int, int) const { return Pre{}; }
__device__ __forceinline__ float xf_id(float v) { return v; }
struct EpiAfast {
    static constexpr bool PERM = true;
    EPI_NOPRE
    bf16_t *Q, *Kb, *Vb, *Ucat, *SG; const float *qnw, *knw; LAS float* SS;
    __device__ __forceinline__ void operator()(const f32x4 (&acc)[2][2][4][2], const pg8::Unit& u, int wr, int wc, int fr, int fq, const Pre& pre_) const {
        using namespace pg8;
        const int row0 = u.pm * BM + wr * 64 + fr, cl = wc * 32 + 8 * fq;
        const bool lat = u.pm < ML / 256;
        if (u.pn < 5) {
            const bool isq = u.pn < 4; const float* nw = isq ? qnw : knw;
#pragma unroll
            for (int ai = 0; ai < 2; ++ai)
#pragma unroll
                for (int m = 0; m < 4; ++m)
#pragma unroll
                    for (int bj = 0; bj < 2; ++bj) { const f32x4 v0 = acc[ai][bj][m][0], v1 = acc[ai][bj][m][1];
                        float s = (v0[0] * v0[0] + v0[1] * v0[1]) + (v0[2] * v0[2] + v0[3] * v0[3]) + (v1[0] * v1[0] + v1[1] * v1[1]) + (v1[2] * v1[2] + v1[3] * v1[3]);
                        s += __shfl_xor(s, 16); s += __shfl_xor(s, 32);
                        if (fq == 0) SS[((ai * HALF + wr * 64 + m * 16 + fr) * 2 + bj) * 4 + wc] = s; }
            asm volatile("s_waitcnt lgkmcnt(0)" ::: "memory"); __builtin_amdgcn_s_barrier(); asm volatile("" ::: "memory");
            const f32x4 w0 = *(const f32x4*)(nw + cl), w1 = *(const f32x4*)(nw + cl + 4);
            float invf[4];
#pragma unroll
            for (int e = 0; e < 4; ++e) invf[e] = exp2f(-(float)(2 * (((cl >> 1) + e) & 31)) * (13.287712379549449f / 64.f));
#pragma unroll
            for (int ai = 0; ai < 2; ++ai)
#pragma unroll
                for (int m = 0; m < 4; ++m) { const int row = row0 + ai * HALF + m * 16;
                    float cs[4], sn[4];
                    if (lat) { const int t = row % SEQ; const float coord = (wc < 2) ? (float)(t >> 6) : (float)(t & 63);
#pragma unroll
                        for (int e = 0; e < 4; ++e) { const float ang = coord * invf[e]; cs[e] = __cosf(ang); sn[e] = __sinf(ang); } }
                    else {
#pragma unroll
                        for (int e = 0; e < 4; ++e) { cs[e] = 1.f; sn[e] = 0.f; } }
                    bf16_t* rp = isq ? Q + (size_t)row * 1024 + u.pn * 256 + cl
                                     : Kb + ((size_t)(lat ? (row / SEQ) * LKV + LC + (row % SEQ) : ((row - ML) / LC) * LKV + ((row - ML) % LC))) * 256 + cl;
#pragma unroll
                    for (int bj = 0; bj < 2; ++bj) {
                        const f32x4 p = *(const LAS f32x4*)(SS + ((ai * HALF + wr * 64 + m * 16 + fr) * 2 + bj) * 4);
                        const float rs = rsqrtf(((p[0] + p[1]) + (p[2] + p[3])) * (1.f / 128.f) + EPS);
                        const f32x4 y0 = acc[ai][bj][m][0] * rs * w0, y1 = acc[ai][bj][m][1] * rs * w1;
                        u32x4 w; w.x = cvt_pk_bf16(y0[0] * cs[0] - y0[1] * sn[0], y0[0] * sn[0] + y0[1] * cs[0]); w.y = cvt_pk_bf16(y0[2] * cs[1] - y0[3] * sn[1], y0[2] * sn[1] + y0[3] * cs[1]);
                        w.z = cvt_pk_bf16(y1[0] * cs[2] - y1[1] * sn[2], y1[0] * sn[2] + y1[1] * cs[2]); w.w = cvt_pk_bf16(y1[2] * cs[3] - y1[3] * sn[3], y1[2] * sn[3] + y1[3] * cs[3]);
                        *(u32x4*)(rp + bj * 128) = w; } }
        }
        else if (u.pn == 5) {
            EPI_ROWS_BF16(Vb + ((size_t)(lat ? (row / SEQ) * LKV + LC + (row % SEQ) : ((row - ML) / LC) * LKV + ((row - ML) % LC))) * 256 + cl, 128, xf_id); }
        else if (u.pn < 8) { const int ch0 = (u.pn - 6) * 256 + cl;
            if (lat) { EPI_ROWS_BF16(Ucat + ucat_idx(row / SEQ, row % SEQ, ch0), (size_t)8 * UROWS * KCAT, xf_id); }
            else { EPI_ROWS_BF16(Ucat + ucat_ctx_idx((row - ML) / LC, (row - ML) % LC, ch0), (size_t)8 * UROWS * KCAT, xf_id); } }
        else { EPI_ROWS_BF16(SG + (size_t)row * 2048 + (u.pn - 8) * 256 + cl, 128, sigmoidf_); }
    }
};
struct EpiStoreFast {
    static constexpr bool PERM = true; bf16_t* O; int ldo;
    EPI_NOPRE
    __device__ __forceinline__ void operator()(const f32x4 (&acc)[2][2][4][2], const pg8::Unit& u, int wr, int wc, int fr, int fq, const Pre& pre_) const {
        using namespace pg8; const int row0 = u.pm * BM + wr * 64 + fr, cl = u.pn * BM + wc * 32 + 8 * fq;
        EPI_ROWS_BF16(O + (size_t)row * ldo + cl, 128, xf_id);
    }
};
__device__ __forceinline__ void unpack8(const u32x4 w, float (&f)[8]) {
    f[0] = __uint_as_float(w.x << 16); f[1] = __uint_as_float(w.x & 0xffff0000u); f[2] = __uint_as_float(w.y << 16); f[3] = __uint_as_float(w.y & 0xffff0000u);
    f[4] = __uint_as_float(w.z << 16); f[5] = __uint_as_float(w.z & 0xffff0000u); f[6] = __uint_as_float(w.w << 16); f[7] = __uint_as_float(w.w & 0xffff0000u);
}
struct EpiGluPair {
    static constexpr bool PERM = true; const bf16_t* SG; bf16_t* PS;
    EPI_NOPRE
    __device__ __forceinline__ void operator()(const f32x4 (&acc)[2][2][4][2], const pg8::Unit& u, int wr, int wc, int fr, int fq, const Pre& pre_) const {
        using namespace pg8; const int row0 = u.pm * BM + wr * 64 + fr, c0 = u.pn * 128 + wc * 32 + 8 * fq;
#pragma unroll
        for (int ai = 0; ai < 2; ++ai)
#pragma unroll
            for (int m = 0; m < 4; ++m) { const int row = row0 + ai * HALF + m * 16; float gs[8], r[8];
                unpack8(*(const u32x4*)(SG + (size_t)row * 2048 + 1024 + c0), gs);
#pragma unroll
                for (int j = 0; j < 8; ++j) { const float av = (j < 4) ? acc[ai][0][m][0][j & 3] : acc[ai][0][m][1][j & 3], bv = (j < 4) ? acc[ai][1][m][0][j & 3] : acc[ai][1][m][1][j & 3]; r[j] = gs[j] * av * sigmoidf_(bv); }
                u32x4 w; w.x = cvt_pk_bf16(r[0], r[1]); w.y = cvt_pk_bf16(r[2], r[3]); w.z = cvt_pk_bf16(r[4], r[5]); w.w = cvt_pk_bf16(r[6], r[7]);
                *(u32x4*)(PS + (size_t)row * 1024 + c0) = w; }
    }
};
struct EpiMergeFast {
    static constexpr bool PERM = true; const bf16_t *SG, *GLU; bf16_t* MG;
    EPI_NOPRE
    __device__ __forceinline__ void operator()(const f32x4 (&acc)[2][2][4][2], const pg8::Unit& u, int wr, int wc, int fr, int fq, const Pre& pre_) const {
        using namespace pg8; const int row0 = u.pm * BM + wr * 64 + fr, cl = u.pn * BM + wc * 32 + 8 * fq;
#pragma unroll
        for (int ai = 0; ai < 2; ++ai)
#pragma unroll
            for (int m = 0; m < 4; ++m) { const int row = row0 + ai * HALF + m * 16;
#pragma unroll
                for (int bj = 0; bj < 2; ++bj) { const size_t o2 = (size_t)row * 2048 + cl + bj * 128;
                    float ga[8], ps[8], r[8];
                    unpack8(*(const u32x4*)(SG + o2), ga); unpack8(*(const u32x4*)(GLU + (size_t)row * 1024 + cl + bj * 128), ps);
#pragma unroll
                    for (int j = 0; j < 8; ++j) { const float v = (j < 4) ? acc[ai][bj][m][0][j & 3] : acc[ai][bj][m][1][j & 3]; r[j] = ga[j] * v + ps[j]; }
                    u32x4 w; w.x = cvt_pk_bf16(r[0], r[1]); w.y = cvt_pk_bf16(r[2], r[3]); w.z = cvt_pk_bf16(r[4], r[5]); w.w = cvt_pk_bf16(r[6], r[7]);
                    *(u32x4*)(MG + (size_t)row * 1024 + cl + bj * 128) = w; } }
    }
};
struct EpiResidFast {
    static constexpr bool PERM = false; const float* base; float* out; const float* gate;
    EPI_NOPRE
    __device__ __forceinline__ void operator()(const f32x4 (&acc)[2][2][4][2], const pg8::Unit& u, int wr, int wc, int fr, int fq, const Pre& pre_) const {
        using namespace pg8; const int row0 = u.pm * BM + wr * 64 + fr, col0 = u.pn * BM + wc * 32 + 4 * fq;
        const float* gp = gate + (size_t)((u.pm * BM) / SEQ) * 6144 + col0;
        f32x4 gv[2][2];
#pragma unroll
        for (int bj = 0; bj < 2; ++bj)
#pragma unroll
            for (int n = 0; n < 2; ++n) gv[bj][n] = *(const f32x4*)(gp + bj * HALF + n * 16);
#pragma unroll
        for (int ai = 0; ai < 2; ++ai)
#pragma unroll
            for (int m = 0; m < 4; ++m) { const size_t off = (size_t)(row0 + ai * HALF + m * 16) * 1024 + col0;
#pragma unroll
                for (int bj = 0; bj < 2; ++bj)
#pragma unroll
                    for (int n = 0; n < 2; ++n) { const f32x4 bs = *(const f32x4*)(base + off + bj * HALF + n * 16); *(f32x4*)(out + off + bj * HALF + n * 16) = bs + gv[bj][n] * acc[ai][bj][m][n]; }
                asm volatile("" ::: "memory"); }
    }
};
template <int CTRL> __device__ __forceinline__ float dppf(float x) { return __builtin_bit_cast(float, __builtin_amdgcn_mov_dpp(__builtin_bit_cast(int, x), CTRL, 0xf, 0xf, true)); }
template <int CTRL> __device__ __forceinline__ float dpp_old(float old, float x) { return __builtin_bit_cast(float, __builtin_amdgcn_update_dpp(__builtin_bit_cast(int, old), __builtin_bit_cast(int, x), CTRL, 0xf, 0xf, false)); }
struct EpiUpConv {
    static constexpr bool PERM = true;
    struct Pre { f32x2 v; };
    __device__ __forceinline__ Pre pre(const pg8::Unit& u, int p, int lane) const { const int c = u.pn * 128 + lane * 2;
        const float* sp = p < 3 ? cw + p * NUP + c : p == 3 ? cb + c : p < 7 ? cw + (p - 4) * NUP + DFF + c : cb + DFF + c; Pre r; r.v = *(const f32x2*)sp; return r; }
    bf16_t* A; float* HALO; const float* cw; const float* cb; LAS float* Bd; LAS float* Pm;
    __device__ __forceinline__ void operator()(const f32x4 (&acc)[2][2][4][2], const pg8::Unit& u, int wr, int wc, int fr, int fq, const Pre& pre_) const {
        using namespace pg8;
        const int x0 = wc * 32 + 8 * fq;
        if (fr == 0) {
#pragma unroll
            for (int ai = 0; ai < 2; ++ai)
#pragma unroll
                for (int bj = 0; bj < 2; ++bj)
#pragma unroll
                    for (int n = 0; n < 2; ++n) *(LAS f32x4*)(Bd + (ai * 4 + wr * 2) * 256 + bj * 128 + x0 + 4 * n) = acc[ai][bj][0][n]; }
        if (fr == 15) {
#pragma unroll
            for (int ai = 0; ai < 2; ++ai)
#pragma unroll
                for (int bj = 0; bj < 2; ++bj)
#pragma unroll
                    for (int n = 0; n < 2; ++n) *(LAS f32x4*)(Bd + (ai * 4 + wr * 2 + 1) * 256 + bj * 128 + x0 + 4 * n) = acc[ai][bj][3][n]; }
        {
          const int p = wr * 4 + wc, xx = (fq * 16 + fr) * 2; Pm[p * 128 + xx] = pre_.v.x; Pm[p * 128 + xx + 1] = pre_.v.y; }
        asm volatile("s_waitcnt lgkmcnt(0)" ::: "memory"); __builtin_amdgcn_s_barrier(); asm volatile("" ::: "memory");
        const int cbase = u.pn * 128 + x0;
        float* hz = HALO + ((size_t)(u.pm * 22 + u.pn) * 4) * 256;
#pragma unroll
        for (int ai = 0; ai < 2; ++ai) {
            const int blk = 2 * ai + wr;
            const LAS float* pbp = Bd + (((blk - 1) >> 1) * 4 + ((blk - 1) & 1) * 2 + 1) * 256 + x0;
            const LAS float* nbp = Bd + (((blk + 1) >> 1) * 4 + ((blk + 1) & 1) * 2) * 256 + x0;
#pragma unroll
            for (int n = 0; n < 2; ++n) {
                const int c = cbase + 4 * n;
                const LAS float* pp = Pm + x0 + 4 * n;
                float o[4][4];
#pragma unroll
                for (int j = 0; j < 4; ++j) {
                    const float w0v = pp[j], w1v = pp[128 + j], w2v = pp[256 + j], bv = pp[384 + j], w0g = pp[512 + j], w1g = pp[640 + j], w2g = pp[768 + j], bg = pp[896 + j];
                    float pbv = 0.f, pbg = 0.f, nbv = 0.f, nbg = 0.f;
                    if (blk > 0) { pbv = pbp[4 * n + j]; pbg = pbp[128 + 4 * n + j]; }
                    if (blk < 3) { nbv = nbp[4 * n + j]; nbg = nbp[128 + 4 * n + j]; }
                    float zv[4], zg[4];
#pragma unroll
                    for (int m = 0; m < 4; ++m) { zv[m] = acc[ai][0][m][n][j]; zg[m] = acc[ai][1][m][n][j]; }
                    const float pv0 = dpp_old<0x111>(pbv, zv[3]), pg0 = dpp_old<0x111>(pbg, zg[3]), nv3 = dpp_old<0x101>(nbv, zv[0]), ng3 = dpp_old<0x101>(nbg, zg[0]);
#pragma unroll
                    for (int m = 0; m < 4; ++m) {
                        const float pv = m == 0 ? pv0 : zv[m > 0 ? m - 1 : 0], pg = m == 0 ? pg0 : zg[m > 0 ? m - 1 : 0], nv = m == 3 ? nv3 : zv[m < 3 ? m + 1 : 3], ng = m == 3 ? ng3 : zg[m < 3 ? m + 1 : 3];
                        const float cv = fmaf(w0v, pv, fmaf(w1v, zv[m], fmaf(w2v, nv, bv))), cg = fmaf(w0g, pg, fmaf(w1g, zg[m], fmaf(w2g, ng, bg)));
                        if (m == 0 && blk == 0 && fr == 0) { hz[0 * 256 + x0 + 4 * n + j] = zv[0]; hz[0 * 256 + 128 + x0 + 4 * n + j] = zg[0]; hz[2 * 256 + x0 + 4 * n + j] = cv; hz[2 * 256 + 128 + x0 + 4 * n + j] = cg; }
                        if (m == 3 && blk == 3 && fr == 15) { hz[1 * 256 + x0 + 4 * n + j] = zv[3]; hz[1 * 256 + 128 + x0 + 4 * n + j] = zg[3]; hz[3 * 256 + x0 + 4 * n + j] = cv; hz[3 * 256 + 128 + x0 + 4 * n + j] = cg; }
                        o[m][j] = siluf_(cg) * cv; }
                }
#pragma unroll
                for (int m = 0; m < 4; ++m) { const int row = u.pm * BM + ai * HALF + wr * 64 + 4 * fr + m; u32x2 w; w.x = cvt_pk_bf16(o[m][0], o[m][1]); w.y = cvt_pk_bf16(o[m][2], o[m][3]);
                    *(u32x2*)(A + (size_t)row * DFF + c) = w; }
                asm volatile("" ::: "memory");
            }
        }
    }
};
__device__ __forceinline__ void conv_fix_panel(int pm, const float* __restrict__ HALO, const float* __restrict__ cw, bf16_t* __restrict__ A, int tid) {
#pragma unroll
    for (int rk = 0; rk < 2; ++rk) {
        if (rk == 0 ? (pm & 7) == 0 : (pm & 7) == 7) continue;
        const int nb = rk == 0 ? pm - 1 : pm + 1;
        for (int c = tid; c < DFF; c += NWV * 64) { const int pn = c >> 7, x = c & 127;
            const float* hp = HALO + ((size_t)(pm * 22 + pn) * 4 + 2 + rk) * 256; const float* hn = HALO + ((size_t)(nb * 22 + pn) * 4 + (rk == 0 ? 1 : 0)) * 256;
            const float wv = cw[(rk == 0 ? 0 : 2) * NUP + c], wg = cw[(rk == 0 ? 0 : 2) * NUP + DFF + c];
            const float val = hp[x] + wv * hn[x], gate = hp[128 + x] + wg * hn[128 + x];
            A[(size_t)(pm * 256 + (rk == 0 ? 0 : 255)) * DFF + c] = f2bf(siluf_(gate) * val); }
    }
}
__device__ __forceinline__ int sidx(int d, int ri, int n) { return d * 128 + ri * 64 + n; }
__device__ __forceinline__ void s5_tables_block(const S5In& P, int g, int qr, bf16_t* __restrict__ W1, bf16_t* __restrict__ B3, float* __restrict__ A32, LAS unsigned char* lds, int tid) {
    LAS float* BBs = (LAS float*)lds;
    LAS float* PWs = BBs + 4096;
    LAS float* CCs = PWs + 66 * 130;
    LAS float* KT = CCs + 32 * 130;
    if (tid < 128) {
        const int d = tid >> 6, n = tid & 63, dg = d * NG + g;
        const float dt = expf(P.ldt[dg]), lr = P.lre[dg * NS + n], li = P.lim[dg * NS + n];
        const float mag = expf(lr * dt), ang = li * dt, are = mag * cosf(ang), aim = mag * sinf(ang);
        const float den = lr * lr + li * li, nr = are - 1.f, ni = aim, fre = (nr * lr + ni * li) / den, fim = (ni * lr - nr * li) / den;
#pragma unroll
        for (int q = 0; q < PG; ++q) { const float br = P.bre[((size_t)dg * NS + n) * PG + q], bi = P.bim[((size_t)dg * NS + n) * PG + q];
            BBs[((d * 64 + n) * 16 + q) * 2] = fre * br - fim * bi; BBs[((d * 64 + n) * 16 + q) * 2 + 1] = fre * bi + fim * br; }
        double pr = 1.0, pi = 0.0; const double ar = (double)are, ai = (double)aim;
        for (int k = 0; k <= 32; ++k) { PWs[(d * 33 + k) * 130 + n * 2] = (float)pr; PWs[(d * 33 + k) * 130 + n * 2 + 1] = (float)pi; const double t0 = pr * ar - pi * ai, t1 = pr * ai + pi * ar; pr = t0; pi = t1; }
        if (qr == 0) { A32[(dg * NS + n) * 2] = PWs[(d * 33 + 32) * 130 + n * 2]; A32[(dg * NS + n) * 2 + 1] = PWs[(d * 33 + 32) * 130 + n * 2 + 1]; }
    }
    for (int i = tid; i < 2048; i += 512) { const int d = i >> 10, p = (i >> 6) & 15, n = i & 63; CCs[(i >> 6) * 130 + (i & 63) * 2] = P.cre[((size_t)(d * NG + g) * PG + p) * NS + n]; CCs[(i >> 6) * 130 + (i & 63) * 2 + 1] = P.cim[((size_t)(d * NG + g) * PG + p) * NS + n]; }
    __syncthreads();
    REPS(22) { const int d = tid >> 8, lagA = (tid >> 4) & 15, p = tid & 15; float accA[16], accB[16];
#pragma unroll
        for (int q = 0; q < 16; ++q) { accA[q] = 0.f; accB[q] = 0.f; }
        const LAS float* cp = CCs + (d * 16 + p) * 130; const LAS float* pa = PWs + (d * 33 + lagA) * 130; const LAS float* pb = PWs + (d * 33 + lagA + 16) * 130;
#pragma unroll 2
        for (int n = 0; n < 64; ++n) { const float cr = cp[2 * n], ci = cp[2 * n + 1], par = pa[2 * n], pai = pa[2 * n + 1], pbr = pb[2 * n], pbi = pb[2 * n + 1];
            const float xr = cr * par - ci * pai, xi = cr * pai + ci * par, yr = cr * pbr - ci * pbi, yi = cr * pbi + ci * pbr; const LAS float* bb = BBs + ((d * 64 + n) * 16) * 2;
#pragma unroll
            for (int q = 0; q < 16; ++q) { const float br = bb[2 * q], bi = bb[2 * q + 1]; accA[q] += xr * br - xi * bi; accB[q] += yr * br - yi * bi; } }
#pragma unroll
        for (int q = 0; q < 16; ++q) { KT[(d * 32 + lagA) * 260 + p * 16 + q] = accA[q]; KT[(d * 32 + lagA + 16) * 260 + p * 16 + q] = accB[q]; } }
    __syncthreads();
    for (int ch = tid; ch < 128 * 96; ch += 512) { const int r = ch / 96, cc = ch % 96, j = qr * 8 + (r >> 4), p = r & 15; float v[8];
        if (cc < 64) { const int i = cc >> 1, q0 = (cc & 1) * 8, lag = j - i;
#pragma unroll
            for (int e = 0; e < 8; ++e) { const int q = q0 + e; float x;
                if (lag > 0) x = KT[lag * 260 + p * 16 + q]; else if (lag < 0) x = KT[(32 - lag) * 260 + p * 16 + q];
                else x = KT[p * 16 + q] + KT[32 * 260 + p * 16 + q] + (q == p ? P.dsk[g * PG + p] : 0.f);
                v[e] = x; } }
        else { const int s0 = (cc - 64) * 8, d = s0 >> 7, ri = (s0 >> 6) & 1, n0 = s0 & 63, k = d == 0 ? j + 1 : 32 - j;
#pragma unroll
            for (int e = 0; e < 8; ++e) { const int n = n0 + e; const float cr = CCs[(d * 16 + p) * 130 + n * 2], ci = CCs[(d * 16 + p) * 130 + n * 2 + 1], pr = PWs[(d * 33 + k) * 130 + n * 2], pi = PWs[(d * 33 + k) * 130 + n * 2 + 1];
                v[e] = ri == 0 ? (cr * pr - ci * pi) : -(cr * pi + ci * pr); } }
        u32x4 w; w.x = pk2(v[0], v[1]); w.y = pk2(v[2], v[3]); w.z = pk2(v[4], v[5]); w.w = pk2(v[6], v[7]);
        *(u32x4*)(B3 + ((size_t)(g * 512 + j * 16 + p)) * KCAT + cc * 8) = w; }
    { const int d = qr >> 1, ri = qr & 1;
      for (int ch = tid; ch < 64 * 64; ch += 512) { const int n = ch >> 6, cc = ch & 63, i = cc >> 1, q0 = (cc & 1) * 8, k = d == 0 ? 31 - i : i; float v[8];
          const float pr = PWs[(d * 33 + k) * 130 + n * 2], pi = PWs[(d * 33 + k) * 130 + n * 2 + 1];
#pragma unroll
          for (int e = 0; e < 8; ++e) { const float br = BBs[((d * 64 + n) * 16 + q0 + e) * 2], bi = BBs[((d * 64 + n) * 16 + q0 + e) * 2 + 1]; v[e] = ri == 0 ? (pr * br - pi * bi) : (pr * bi + pi * br); }
          u32x4 w; w.x = pk2(v[0], v[1]); w.y = pk2(v[2], v[3]); w.z = pk2(v[4], v[5]); w.w = pk2(v[6], v[7]);
          *(u32x4*)(W1 + ((size_t)(g * 256 + qr * 64 + n)) * 512 + cc * 8) = w; } }
    __syncthreads();
}
struct EpiS1 {
    static constexpr bool PERM = false; float* L;
    EPI_NOPRE
    __device__ __forceinline__ void operator()(const f32x4 (&acc)[2][2][4][2], const pg8::Unit& u, int wr, int wc, int fr, int fq, const Pre& pre_) const {
        using namespace pg8; const int row0 = u.pm * BM + wr * 64 + fr, col0 = wc * 32 + 4 * fq;
#pragma unroll
        for (int ai = 0; ai < 2; ++ai)
#pragma unroll
            for (int m = 0; m < 4; ++m) { float* rp = L + ((size_t)u.grp * UROWS + row0 + ai * HALF + m * 16) * 256 + col0;
#pragma unroll
                for (int bj = 0; bj < 2; ++bj)
#pragma unroll
                    for (int n = 0; n < 2; ++n) *(f32x4*)(rp + bj * HALF + n * 16) = acc[ai][bj][m][n]; }
    }
};
struct EpiS3 {
    static constexpr bool PERM = true; bf16_t* SSM;
    EPI_NOPRE
    __device__ __forceinline__ void operator()(const f32x4 (&acc)[2][2][4][2], const pg8::Unit& u, int wr, int wc, int fr, int fq, const Pre& pre_) const {
        using namespace pg8; const int row0 = u.pm * BM + wr * 64 + fr, cl = u.pn * BM + wc * 32 + 8 * fq;
        EPI_ROWS_BF16(SSM + ((size_t)(u.grp * 1024 + row)) * 512 + cl, 128, gelu_tanh);
    }
};
struct OrderS1 { int G, c; __device__ __forceinline__ bool next(int i, pg8::Unit& u) const { const int L = i * G + c; if (L >= NG * 5) return false; u.grp = L / 5; u.pm = L % 5; u.pn = 0; return true; } };
struct OrderOne { pg8::Unit u0; __device__ __forceinline__ bool next(int i, pg8::Unit& u) const { if (i != 0) return false; u = u0; return true; } };
template <int MODE> struct EpiResNorm {
    static constexpr bool PERM = false;
    EPI_NOPRE
    const float* base; float* out; const float* gate; const float* fw; unsigned* xs; unsigned* cnt; LAS float* P;
    bf16_t* H2; const float* sh; const float* sc;
    __device__ __forceinline__ void operator()(f32x4 (&acc)[2][2][4][2], const pg8::Unit& u, int wr, int wc, int fr, int fq, const Pre& pre_) const {
        using namespace pg8; const int row0 = u.pm * BM + wr * 64 + fr, col0 = u.pn * BM + wc * 32 + 4 * fq;
        const int wid = wr * 4 + wc, lane = fq * 16 + fr;
        { const float* gp = gate + (size_t)((u.pm * BM) / SEQ) * 6144 + col0; f32x4 gv[2][2];
#pragma unroll
          for (int bj = 0; bj < 2; ++bj)
#pragma unroll
              for (int n = 0; n < 2; ++n) gv[bj][n] = *(const f32x4*)(gp + bj * HALF + n * 16);
#pragma unroll
          for (int ai = 0; ai < 2; ++ai)
#pragma unroll
              for (int m = 0; m < 4; ++m) { const size_t off = (size_t)(row0 + ai * HALF + m * 16) * 1024 + col0; float s = 0.f;
#pragma unroll
                  for (int bj = 0; bj < 2; ++bj)
#pragma unroll
                      for (int n = 0; n < 2; ++n) { const f32x4 x = *(const f32x4*)(base + off + bj * HALF + n * 16) + gv[bj][n] * acc[ai][bj][m][n]; acc[ai][bj][m][n] = x; s += (x[0] * x[0] + x[1] * x[1]) + (x[2] * x[2] + x[3] * x[3]);
                          if (MODE == 1) *(f32x4*)(out + off + bj * HALF + n * 16) = x; }
                  s += __shfl_xor(s, 16); s += __shfl_xor(s, 32);
                  if (fq == 0) P[(ai * HALF + wr * 64 + m * 16 + fr) * 4 + wc] = s; } }
        asm volatile("s_waitcnt lgkmcnt(0)" ::: "memory"); __builtin_amdgcn_s_barrier(); asm volatile("" ::: "memory");
        const int prow = wid * 32 + (lane & 31);
        if (lane < 32) { const f32x4 p = *(const LAS f32x4*)(P + prow * 4);
            __hip_atomic_store(xs + ((size_t)(u.pm * BM + prow)) * 4 + u.pn, __float_as_uint((p[0] + p[1]) + (p[2] + p[3])), __ATOMIC_RELAXED, __HIP_MEMORY_SCOPE_AGENT); }
        asm volatile("s_waitcnt vmcnt(0)" ::: "memory");
        if (lane == 0) __hip_atomic_fetch_add(cnt + 64 * u.pm, 1u, __ATOMIC_RELAXED, __HIP_MEMORY_SCOPE_AGENT);
        if (wid == 0) {
            unsigned spins = 0;
            while ((unsigned)__builtin_amdgcn_readfirstlane(__hip_atomic_load(cnt + 64 * u.pm, __ATOMIC_RELAXED, __HIP_MEMORY_SCOPE_AGENT)) < 32u) { __builtin_amdgcn_s_sleep(2); if (++spins > (1u << 22)) break; }
            __builtin_amdgcn_fence(__ATOMIC_ACQUIRE, "agent");
        }
        asm volatile("s_waitcnt vmcnt(0) lgkmcnt(0)" ::: "memory"); __builtin_amdgcn_s_barrier(); asm volatile("" ::: "memory");
        if (lane < 32) { const unsigned* sl = xs + ((size_t)(u.pm * BM + prow)) * 4; float t = 0.f;
#pragma unroll
            for (int k = 0; k < 4; ++k) t += __uint_as_float(__hip_atomic_load(sl + k, __ATOMIC_RELAXED, __HIP_MEMORY_SCOPE_AGENT));
            P[1024 + prow] = rsqrtf(t * (1.f / DM) + EPS); }
        asm volatile("s_waitcnt lgkmcnt(0)" ::: "memory"); __builtin_amdgcn_s_barrier(); asm volatile("" ::: "memory");
        if (MODE == 0) {
            f32x4 fv[2][2];
#pragma unroll
            for (int bj = 0; bj < 2; ++bj)
#pragma unroll
                for (int n = 0; n < 2; ++n) fv[bj][n] = *(const f32x4*)(fw + col0 + bj * HALF + n * 16);
#pragma unroll
            for (int ai = 0; ai < 2; ++ai)
#pragma unroll
                for (int m = 0; m < 4; ++m) { const int r = ai * HALF + wr * 64 + m * 16 + fr; const float rs = P[1024 + r]; const size_t off = (size_t)(u.pm * BM + r) * 1024 + col0;
#pragma unroll
                    for (int bj = 0; bj < 2; ++bj)
#pragma unroll
                        for (int n = 0; n < 2; ++n) *(f32x4*)(out + off + bj * HALF + n * 16) = acc[ai][bj][m][n] * rs * fv[bj][n]; }
        } else {
            float rsv[2][4];
#pragma unroll
            for (int ai = 0; ai < 2; ++ai)
#pragma unroll
                for (int m = 0; m < 4; ++m) rsv[ai][m] = P[1024 + ai * HALF + wr * 64 + m * 16 + fr];
            const size_t mo = (size_t)((u.pm * BM) / SEQ) * 6144 + col0;
#pragma unroll
            for (int bj = 0; bj < 2; ++bj)
#pragma unroll
                for (int n = 0; n < 2; ++n) { const int cc = bj * HALF + n * 16; const f32x4 ww = *(const f32x4*)(fw + col0 + cc), s1 = *(const f32x4*)(sc + mo + cc) + 1.f, s0 = *(const f32x4*)(sh + mo + cc);
#pragma unroll
                    for (int ai = 0; ai < 2; ++ai)
#pragma unroll
                        for (int m = 0; m < 4; ++m) { const f32x4 y = (acc[ai][bj][m][n] * rsv[ai][m] * ww) * s1 + s0; u32x2 w; w.x = cvt_pk_bf16(y[0], y[1]); w.y = cvt_pk_bf16(y[2], y[3]);
                            *(u32x2*)(H2 + (size_t)(row0 + ai * HALF + m * 16) * 1024 + col0 + cc) = w; }
                    asm volatile("" ::: "memory"); }
        }
    }
};
struct OrderRect { pg8::StaticOrder so; __device__ __forceinline__ bool next(int i, pg8::Unit& u) const { return so.next(i, u); } };
struct OrderA {
    pg8::StaticOrder so;
    __device__ __forceinline__ bool next(int i, pg8::Unit& u) const {
        if (so.next(i, u)) return true;
        const long L = (long)i * so.G + so.c - so.nwg; if (L < 0 || L >= 64) return false;
        u.pm = 128 + (int)(L >> 2); u.pn = 4 + (int)(L & 3); u.grp = 0; return true;
    }
};

__global__ void __launch_bounds__(NWV * 64, 2) mk_fwd(MkArgs a) {
    extern __shared__ __attribute__((aligned(16))) unsigned char lds_raw[];
    LAS unsigned char* lds = (LAS unsigned char*)lds_raw;
#if !USE_XBAR
    cg::grid_group grid = cg::this_grid();
#endif
    const int tid0 = threadIdx.x, wave = __builtin_amdgcn_readfirstlane(tid0 >> 6);
#define PHASE_IDS const int tid = opaque_tid(wave), lane = tid & 63; (void)tid; (void)lane
    const int G = gridDim.x, bx = blockIdx.x;
    const int gw = bx * NWV + wave, NGW = G * NWV;
    unsigned char* ws = a.ws;
#define mod ((float*)(ws + WS_MOD))
#define WTin ((bf16_t*)(ws + WS_WIN))
#define WTbr ((bf16_t*)(ws + WS_WBR))
#define WTglu ((bf16_t*)(ws + WS_WGLU))
#define WTout ((bf16_t*)(ws + WS_WOUT))
#define WTup ((bf16_t*)(ws + WS_WUP))
#define WTdn ((bf16_t*)(ws + WS_WDN))
#define H ((bf16_t*)(ws + WS_H))
#define Q ((bf16_t*)(ws + WS_Q))
#define Kb ((bf16_t*)(ws + WS_K))
#define Vb ((bf16_t*)(ws + WS_V))
#define Ucat ((bf16_t*)(ws + WS_UCAT))
#define Uctx Ucat
#define SG ((bf16_t*)(ws + WS_SG))
#define O ((bf16_t*)(ws + WS_O))
#define SSM ((bf16_t*)(ws + WS_SSM))
#define GLU ((bf16_t*)(ws + WS_GLU))
#define MG ((bf16_t*)(ws + WS_MG))
#define H2 ((bf16_t*)(ws + WS_H2))
#define Ab ((bf16_t*)(ws + WS_A))
#define Ytmp ((float*)(ws + WS_YTMP))
    float* const out = a.out;
    const int lo = a.ph_lo, hi = a.ph_hi;
    volatile LAS unsigned* bst = (volatile LAS unsigned*)(lds + MK_LDS - 16);
    if (tid0 < 2) bst[tid0] = 0u;
    __syncthreads();
    XcdBarrier xbar = xcd_barrier_post((unsigned*)(ws + WS_CTL), bst);
#define IN(k) (lo <= (k) && (k) < hi)
#if USE_XBAR
#define SEAM(k) do { if (IN(k) && IN((k) + 1)) xcd_barrier(xbar); } while (0)
#else
#define SEAM(k) do { if (IN(k) && IN((k) + 1)) grid.sync(); } while (0)
#endif

    if (IN(0)) REPS(0) { PHASE_IDS;
        if (bx < 96) REPS(16) {
            LAS float* sc = (LAS float*)lds;
            LAS float* red = (LAS float*)(lds + 17 * 1024 * 4);
            for (int i = tid; i < 17 * 1024; i += NWV * 64) { const int r = i >> 10, k = i & 1023; sc[i] = siluf_(r < NB ? a.in[1][(size_t)r * DM + k] : a.in[3][k]); }
            __syncthreads();
            const int col = bx * 64 + lane; float acc[17];
#pragma unroll
            for (int r = 0; r < 17; ++r) acc[r] = 0.f;
            const float* wm = a.in[4];
            for (int k = wave * 128; k < wave * 128 + 128; ++k) { const float w = wm[(size_t)k * 6144 + col];
#pragma unroll
                for (int r = 0; r < 17; ++r) acc[r] = fmaf(sc[r * 1024 + k], w, acc[r]); }
#pragma unroll
            for (int r = 0; r < 17; ++r) red[(wave * 17 + r) * 64 + lane] = acc[r];
            __syncthreads();
            for (int i = tid; i < 17 * 64; i += NWV * 64) { const int r = i >> 6, cc = i & 63; float s = a.in[5][bx * 64 + cc];
#pragma unroll
                for (int w = 0; w < 8; ++w) s += red[(w * 17 + r) * 64 + cc];
                mod[(size_t)r * 6144 + bx * 64 + cc] = s; }
            __syncthreads();
        }
        if (bx >= 96 && bx < 96 + 128 || (G < 224 && bx < 96)) {
            S5In s5{a.in[12], a.in[13], a.in[14], a.in[15], a.in[16], a.in[17], a.in[18], a.in[19]};
            const int first = (G >= 224) ? bx - 96 : bx, step = (G >= 224) ? 128 : (G < 96 ? G : 96);
            REPS(17) for (int it = first; it < 128; it += step) s5_tables_block(s5, it >> 2, it & 3, (bf16_t*)((char*)a.out + OUT_W1), (bf16_t*)((char*)a.out + OUT_B3), (float*)(ws + WS_A32), lds, tid);
        }
        LAS float* scr = (LAS float*)(lds + wave * 16384);
        constexpr int I_IN = (DM / 64) * (DIN / 32), I_SQ = (DM / 64) * (DM / 32), I_GLU = (512 / 64) * (2048 / 32), I_UP = (DM / 64) * (NUP / 32), I_DN = (DFF / 64) * (DM / 32);
        constexpr int NITEMS = I_IN + 2 * I_SQ + I_GLU + I_UP + I_DN;
        REPS(18) for (int it = gw; it < NITEMS; it += NGW) {
            int r = it;
            if (r < I_IN) { transpose_item<0>(a.in[8], DM, DIN, WTin, scr, r, lane); continue; } r -= I_IN;
            if (r < I_SQ) { transpose_item<0>(a.in[11], DM, DM, WTbr, scr, r, lane); continue; } r -= I_SQ;
            if (r < I_GLU) { transpose_item<2>(a.in[20], 512, 2048, WTglu, scr, r, lane); continue; } r -= I_GLU;
            if (r < I_SQ) { transpose_item<0>(a.in[21], DM, DM, WTout, scr, r, lane); continue; } r -= I_SQ;
            if (r < I_UP) { transpose_item<1>(a.in[22], DM, NUP, WTup, scr, r, lane); continue; } r -= I_UP;
            transpose_item<0>(a.in[25], DFF, DM, WTdn, scr, r, lane);
        }
    }
    SEAM(0);
    if (IN(1)) REPS(1) { PHASE_IDS;
        for (int L = bx; L < 64; L += G) {
            const int r0 = ML + 256 * (L >> 2);
            for (int r = r0 + 4 * wave; r < r0 + 256; r += 4 * NWV) norm_mod_rows4(a.in[2] + (size_t)(r - ML) * DM, a.in[6], mod + (size_t)NB * 6144, mod + (size_t)NB * 6144 + 1024, H + (size_t)r * DM, lane);
            asm volatile("s_waitcnt vmcnt(0)" ::: "memory"); __syncthreads();
            pg8::Gemm g{H, WTin, DM, DM, DM, 0, 0, 0}; OrderOne S{{128 + (L >> 2), 4 + (L & 3), 0}}; EpiAfast E{Q, Kb, Vb, Ucat, SG, a.in[9], a.in[10], (LAS float*)(lds + 131072)};
            pg8::gemm_phase<EpiAfast, OrderOne>(lds, g, S, E, wave);
        }
        { const int nb = G > 64 ? G - 64 : G, ib = G > 64 ? bx - 64 : bx;
          if (ib >= 0) for (int r = 4 * (ib * NWV + wave); r < ML; r += 4 * nb * NWV) { const int mb = r / SEQ; norm_mod_rows4(a.in[0] + (size_t)r * DM, a.in[6], mod + (size_t)mb * 6144, mod + (size_t)mb * 6144 + 1024, H + (size_t)r * DM, lane); } }
    }
    SEAM(1);
    if (IN(2)) REPS(2) {
        pg8::Gemm g{H, WTin, DM, DM, DM, 0, 0, 0}; OrderRect S; S.so.init(ML / 256, DIN / 256, G, bx);
        EpiAfast E{Q, Kb, Vb, Ucat, SG, a.in[9], a.in[10], (LAS float*)(lds + 131072)};
        pg8::gemm_phase<EpiAfast, OrderRect>(lds, g, S, E, wave);
    }
    SEAM(2);
    if (IN(4)) REPS(4) {
#if !S5_NAIVE
        { pg8::Gemm g{Ucat, (const bf16_t*)((char*)a.out + OUT_W1), KCAT, 512, 512, (size_t)UROWS * KCAT * 2, (size_t)256 * 512 * 2, 0}; OrderS1 S{G, bx}; EpiS1 E{(float*)((char*)a.out + OUT_L)}; pg8::gemm_phase<EpiS1, OrderS1>(lds, g, S, E, wave); }
#endif
        const int nrounds = (NB * 2 * 32 + G - 1) / G;
        for (int i = 0; i < nrounds; ++i) {
            int unit; if (G == 256) { const int bk = i * 8 + (bx & 7), s = bx >> 3; unit = bk * 32 + s; } else unit = i * G + bx;
            if (unit >= NB * 2 * 32) break;
            const int bk = unit >> 5, s = unit & 31, b = bk >> 1, kvh = bk & 1, h = kvh * 4 + (s >> 3), qb = s & 7;
            const size_t q0 = ((size_t)b * SEQ + (size_t)qb * 256) * 1024 + h * 128, k0 = (size_t)b * LKV * 256 + kvh * 128;
            att::attn_dense_body(Q + q0, Kb + k0, Vb + k0, O + q0, LKV, (char*)lds_raw, wave);
        }
    }
    SEAM(4);
    if (IN(5)) REPS(5) { PHASE_IDS;
#if S5_NAIVE
        S5In s5{a.in[12], a.in[13], a.in[14], a.in[15], a.in[16], a.in[17], a.in[18], a.in[19]};
        for (int it = bx * 2 + wave; wave < 2 && it < NB * NG; it += G * 2) s5_naive_wave(s5, Ucat, Uctx, Ytmp, SSM, lane, it & 31, it >> 5);
#else
        const float* Lb = (const float*)((char*)a.out + OUT_L); const float* A32 = (const float*)(ws + WS_A32);
        for (int un = bx; un < 256; un += G) {
            const int g = un >> 3, pm = (un >> 1) & 3, pn = un & 1;
            REPS(19) { const int bl = tid >> 7, d = (tid >> 6) & 1, n = tid & 63, b = pm * 4 + bl;
              const float ar = A32[((d * NG + g) * NS + n) * 2], ai = A32[((d * NG + g) * NS + n) * 2 + 1];
              const float* Lg = Lb + (size_t)g * UROWS * 256 + sidx(d, 0, n); bf16_t* Sg = Ucat + (size_t)g * UROWS * KCAT + 512 + sidx(d, 0, n);
              float sr = 0.f, si = 0.f;
              { float lr[8], li[8];
#pragma unroll
                for (int i = 0; i < 8; ++i) { const int row = 1024 + b * 8 + (d == 0 ? i : 7 - i); lr[i] = Lg[(size_t)row * 256]; li[i] = Lg[(size_t)row * 256 + 64]; }
#pragma unroll
                for (int i = 0; i < 8; ++i) { const float t0 = ar * sr - ai * si + lr[i], t1 = ar * si + ai * sr + li[i]; sr = t0; si = t1; } }
#pragma unroll 1
              for (int i0 = 0; i0 < 64; i0 += 32) { float lr[32], li[32];
#pragma unroll
                  for (int i = 0; i < 32; ++i) { const int row = b * 64 + (d == 0 ? i0 + i : 63 - i0 - i); lr[i] = Lg[(size_t)row * 256]; li[i] = Lg[(size_t)row * 256 + 64]; }
#pragma unroll
                  for (int i = 0; i < 32; ++i) { const int row = b * 64 + (d == 0 ? i0 + i : 63 - i0 - i);
                      Sg[(size_t)row * KCAT] = f2bf(sr); Sg[(size_t)row * KCAT + 64] = f2bf(si);
                      const float t0 = ar * sr - ai * si + lr[i], t1 = ar * si + ai * sr + li[i]; sr = t0; si = t1; } }
              asm volatile("s_waitcnt vmcnt(0)" ::: "memory"); __syncthreads(); }
            pg8::Gemm gm{Ucat, (const bf16_t*)((char*)a.out + OUT_B3), KCAT, KCAT, KCAT, (size_t)UROWS * KCAT * 2, (size_t)512 * KCAT * 2, 0}; OrderOne S{{pm, pn, g}}; EpiS3 E{SSM};
            REPS(20) pg8::gemm_phase<EpiS3, OrderOne>(lds, gm, S, E, wave);
        }
#endif
    }
    SEAM(5);
    if (IN(6)) REPS(6) { pg8::Gemm g{SSM, WTglu, 512, 512, 512, 0, 0, 1}; OrderRect S; S.so.init(ML / 256, 2048 / 256, G, bx); EpiGluPair E{SG, GLU}; pg8::gemm_phase<EpiGluPair, OrderRect>(lds, g, S, E, wave); }
    SEAM(6);
    if (IN(7)) REPS(7) { pg8::Gemm g{O, WTbr, DM, DM, DM, 0, 0, 0}; OrderRect S; S.so.init(ML / 256, DM / 256, G, bx); EpiMergeFast E{SG, GLU, MG}; pg8::gemm_phase<EpiMergeFast, OrderRect>(lds, g, S, E, wave); }
    SEAM(7);
    if (IN(8)) REPS(8) { pg8::Gemm g{MG, WTout, DM, DM, DM, 0, 0, 0}; OrderRect S; S.so.init(ML / 256, DM / 256, G, bx); EpiResNorm<1> E{a.in[0], out, mod + 2048, a.in[7], (unsigned*)(ws + WS_XS2), (unsigned*)(ws + WS_CTL + 65536), (LAS float*)(lds + 131072), H2, mod + 3072, mod + 4096}; pg8::gemm_phase<EpiResNorm<1>, OrderRect>(lds, g, S, E, wave); }
    SEAM(8);
    if (IN(10)) REPS(10) { pg8::Gemm g{H2, WTup, DM, DM, DM, 0, 0, 2}; OrderRect S; S.so.init(ML / 256, NUP / 256, G, bx);
        EpiUpConv E{Ab, (float*)(ws + WS_HALO), a.in[23], a.in[24], (LAS float*)(lds + 131072), (LAS float*)(lds + 131072 + 8192)}; pg8::gemm_phase<EpiUpConv, OrderRect>(lds, g, S, E, wave); }
    SEAM(10);
    if (IN(14)) { PHASE_IDS; pg8::Gemm g{Ab, WTdn, DFF, DFF, DFF, 0, 0, 0}; OrderRect S; S.so.init(ML / 256, DM / 256, G, bx);
        { pg8::Unit u; for (int i = 0; S.next(i, u); ++i) conv_fix_panel(u.pm, (const float*)(ws + WS_HALO), a.in[23], Ab, tid); asm volatile("s_waitcnt vmcnt(0)" ::: "memory"); __syncthreads(); }
        EpiResNorm<0> E{out, out, mod + 5120, a.in[26], (unsigned*)(ws + WS_XS), (unsigned*)(ws + WS_CTL + 16384), (LAS float*)(lds + 131072), nullptr, nullptr, nullptr}; pg8::gemm_phase<EpiResNorm<0>, OrderRect>(lds, g, S, E, wave); }
#undef IN
#undef SEAM
#undef mod
#undef WTin
#undef WTbr
#undef WTglu
#undef WTout
#undef WTup
#undef WTdn
#undef H
#undef Q
#undef Kb
#undef Vb
#undef Ucat
#undef Uctx
#undef SG
#undef O
#undef SSM
#undef GLU
#undef MG
#undef H2
#undef Ab
#undef Ytmp
}

extern "C" void kernel_launch(void* const* d_in, const int* in_sizes, int n_in, void* d_out, int out_size, void* d_ws, size_t ws_size, hipStream_t stream) {
    static int grid_blocks = 0;
    if (grid_blocks == 0) {
        if (n_in != 27 || in_sizes[0] != ML * DM || out_size != ML * DM || ws_size < WS_NEED) {
            fprintf(stderr, "kernel_launch: unexpected shapes: n_in %d in0 %d out %d ws %zu (need >= %zu)\n", n_in, n_in > 0 ? in_sizes[0] : -1, out_size, ws_size, (size_t)WS_NEED); grid_blocks = -1; return; }
        int dev = 0, cus = 0, per_cu = 0;
        if (hipGetDevice(&dev) != hipSuccess || hipDeviceGetAttribute(&cus, hipDeviceAttributeMultiprocessorCount, dev) != hipSuccess) { fprintf(stderr, "kernel_launch: device query failed\n"); grid_blocks = -1; return; }
        if (hipFuncSetAttribute((const void*)mk_fwd, hipFuncAttributeMaxDynamicSharedMemorySize, MK_LDS) != hipSuccess) { fprintf(stderr, "kernel_launch: hipFuncSetAttribute(mk_fwd) failed\n"); grid_blocks = -1; return; }
        if (hipOccupancyMaxActiveBlocksPerMultiprocessor(&per_cu, (const void*)mk_fwd, NWV * 64, MK_LDS) != hipSuccess || per_cu < 1) { fprintf(stderr, "kernel_launch: occupancy query says %d blocks/CU\n", per_cu); grid_blocks = -1; return; }
        grid_blocks = cus;
    }
    if (grid_blocks < 0) return;
    if (hipMemsetAsync((char*)d_ws + WS_CTL, 0, 131072, stream) != hipSuccess) fprintf(stderr, "kernel_launch: memset failed\n");
    MkArgs a{};
    for (int i = 0; i < 27; ++i) a.in[i] = (const float*)d_in[i];
    a.out = (float*)d_out; a.ws = (unsigned char*)d_ws; a.ph_lo = 0; a.ph_hi = 16;
    void* args[] = {&a};
    hipError_t e = hipLaunchCooperativeKernel((const void*)mk_fwd, dim3(grid_blocks), dim3(NWV * 64), args, MK_LDS, stream);
    if (e != hipSuccess) fprintf(stderr, "kernel_launch: cooperative launch failed: %s (grid %d)\n", hipGetErrorString(e), grid_blocks);
}
```

```cpp
#include <hip/hip_runtime.h>
#include <cstdio>
#include <cstdint>

typedef unsigned short bf16_t;
typedef short bf16x8 __attribute__((ext_vector_type(8)));
typedef short s16x4 __attribute__((ext_vector_type(4)));
typedef float f32x4 __attribute__((ext_vector_type(4)));
typedef float f32x16 __attribute__((ext_vector_type(16)));
typedef unsigned u32x4 __attribute__((ext_vector_type(4)));
typedef unsigned u32x2 __attribute__((ext_vector_type(2)));
typedef float f32x2 __attribute__((ext_vector_type(2)));

constexpr int NB = 16, SEQ = 2048, DM = 1024, LC = 256, LKV = LC + SEQ;
constexpr int ML = NB * SEQ, MC = NB * LC, MT = ML + MC;
constexpr int DIN = 4096, DFF = 2816, NUP = 2 * DFF;
constexpr int NG = 32, NS = 64, PG = 16;
constexpr int TCH = 32, NCH = SEQ / TCH, KCAT = TCH * PG + 256;
constexpr int UROWS = 1280;
constexpr float EPS = 1e-6f;

constexpr size_t MiB = 1u << 20;
constexpr size_t WS_CTL = 0, WS_MOD = 1 * MiB;
constexpr size_t WS_WIN = 16 * MiB, WS_WBR = 24 * MiB, WS_WGLU = 26 * MiB, WS_WOUT = 28 * MiB, WS_WUP = 30 * MiB, WS_WDN = 41 * MiB;
constexpr size_t WS_H = 48 * MiB;
constexpr size_t WS_Q = 120 * MiB;
constexpr size_t WS_K = 184 * MiB;
constexpr size_t WS_V = 202 * MiB;
constexpr size_t WS_UCAT = 220 * MiB;
constexpr size_t WS_SG = 280 * MiB;
constexpr size_t WS_O = 408 * MiB;
constexpr size_t WS_SSM = 472 * MiB;
constexpr size_t WS_A32 = 2 * MiB;
constexpr size_t OUT_W1 = 0, OUT_B3 = 8 * MiB, OUT_L = 32 * MiB;
constexpr size_t WS_YTMP = 48 * MiB;
constexpr size_t WS_GLU = 48 * MiB;
constexpr size_t WS_H2 = 48 * MiB;
constexpr size_t WS_A = 112 * MiB;
constexpr size_t WS_HALO = 368 * MiB;
constexpr size_t WS_XS = 380 * MiB;
constexpr size_t WS_XS2 = 381 * MiB;
constexpr size_t WS_X1B = 280 * MiB;
constexpr int A_SPLIT_PM = 122; constexpr size_t A_HI_SHIFT = 384 * MiB - (112 * MiB + (size_t)A_SPLIT_PM * 44 * 32768);
constexpr size_t WS_NEED = 512 * MiB;

__device__ __forceinline__ int opaque_tid(int wave) { int t = wave * 64 + (int)__builtin_amdgcn_mbcnt_hi(~0u, __builtin_amdgcn_mbcnt_lo(~0u, 0u)); asm volatile("" : "+v"(t)); return t; }
__device__ __forceinline__ float bf2f(bf16_t v) { return __uint_as_float(((unsigned)v) << 16); }
typedef __bf16 bf16v2_t __attribute__((ext_vector_type(2)));
__device__ __forceinline__ unsigned pk2(float lo, float hi) { const f32x2 v = {lo, hi}; return __builtin_bit_cast(unsigned, __builtin_convertvector(v, bf16v2_t)); }
__device__ __forceinline__ bf16_t f2bf(float f) { return (bf16_t)(pk2(f, f) & 0xffffu); }
__device__ __forceinline__ float sigmoidf_(float x) { return __builtin_amdgcn_rcpf(1.f + __expf(-x)); }
__device__ __forceinline__ float siluf_(float x) { return x * __builtin_amdgcn_rcpf(1.f + __expf(-x)); }
__device__ __forceinline__ float gelu_tanh(float x) { const float u = 0.7978845608028654f * (x + 0.044715f * x * x * x); return x * __builtin_amdgcn_rcpf(1.f + __expf(-2.f * u)); }
__device__ __forceinline__ float wave_sum(float v) {
#pragma unroll
    for (int o = 1; o < 64; o <<= 1) v += __shfl_xor(v, o);
    return v;
}
__device__ __forceinline__ size_t ucat_idx(int b, int t, int ch) { const int g = ch >> 4, q = ch & 15, c = t >> 5, j = t & 31; return ((size_t)(g * UROWS + b * NCH + c)) * KCAT + j * PG + q; }
__device__ __forceinline__ size_t ucat_ctx_idx(int b, int tc, int ch) { const int g = ch >> 4, q = ch & 15, c = tc >> 5, j = tc & 31; return ((size_t)(g * UROWS + 1024 + b * 8 + c)) * KCAT + j * PG + q; }

__device__ __forceinline__ void qk_norm_rope_row(bf16_t* p, const float* __restrict__ w, int pos, int lane) {
    const unsigned raw = *(const unsigned*)(p + 2 * lane);
    const float v0 = bf2f((bf16_t)(raw & 0xffff)), v1 = bf2f((bf16_t)(raw >> 16));
    const float rs = rsqrtf(wave_sum(v0 * v0 + v1 * v1) * (1.f / 128.f) + EPS);
    float y0 = v0 * rs * w[2 * lane], y1 = v1 * rs * w[2 * lane + 1];
    if (pos >= 0) {
        const float coord = (lane < 32) ? (float)(pos >> 6) : (float)(pos & 63);
        const float invf = exp2f(-(float)(2 * (lane & 31)) * (13.287712379549449f / 64.f));
        const float ang = coord * invf; const float cs = cosf(ang), sn = sinf(ang);
        const float o0 = y0 * cs - y1 * sn, o1 = y0 * sn + y1 * cs; y0 = o0; y1 = o1;
    }
    *(unsigned*)(p + 2 * lane) = (unsigned)f2bf(y0) | ((unsigned)f2bf(y1) << 16);
}
__device__ __forceinline__ size_t blk16x32(int pm, int KT, int kt, int half, int rb8, int kb2) { return ((((((size_t)pm * KT + kt) * 2 + half) * 8 + rb8) * 2 + kb2)) * 1024; }
namespace att {
constexpr int D = 128, NW = 8, QBLK = 32, KVBLK = 64;
constexpr float SCALE = 0.088388347648318440f;
constexpr float THR = 8.f;
#ifndef ATT_SDEPTH
#define ATT_SDEPTH 2
#endif
constexpr int LDQ = 1024, LDK = 256, LDO = 1024;
constexpr size_t SHM_V = KVBLK * D * 2, SHM_K = KVBLK * D * 2, SHM_ATTN = 2 * SHM_V + 2 * SHM_K + NW * 64 * 4;
#define KSWZ(row, colB) ((row) * 256 + ((colB) ^ (((row) & 7) << 4)))
#define SBAR() __builtin_amdgcn_sched_barrier(0)
__device__ __forceinline__ int crow(int r, int hi) { return (r & 3) + 8 * (r >> 2) + 4 * hi; }
__device__ __forceinline__ unsigned cvtpk(float lo, float hi) { unsigned r; asm volatile("v_cvt_pk_bf16_f32 %0, %1, %2" : "=v"(r) : "v"(lo), "v"(hi)); return r; }
__device__ __forceinline__ void partialSM(f32x16& p0, f32x16& p1, float& m_reg, float& mn, float& alpha) {
    constexpr float C = SCALE * 1.4426950408889634f;
    float pmax = p0[0]; for (int r = 1; r < 16; ++r) pmax = fmaxf(pmax, p0[r]); for (int r = 0; r < 16; ++r) pmax = fmaxf(pmax, p1[r]);
    { auto rr = __builtin_amdgcn_permlane32_swap(__float_as_uint(pmax), __float_as_uint(pmax), false, false);
      pmax = fmaxf(__uint_as_float(rr[0]), __uint_as_float(rr[1])); }
    if (__builtin_expect(__all(pmax - m_reg <= THR / SCALE), 1)) { mn = m_reg; alpha = 1.f; }
    else { mn = fmaxf(m_reg, pmax); alpha = __builtin_amdgcn_exp2f((m_reg - mn) * C); m_reg = mn; }
    float mnC = -mn * C;
    for (int r = 0; r < 16; ++r) p0[r] = fmaf(p0[r], C, mnC); for (int r = 0; r < 16; ++r) p1[r] = fmaf(p1[r], C, mnC);
    for (int r = 0; r < 16; ++r) p0[r] = __builtin_amdgcn_exp2f(p0[r]);
}
__device__ __forceinline__ void finishSM(f32x16& p0, f32x16& p1, float alpha, float& l_reg, bf16x8& pa0, bf16x8& pa1, bf16x8& pa2, bf16x8& pa3) {
    for (int r = 0; r < 16; ++r) p1[r] = __builtin_amdgcn_exp2f(p1[r]);
    float ps = 0; for (int r = 0; r < 16; ++r) ps += p0[r]; for (int r = 0; r < 16; ++r) ps += p1[r];
    { auto rr = __builtin_amdgcn_permlane32_swap(__float_as_uint(ps), __float_as_uint(ps), false, false);
      ps = __uint_as_float(rr[0]) + __uint_as_float(rr[1]); }
    l_reg = l_reg * alpha + ps;
#define PK4(P, BASE, OUT) do { unsigned a0 = cvtpk(P[BASE + 0], P[BASE + 1]), a1 = cvtpk(P[BASE + 2], P[BASE + 3]);   \
    unsigned b0 = cvtpk(P[BASE + 4], P[BASE + 5]), b1 = cvtpk(P[BASE + 6], P[BASE + 7]);                              \
    auto r0 = __builtin_amdgcn_permlane32_swap(a0, b0, false, false); auto r1 = __builtin_amdgcn_permlane32_swap(a1, b1, false, false); \
    u32x4 w = {r0[0], r1[0], r0[1], r1[1]}; OUT = *reinterpret_cast<bf16x8*>(&w); } while (0)
    PK4(p0, 0, pa0); PK4(p0, 8, pa1); PK4(p1, 0, pa2); PK4(p1, 8, pa3);
#undef PK4
}
__device__ __forceinline__ void qkt(f32x16& p0, f32x16& p1, const bf16_t* Ks, const bf16x8* qr, int r32, int hi) {
    p0 = f32x16{}; p1 = f32x16{};
    for (int d0 = 0; d0 < 8; ++d0) { int cb = (d0 * 16 + hi * 8) * 2;
        bf16x8 b0 = *reinterpret_cast<const bf16x8*>((const char*)Ks + KSWZ(r32, cb));
        bf16x8 b1 = *reinterpret_cast<const bf16x8*>((const char*)Ks + KSWZ(32 + r32, cb));
        p0 = __builtin_amdgcn_mfma_f32_32x32x16_bf16(b0, qr[d0], p0, 0, 0, 0);
        p1 = __builtin_amdgcn_mfma_f32_32x32x16_bf16(b1, qr[d0], p1, 0, 0, 0); }
}
__device__ __forceinline__ int v_st(int k, int c) { const int kk = (k & ~0xC) | ((k & 4) << 1) | ((k & 8) >> 1); return ((kk >> 3) * 4 + (c >> 5)) * 512 + ((kk & 7) * 32 + (c & 31)) * 2; }
__device__ __forceinline__ int v_rd_base(int lane) { return ((lane & 3) << 3) | (((lane >> 2) & 3) << 6) | (((lane >> 4) & 1) << 5) | (((lane >> 5) & 1) << 8); }
constexpr int v_rd_off(int d0, int ks, int half) { return d0 * 512 + ks * 4096 + half * 2048; }
template <int OFF> __device__ __forceinline__ s16x4 tr_read(int vb) {
    s16x4 r; asm volatile("ds_read_b64_tr_b16 %0, %1 offset:%2" : "=&v"(r) : "v"(vb), "i"(OFF) : "memory"); return r;
}
template <int D0> __device__ __forceinline__ void pv_one(f32x16& od, int vb, bf16x8 pa0, bf16x8 pa1, bf16x8 pa2, bf16x8 pa3) {
    const s16x4 l0 = tr_read<v_rd_off(D0, 0, 0)>(vb), h0 = tr_read<v_rd_off(D0, 0, 1)>(vb), l1 = tr_read<v_rd_off(D0, 1, 0)>(vb), h1 = tr_read<v_rd_off(D0, 1, 1)>(vb);
    const s16x4 l2 = tr_read<v_rd_off(D0, 2, 0)>(vb), h2 = tr_read<v_rd_off(D0, 2, 1)>(vb), l3 = tr_read<v_rd_off(D0, 3, 0)>(vb), h3 = tr_read<v_rd_off(D0, 3, 1)>(vb);
    asm volatile("s_waitcnt lgkmcnt(0)" ::: "memory"); SBAR();
#define PK(L, H) (bf16x8){L[0], L[1], L[2], L[3], H[0], H[1], H[2], H[3]}
    od = __builtin_amdgcn_mfma_f32_32x32x16_bf16(pa0, PK(l0, h0), od, 0, 0, 0);
    od = __builtin_amdgcn_mfma_f32_32x32x16_bf16(pa1, PK(l1, h1), od, 0, 0, 0);
    od = __builtin_amdgcn_mfma_f32_32x32x16_bf16(pa2, PK(l2, h2), od, 0, 0, 0);
    od = __builtin_amdgcn_mfma_f32_32x32x16_bf16(pa3, PK(l3, h3), od, 0, 0, 0);
#undef PK
}
__device__ __forceinline__ void pv_d0(f32x16* o, int vb, bf16x8 pa0, bf16x8 pa1, bf16x8 pa2, bf16x8 pa3) {
    pv_one<0>(o[0], vb, pa0, pa1, pa2, pa3); pv_one<1>(o[1], vb, pa0, pa1, pa2, pa3); pv_one<2>(o[2], vb, pa0, pa1, pa2, pa3); pv_one<3>(o[3], vb, pa0, pa1, pa2, pa3);
}
__device__ __forceinline__ void qkt_fsm(f32x16& pn0, f32x16& pn1, const bf16_t* Ks, const bf16x8* qr, int r32, int hi, f32x16& pp0, f32x16& pp1, float alpha, float& l_reg, bf16x8& pa0, bf16x8& pa1, bf16x8& pa2, bf16x8& pa3) {
#define QF_READ(D0, B0, B1) const bf16x8 B0 = *reinterpret_cast<const bf16x8*>((const char*)Ks + KSWZ(r32, ((D0) * 16 + hi * 8) * 2)), B1 = *reinterpret_cast<const bf16x8*>((const char*)Ks + KSWZ(32 + r32, ((D0) * 16 + hi * 8) * 2))
#define QF_MMA(D0, B0, B1) do { pn0 = __builtin_amdgcn_mfma_f32_32x32x16_bf16(B0, qr[D0], pn0, 0, 0, 0); pn1 = __builtin_amdgcn_mfma_f32_32x32x16_bf16(B1, qr[D0], pn1, 0, 0, 0); } while (0)
    pn0 = f32x16{}; pn1 = f32x16{};
    QF_READ(0, k00, k01); QF_READ(1, k10, k11);
    QF_MMA(0, k00, k01); QF_READ(2, k20, k21);
#pragma unroll
    for (int r = 0; r < 4; ++r) pp1[r] = __builtin_amdgcn_exp2f(pp1[r]);
    asm volatile("" : "+v"(pp1)); SBAR();
    QF_MMA(1, k10, k11); QF_READ(3, k30, k31);
#pragma unroll
    for (int r = 4; r < 8; ++r) pp1[r] = __builtin_amdgcn_exp2f(pp1[r]);
    asm volatile("" : "+v"(pp1)); SBAR();
    QF_MMA(2, k20, k21); QF_READ(4, k40, k41);
#pragma unroll
    for (int r = 8; r < 12; ++r) pp1[r] = __builtin_amdgcn_exp2f(pp1[r]);
    asm volatile("" : "+v"(pp1)); SBAR();
    QF_MMA(3, k30, k31); QF_READ(5, k50, k51);
#pragma unroll
    for (int r = 12; r < 16; ++r) pp1[r] = __builtin_amdgcn_exp2f(pp1[r]);
    asm volatile("" : "+v"(pp1)); SBAR();
    QF_MMA(4, k40, k41); QF_READ(6, k60, k61);
    float ps = 0;
#pragma unroll
    for (int r = 0; r < 16; ++r) ps += pp0[r];
    asm volatile("" : "+v"(ps)); SBAR();
    QF_MMA(5, k50, k51); QF_READ(7, k70, k71);
#pragma unroll
    for (int r = 0; r < 16; ++r) ps += pp1[r];
    { auto rr = __builtin_amdgcn_permlane32_swap(__float_as_uint(ps), __float_as_uint(ps), false, false);
      ps = __uint_as_float(rr[0]) + __uint_as_float(rr[1]);
      l_reg = l_reg * alpha + ps; }
    asm volatile("" : "+v"(l_reg)); SBAR();
#define PK4(P, BASE, OUT) do { unsigned a0 = cvtpk(P[BASE + 0], P[BASE + 1]), a1 = cvtpk(P[BASE + 2], P[BASE + 3]);   \
    unsigned b0 = cvtpk(P[BASE + 4], P[BASE + 5]), b1 = cvtpk(P[BASE + 6], P[BASE + 7]);                              \
    auto r0 = __builtin_amdgcn_permlane32_swap(a0, b0, false, false); auto r1 = __builtin_amdgcn_permlane32_swap(a1, b1, false, false); \
    u32x4 w = {r0[0], r1[0], r0[1], r1[1]}; OUT = *reinterpret_cast<bf16x8*>(&w); } while (0)
    QF_MMA(6, k60, k61);
    PK4(pp0, 0, pa0); PK4(pp0, 8, pa1);
    asm volatile("" : "+v"(pa0), "+v"(pa1)); SBAR();
    QF_MMA(7, k70, k71);
    PK4(pp1, 0, pa2); PK4(pp1, 8, pa3);
#undef PK4
    asm volatile("" : "+v"(pa2), "+v"(pa3));
#undef QF_READ
#undef QF_MMA
}
__device__ __forceinline__ void pv_sm(f32x16* o, int vb, bf16x8 pa0, bf16x8 pa1, bf16x8 pa2, bf16x8 pa3, f32x16& p0, f32x16& p1, float& m_reg, float& mn, float& alpha) {
    constexpr float C = SCALE * 1.4426950408889634f;
#define PVS_READ(D0, L0, H0, L1, H1, L2, H2, L3, H3) const s16x4 L0 = tr_read<v_rd_off(D0, 0, 0)>(vb), H0 = tr_read<v_rd_off(D0, 0, 1)>(vb), L1 = tr_read<v_rd_off(D0, 1, 0)>(vb), H1 = tr_read<v_rd_off(D0, 1, 1)>(vb), \
        L2 = tr_read<v_rd_off(D0, 2, 0)>(vb), H2 = tr_read<v_rd_off(D0, 2, 1)>(vb), L3 = tr_read<v_rd_off(D0, 3, 0)>(vb), H3 = tr_read<v_rd_off(D0, 3, 1)>(vb)
#define PVS_PK(L, H) (bf16x8){L[0], L[1], L[2], L[3], H[0], H[1], H[2], H[3]}
#define PVS_MMA(D0, L0, H0, L1, H1, L2, H2, L3, H3) do { o[D0] = __builtin_amdgcn_mfma_f32_32x32x16_bf16(pa0, PVS_PK(L0, H0), o[D0], 0, 0, 0); o[D0] = __builtin_amdgcn_mfma_f32_32x32x16_bf16(pa1, PVS_PK(L1, H1), o[D0], 0, 0, 0); \
        o[D0] = __builtin_amdgcn_mfma_f32_32x32x16_bf16(pa2, PVS_PK(L2, H2), o[D0], 0, 0, 0); o[D0] = __builtin_amdgcn_mfma_f32_32x32x16_bf16(pa3, PVS_PK(L3, H3), o[D0], 0, 0, 0); } while (0)
#define PVS_GO() do { asm volatile("s_waitcnt lgkmcnt(0)" ::: "memory"); SBAR(); } while (0)
    PVS_READ(0, a0, b0, a1, b1, a2, b2, a3, b3); PVS_GO();
    PVS_MMA(0, a0, b0, a1, b1, a2, b2, a3, b3);
    float pmax = p0[0];
#pragma unroll
    for (int r = 1; r < 16; ++r) pmax = fmaxf(pmax, p0[r]);
    PVS_READ(1, c0, d0, c1, d1, c2, d2, c3, d3); asm volatile("" : "+v"(pmax)); PVS_GO();
    PVS_MMA(1, c0, d0, c1, d1, c2, d2, c3, d3);
#pragma unroll
    for (int r = 0; r < 16; ++r) pmax = fmaxf(pmax, p1[r]);
    { auto rr = __builtin_amdgcn_permlane32_swap(__float_as_uint(pmax), __float_as_uint(pmax), false, false);
      pmax = fmaxf(__uint_as_float(rr[0]), __uint_as_float(rr[1])); }
    { const bool keep = __all(pmax - m_reg <= THR / SCALE);
      const float mx = fmaxf(m_reg, pmax);
      mn = keep ? m_reg : mx; alpha = keep ? 1.f : __builtin_amdgcn_exp2f((m_reg - mx) * C); m_reg = mn; }
    float mnC = -mn * C;
    PVS_READ(2, e0, f0, e1, f1, e2, f2, e3, f3); asm volatile("" : "+v"(mnC), "+v"(alpha)); PVS_GO();
    PVS_MMA(2, e0, f0, e1, f1, e2, f2, e3, f3);
#pragma unroll
    for (int r = 0; r < 16; ++r) p0[r] = fmaf(p0[r], C, mnC);
#pragma unroll
    for (int r = 0; r < 8; ++r) p0[r] = __builtin_amdgcn_exp2f(p0[r]);
    PVS_READ(3, g0, h0, g1, h1, g2, h2, g3, h3); asm volatile("" : "+v"(p0)); PVS_GO();
    PVS_MMA(3, g0, h0, g1, h1, g2, h2, g3, h3);
#pragma unroll
    for (int r = 0; r < 16; ++r) p1[r] = fmaf(p1[r], C, mnC);
#pragma unroll
    for (int r = 8; r < 16; ++r) p0[r] = __builtin_amdgcn_exp2f(p0[r]);
    asm volatile("" : "+v"(p0), "+v"(p1));
#undef PVS_READ
#undef PVS_PK
#undef PVS_MMA
#undef PVS_GO
}
__device__ __forceinline__ void attn_dense_body(const bf16_t* __restrict__ Qb, const bf16_t* __restrict__ Kh, const bf16_t* __restrict__ Vh, bf16_t* __restrict__ Ob, int seq, char* lds, int wave_id, int o_pm, int o_h) {
    const int tid = opaque_tid(wave_id), wid = tid >> 6, lane = tid & 63, r32 = lane & 31, hi = lane >> 5;
    bf16_t* V_lds = (bf16_t*)lds; bf16_t* K_lds = (bf16_t*)(lds + 2 * SHM_V);
    float* ws = (float*)(lds + 2 * SHM_V + 2 * SHM_K) + wid * 64; float* li_l = ws; float* al_l = ws + 32;
    float m_reg = -1e30f, l_reg = 0; f32x16 o[4] = {}; bf16x8 qr[8];
    const bf16_t* Qw = Qb + (long)(wid * QBLK + r32) * LDQ + hi * 8;
#pragma unroll
    for (int d0 = 0; d0 < 8; ++d0) qr[d0] = *reinterpret_cast<const bf16x8*>(Qw + d0 * 16);
    const int sr = tid >> 4, sc = (tid & 15) * 8, vst0 = v_st(sr, sc), vst1 = v_st(32 + sr, sc);
    const int vb0 = (int)(uintptr_t)V_lds + v_rd_base(lane);
    constexpr int SDEPTH = ATT_SDEPTH;
    struct { bf16x8 vs0, vs1, ks0, ks1; } sr_[SDEPTH];
    typedef const __attribute__((address_space(1))) char* gcp;
    gcp Vu, Ku;
    { const unsigned long long v_ = (unsigned long long)Vh, k_ = (unsigned long long)Kh;
      Vu = (gcp)(((unsigned long long)(unsigned)__builtin_amdgcn_readfirstlane((unsigned)(v_ >> 32)) << 32) | (unsigned)__builtin_amdgcn_readfirstlane((unsigned)v_));
      Ku = (gcp)(((unsigned long long)(unsigned)__builtin_amdgcn_readfirstlane((unsigned)(k_ >> 32)) << 32) | (unsigned)__builtin_amdgcn_readfirstlane((unsigned)k_)); }
    const unsigned vofs = (unsigned)(sr * LDK + sc) * 2u;
    typedef const __attribute__((address_space(1))) bf16x8* gv8p;
#define SLOAD(i, k0) do { gcp vb_ = Vu + (size_t)(k0) * (LDK * 2); gcp kb_ = Ku + (size_t)(k0) * (LDK * 2); \
    sr_[i].vs0 = *(gv8p)(vb_ + vofs); sr_[i].vs1 = *(gv8p)(vb_ + 32 * LDK * 2 + vofs); \
    sr_[i].ks0 = *(gv8p)(kb_ + vofs); sr_[i].ks1 = *(gv8p)(kb_ + 32 * LDK * 2 + vofs); } while (0)
#define SWRITE(b, i) do { *(bf16x8*)((char*)V_lds + (b) * SHM_V + vst0) = sr_[i].vs0;          \
    *(bf16x8*)((char*)V_lds + (b) * SHM_V + vst1) = sr_[i].vs1; int kc = sc * 2;               \
    *(bf16x8*)((char*)K_lds + (b) * SHM_K + KSWZ(sr, kc)) = sr_[i].ks0;                       \
    *(bf16x8*)((char*)K_lds + (b) * SHM_K + KSWZ(32 + sr, kc)) = sr_[i].ks1; } while (0)
#define SWAIT() do { if constexpr (SDEPTH == 2) asm volatile("s_waitcnt vmcnt(4)" ::: "memory"); else asm volatile("s_waitcnt vmcnt(0)" ::: "memory"); } while (0)
#define RESC(a) do { if (__any((a) < 1.f)) { if (hi == 0) al_l[r32] = (a); asm volatile("s_waitcnt lgkmcnt(0)" ::: "memory"); \
    for (int d = 0; d < 4; ++d) for (int r = 0; r < 16; ++r) o[d][r] *= al_l[crow(r, hi)]; } } while (0)
    f32x16 pA0, pA1, pB0, pB1; float mnA, mnB, alA, alB; bf16x8 pa0, pa1, pa2, pa3; const int NT = seq / KVBLK;
    constexpr int SE = 0, SO = SDEPTH - 1;
    SLOAD(SE, 0); asm volatile("s_waitcnt vmcnt(0)" ::: "memory"); SWRITE(0, SE); __syncthreads();
    qkt(pA0, pA1, K_lds, qr, r32, hi); partialSM(pA0, pA1, m_reg, mnA, alA);
    SLOAD(SO, KVBLK); if constexpr (SDEPTH == 2) { if (2 < NT) SLOAD(SE, 2 * KVBLK); }
    SWAIT(); SWRITE(1, SO); __syncthreads();
    for (int j = 1; j + 1 < NT; j += 2) {
        SBAR(); qkt_fsm(pB0, pB1, (bf16_t*)((char*)K_lds + SHM_K), qr, r32, hi, pA0, pA1, alA, l_reg, pa0, pa1, pa2, pa3); SBAR();
        SLOAD(SO, (j + SDEPTH) * KVBLK); SBAR();
        pv_sm(o, vb0, pa0, pa1, pa2, pa3, pB0, pB1, m_reg, mnB, alB);
        __syncthreads(); SWAIT(); SWRITE(0, SE);
        RESC(alB); __syncthreads();
        SBAR(); qkt_fsm(pA0, pA1, K_lds, qr, r32, hi, pB0, pB1, alB, l_reg, pa0, pa1, pa2, pa3); SBAR();
        if (SDEPTH == 1 || j + 3 < NT) SLOAD(SE, (j + 1 + SDEPTH) * KVBLK); SBAR();
        pv_sm(o, vb0 + (int)SHM_V, pa0, pa1, pa2, pa3, pA0, pA1, m_reg, mnA, alA);
        __syncthreads(); SWAIT(); SWRITE(1, SO);
        RESC(alA); __syncthreads();
    }
    SBAR(); qkt(pB0, pB1, (bf16_t*)((char*)K_lds + SHM_K), qr, r32, hi);
    finishSM(pA0, pA1, alA, l_reg, pa0, pa1, pa2, pa3); SBAR();
    pv_sm(o, vb0, pa0, pa1, pa2, pa3, pB0, pB1, m_reg, mnB, alB);
    __syncthreads(); RESC(alB);
    finishSM(pB0, pB1, alB, l_reg, pa0, pa1, pa2, pa3); SBAR();
    pv_d0(o, vb0 + (int)SHM_V, pa0, pa1, pa2, pa3);
    { const int tid2 = opaque_tid(wave_id), lane2 = tid2 & 63, r32b = lane2 & 31, hib = lane2 >> 5;
      float* li2 = (float*)(lds + 2 * SHM_V + 2 * SHM_K) + wave_id * 64;
      if (hib == 0) li2[r32b] = l_reg; asm volatile("s_waitcnt lgkmcnt(0)" ::: "memory");
      float rli[16];
#pragma unroll
      for (int r = 0; r < 16; ++r) rli[r] = __builtin_amdgcn_rcpf(li2[crow(r, hib)]);
      __syncthreads();
      bf16_t* ost = (bf16_t*)(lds + wave_id * 8704);
#pragma unroll
      for (int r = 0; r < 16; ++r) { const int orow = crow(r, hib);
#pragma unroll
          for (int d0 = 0; d0 < 4; ++d0) ost[orow * 136 + d0 * 32 + r32b] = f2bf(o[d0][r] * rli[r]); }
      asm volatile("s_waitcnt lgkmcnt(0)" ::: "memory");
#pragma unroll
      for (int i = 0; i < 8; ++i) { const int rb = i >> 2, cb = i & 3, rr = lane2 >> 2, c8 = (lane2 & 3) * 8;
          *(u32x4*)((char*)Ob + blk16x32(o_pm, 16, o_h * 2 + (cb >> 1), wave_id >> 2, (wave_id & 3) * 2 + rb, cb & 1) + (rr * 32 + c8) * 2) = *(const u32x4*)(ost + (rb * 16 + rr) * 136 + cb * 32 + c8); } }
    __syncthreads();
#undef SLOAD
#undef SWRITE
#undef SWAIT
#undef RESC
}
}

struct S5In { const float *lre, *lim, *ldt, *bre, *bim, *cre, *cim, *dsk; };
__device__ __forceinline__ void s5_naive_wave(const S5In& P, const bf16_t* __restrict__ Ucat, const bf16_t* __restrict__ Uctx, float* __restrict__ Ytmp, bf16_t* __restrict__ SSM, int n, int g, int b) {
    const float dskip = P.dsk[g * PG + (n & 15)];
    for (int dir = 0; dir < 2; ++dir) {
        const int dg = dir * NG + g;
        const float dt = expf(P.ldt[dg]), lr = P.lre[dg * NS + n], li = P.lim[dg * NS + n];
        const float mag = expf(lr * dt), ang = li * dt, are = mag * cosf(ang), aim = mag * sinf(ang);
        const float den = lr * lr + li * li, nr = are - 1.f, ni = aim, fre = (nr * lr + ni * li) / den, fim = (ni * lr - nr * li) / den;
        float bbr[PG], bbi[PG], cr[PG], ci[PG];
#pragma unroll
        for (int p = 0; p < PG; ++p) { const float br = P.bre[((size_t)dg * NS + n) * PG + p], bi = P.bim[((size_t)dg * NS + n) * PG + p];
            bbr[p] = fre * br - fim * bi; bbi[p] = fre * bi + fim * br; cr[p] = P.cre[((size_t)dg * PG + p) * NS + n]; ci[p] = P.cim[((size_t)dg * PG + p) * NS + n]; }
        float sre = 0.f, sim = 0.f;
        for (int i = 0; i < LC; ++i) { const int tc = dir == 0 ? i : LC - 1 - i;
            const bf16_t* upc = Ucat + ucat_ctx_idx(b, tc, g * PG); const bf16x8 u0 = *(const bf16x8*)upc, u1 = *(const bf16x8*)(upc + 8);
            float bur = 0.f, bui = 0.f;
#pragma unroll
            for (int p = 0; p < 8; ++p) { const float ua = bf2f((bf16_t)u0[p]), ub = bf2f((bf16_t)u1[p]); bur += bbr[p] * ua + bbr[p + 8] * ub; bui += bbi[p] * ua + bbi[p + 8] * ub; }
            const float nre = are * sre - aim * sim + bur, nim = are * sim + aim * sre + bui; sre = nre; sim = nim; }
        for (int i = 0; i < SEQ; ++i) { const int t = dir == 0 ? i : SEQ - 1 - i;
            const bf16_t* up = Ucat + ucat_idx(b, t, g * PG);
            const bf16x8 u0 = *(const bf16x8*)up, u1 = *(const bf16x8*)(up + 8);
            float uu[PG]; float bur = 0.f, bui = 0.f;
#pragma unroll
            for (int p = 0; p < 8; ++p) { uu[p] = bf2f((bf16_t)u0[p]); uu[p + 8] = bf2f((bf16_t)u1[p]); }
#pragma unroll
            for (int p = 0; p < PG; ++p) { bur += bbr[p] * uu[p]; bui += bbi[p] * uu[p]; }
            const float nre = are * sre - aim * sim + bur, nim = are * sim + aim * sre + bui; sre = nre; sim = nim;
            float mine = 0.f, myu = 0.f;
#pragma unroll
            for (int p = 0; p < PG; ++p) { const float y = wave_sum(cr[p] * sre - ci[p] * sim); if (n == p) { mine = y; myu = uu[p]; } }
            if (n < PG) { const size_t oi = ((size_t)(b * SEQ + t)) * 512 + g * PG + n;
                if (dir == 0) Ytmp[oi] = myu * dskip + mine;
                else SSM[oi] = f2bf(gelu_tanh(Ytmp[oi] + mine)); }
        }
    }
}

#include <hip/hip_cooperative_groups.h>
namespace cg = cooperative_groups;
#define LAS __attribute__((address_space(3)))
#define GAS __attribute__((address_space(1)))

namespace pg8 {
constexpr int BM = 256, BK = 64, HALF = 128, HTB = HALF * BK * 2, STAGE_BYTES = 8 * HTB, NXCD = 8, WGM = 8;
__host__ __device__ __forceinline__ int lds_byte(int r, int c) { const int st = (r >> 4) * 2 + (c >> 5), rr = r & 15, cc = c & 31, ob = rr * 64 + cc * 2; return st * 1024 + (ob ^ (((ob >> 9) & 1) << 5)); }
__host__ __device__ __forceinline__ void stage_rc(int b, int& R, int& C) { const int st = b / 1024, sb = b % 1024, swz = sb ^ (((sb >> 9) & 1) << 5); R = (st >> 1) * 16 + swz / 64; C = (st & 1) * 32 + (swz % 64) / 2; }
__host__ __device__ __forceinline__ int perm32(int rho) { const int n = rho >> 4, i = rho & 15; return 8 * (i >> 2) + 4 * n + (i & 3); }
struct Unit { int pm, pn, grp; };
struct Gemm { const bf16_t* A; const bf16_t* Bt; int lda, ldb, K; size_t a_grp, b_grp; int amode; };
struct StaticOrder {
    int nM, nN, nwg, G, c;
    __device__ __forceinline__ void init(int nM_, int nN_, int G_, int c_) { nM = nM_; nN = nN_; nwg = nM * nN; G = G_; c = c_; }
    __device__ __forceinline__ bool next(int i, Unit& u) const {
        const long L = (long)i * G + c; if (L >= nwg) return false;
        int wgid = (int)L; { const int q = nwg / NXCD, r = nwg % NXCD, xcd = wgid % NXCD, off = wgid / NXCD; wgid = (xcd < r ? xcd * (q + 1) : r * (q + 1) + (xcd - r) * q) + off; }
        const int nig = WGM * nN, gid = wgid / nig, fm = gid * WGM, gsz = (nM - fm) < WGM ? (nM - fm) : WGM;
        u.pm = fm + ((wgid % nig) % gsz); u.pn = (wgid % nig) / gsz; u.grp = 0; return true;
    }
};
__device__ __forceinline__ unsigned cvt_pk_bf16(float lo, float hi) { return pk2(lo, hi); }
#define EPI_ROWS_BF16(ROWPTR, BJSTRIDE, XF) do { \
    _Pragma("unroll") for (int ai = 0; ai < 2; ++ai) _Pragma("unroll") for (int m = 0; m < 4; ++m) { const int row = row0 + ai * HALF + m * 16; bf16_t* rp = (ROWPTR); \
        _Pragma("unroll") for (int bj = 0; bj < 2; ++bj) { f32x4 v0 = acc[ai][bj][m][0], v1 = acc[ai][bj][m][1]; \
            _Pragma("unroll") for (int j = 0; j < 4; ++j) { v0[j] = XF(v0[j]); v1[j] = XF(v1[j]); } \
            u32x4 w; w.x = cvt_pk_bf16(v0[0], v0[1]); w.y = cvt_pk_bf16(v0[2], v0[3]); w.z = cvt_pk_bf16(v1[0], v1[1]); w.w = cvt_pk_bf16(v1[2], v1[3]); \
            *(u32x4*)(rp + (size_t)bj * (BJSTRIDE)) = w; } } } while (0)
template <class Epi, class Sched, bool ALIGN_EPI = true, bool SP2 = true>
__device__ __forceinline__ void gemm_phase(LAS unsigned char* lds, const Gemm g, const Sched& S, const Epi& E, int wave_id) {
    const int tid = opaque_tid(wave_id), wid = __builtin_amdgcn_readfirstlane(tid >> 6), lane = tid & 63, wr = wid >> 2, wc = wid & 3, fr = lane & 15, fq = lane >> 4;
    const int K = g.K, nt = K / BK;
    unsigned voffA[2], voffB[2];
#pragma unroll
    for (int i = 0; i < 2; ++i) { int R, C; stage_rc(tid * 16 + i * 8192, R, C); const int Rb = Epi::PERM ? ((R & ~31) + perm32(R & 31)) : R;
        voffA[i] = g.amode == 1 ? (unsigned)((((C >> 4) * 1024 + (R >> 5)) * 512 + (R & 31) * 16 + (C & 15)) * 2) : g.amode == 2 ? (unsigned)((((R & ~63) | (4 * (R & 15) + ((R >> 4) & 3))) * g.lda + C) * 2) : g.amode == 3 ? (unsigned)((((((R >> 6) * 2 + (C >> 5)) * 2) * 4 + (R & 3)) * 1024) + ((((R & 63) >> 2) * 4 + ((C >> 3) & 3)) * 16)) : (g.amode == 4 || g.amode == 5) ? (unsigned)((((R >> 4) * 2 + (C >> 5)) * 1024) + (((R & 15) * 32 + (C & 31)) * 2)) : (unsigned)(R * g.lda + C) * 2u; voffB[i] = (unsigned)(Rb * g.ldb + C) * 2u; }
    const size_t kstep = (size_t)(BK * 2), kstepA = g.amode == 1 ? (size_t)4 * 1024 * 512 * 2 : (g.amode == 3 || g.amode == 4 || g.amode == 5) ? (size_t)32768 : kstep;
    const size_t hstepA = g.amode == 1 ? (size_t)4 * 512 * 2 : g.amode == 3 ? (size_t)4096 : (g.amode == 4 || g.amode == 5) ? (size_t)16384 : (size_t)HALF * g.lda * 2, hstepB = (size_t)HALF * g.ldb * 2;
    const size_t tstepA = g.amode == 3 ? (size_t)44 * 32768 : g.amode == 4 ? (size_t)(g.K / 64) * 32768 : g.amode == 5 ? (size_t)(g.K / 64) * 65536 : 2 * hstepA, tstepB = 2 * hstepB;
    const unsigned ldsw = (unsigned)wid * 1024u;
    const int aoff = lds_byte(wr * 64 + fr, fq * 8), boff = lds_byte(wc * 32 + fr, fq * 8);
#define PG8_SA(b, h) (((b) * 2 + (h)) * HTB)
#define PG8_SB(b, h) ((4 + (b) * 2 + (h)) * HTB)
#define PG8_STAGE(bufoff, gbase, voff) do { _Pragma("unroll") for (int _i = 0; _i < 2; ++_i) \
        __builtin_amdgcn_global_load_lds((const unsigned*)((const char*)(gbase) + (voff)[_i]), (LAS unsigned*)(lds + (bufoff) + ldsw + _i * 8192), 16, 0, 0); } while (0)
#define PG8_LDA(dst, b, h) do { _Pragma("unroll") for (int m = 0; m < 4; ++m) _Pragma("unroll") for (int k = 0; k < 2; ++k) dst[m][k] = *(const LAS bf16x8*)(lds + PG8_SA(b, h) + aoff + m * 2048 + k * 1024); } while (0)
#define PG8_LDB(dst, b, h) do { _Pragma("unroll") for (int n = 0; n < 2; ++n) _Pragma("unroll") for (int k = 0; k < 2; ++k) dst[n][k] = *(const LAS bf16x8*)(lds + PG8_SB(b, h) + boff + n * 2048 + k * 1024); } while (0)
#define PG8_MMA(ai, bj, At, Bt) do { __builtin_amdgcn_s_setprio(1); _Pragma("unroll") for (int m = 0; m < 4; ++m) _Pragma("unroll") for (int n = 0; n < 2; ++n) _Pragma("unroll") for (int k = 0; k < 2; ++k) \
        acc[ai][bj][m][n] = __builtin_amdgcn_mfma_f32_16x16x32_bf16(Bt[n][k], At[m][k], acc[ai][bj][m][n], 0, 0, 0); __builtin_amdgcn_s_setprio(0); } while (0)
#define PG8_WAIT_V(n) asm volatile("s_waitcnt vmcnt(" #n ")" ::: "memory")
#define PG8_WAIT_L(n) asm volatile("s_waitcnt lgkmcnt(" #n ")" ::: "memory")
#define PG8_BAR __builtin_amdgcn_s_barrier()
#define PG8_SCHED __builtin_amdgcn_sched_barrier(0)
    Unit cur, nxt; int ui = 0;
    if (!S.next(0, cur)) return;
    f32x4 acc[2][2][4][2];
#pragma unroll
    for (int a = 0; a < 2; ++a)
#pragma unroll
        for (int b = 0; b < 2; ++b)
#pragma unroll
            for (int m = 0; m < 4; ++m)
#pragma unroll
                for (int n = 0; n < 2; ++n) acc[a][b][m][n] = (f32x4){0.f, 0.f, 0.f, 0.f};
    bf16x8 At[4][2], B0[2][2], B1[2][2];
    const char* cA = (const char*)g.A + (size_t)cur.grp * g.a_grp + (size_t)cur.pm * tstepA + ((g.amode == 3 && cur.pm >= A_SPLIT_PM) ? A_HI_SHIFT : (size_t)0); const char* cB = (const char*)g.Bt + (size_t)cur.grp * g.b_grp + (size_t)cur.pn * tstepB;
    typename Epi::Pre pre = E.pre(cur, wid, lane);
    if constexpr (SP2) {
        PG8_STAGE(PG8_SB(0, 0), cB, voffB); PG8_STAGE(PG8_SB(0, 1), cB + hstepB, voffB); PG8_STAGE(PG8_SA(0, 0), cA, voffA); PG8_STAGE(PG8_SA(0, 1), cA + hstepA, voffA);
        if (wr == 1) PG8_BAR;
        PG8_WAIT_V(2); PG8_BAR;
        PG8_STAGE(PG8_SB(1, 0), cB + kstep, voffB); PG8_STAGE(PG8_SA(1, 0), cA + kstepA, voffA); PG8_STAGE(PG8_SB(1, 1), cB + hstepB + kstep, voffB);
        PG8_WAIT_V(6); PG8_BAR;
    } else {
        PG8_STAGE(PG8_SB(0, 0), cB, voffB); PG8_STAGE(PG8_SA(0, 0), cA, voffA); PG8_STAGE(PG8_SB(0, 1), cB + hstepB, voffB); PG8_STAGE(PG8_SA(0, 1), cA + hstepA, voffA);
        if (wr == 1) PG8_BAR;
        PG8_WAIT_V(4); PG8_BAR;
        PG8_STAGE(PG8_SB(1, 0), cB + kstep, voffB); PG8_STAGE(PG8_SA(1, 0), cA + kstepA, voffA); PG8_STAGE(PG8_SB(1, 1), cB + hstepB + kstep, voffB);
        PG8_WAIT_V(6); PG8_BAR;
    }
    for (;;) {
        const bool has_next = S.next(ui + 1, nxt);
        const char* nA = has_next ? (const char*)g.A + (size_t)nxt.grp * g.a_grp + (size_t)nxt.pm * tstepA + ((g.amode == 3 && nxt.pm >= A_SPLIT_PM) ? A_HI_SHIFT : (size_t)0) : cA; const char* nB = has_next ? (const char*)g.Bt + (size_t)nxt.grp * g.b_grp + (size_t)nxt.pn * tstepB : cB;
        for (int t = 0; t < nt; t += 2) {
            const bool last = (t == nt - 2);
            const char* a1 = cA + (size_t)(t + 1) * kstepA;
            const char* a2 = last ? nA : cA + (size_t)(t + 2) * kstepA; const char* b2 = last ? nB : cB + (size_t)(t + 2) * kstep;
            const char* a3 = a2 + kstepA; const char* b3 = b2 + kstep;
            if constexpr (SP2) {
            PG8_LDB(B0, 0, 0); PG8_LDB(B1, 0, 1); PG8_SCHED; PG8_LDA(At, 0, 0); PG8_STAGE(PG8_SA(1, 1), a1 + hstepA, voffA);
            PG8_WAIT_V(8); PG8_WAIT_L(0); PG8_BAR; PG8_MMA(0, 0, At, B0); PG8_MMA(0, 1, At, B1); PG8_BAR; PG8_SCHED;
            PG8_LDA(At, 0, 1); PG8_STAGE(PG8_SB(0, 0), b2, voffB); PG8_STAGE(PG8_SB(0, 1), b2 + hstepB, voffB); PG8_STAGE(PG8_SA(0, 0), a2, voffA);
            PG8_WAIT_V(8); PG8_WAIT_L(0); PG8_BAR; PG8_MMA(1, 0, At, B0); PG8_MMA(1, 1, At, B1); PG8_BAR; PG8_SCHED;
            PG8_LDB(B0, 1, 0); PG8_LDB(B1, 1, 1); PG8_SCHED; PG8_LDA(At, 1, 0); PG8_STAGE(PG8_SA(0, 1), a2 + hstepA, voffA);
            PG8_WAIT_V(8); PG8_WAIT_L(0); PG8_BAR; PG8_MMA(0, 0, At, B0); PG8_MMA(0, 1, At, B1); PG8_BAR; PG8_SCHED;
            PG8_LDA(At, 1, 1); PG8_STAGE(PG8_SB(1, 0), b3, voffB); PG8_STAGE(PG8_SB(1, 1), b3 + hstepB, voffB); PG8_STAGE(PG8_SA(1, 0), a3, voffA);
            PG8_WAIT_V(8); PG8_WAIT_L(0); PG8_BAR; PG8_MMA(1, 0, At, B0); PG8_MMA(1, 1, At, B1); PG8_BAR; PG8_SCHED;
            } else {
            PG8_LDB(B0, 0, 0); PG8_SCHED; PG8_LDA(At, 0, 0); PG8_STAGE(PG8_SA(1, 1), a1 + hstepA, voffA);
            PG8_WAIT_L(8); PG8_BAR; PG8_WAIT_L(0); PG8_MMA(0, 0, At, B0); PG8_BAR; PG8_SCHED;
            PG8_LDB(B1, 0, 1); PG8_STAGE(PG8_SB(0, 0), b2, voffB);
            PG8_BAR; PG8_WAIT_L(0); PG8_MMA(0, 1, At, B1); PG8_BAR;
            PG8_LDA(At, 0, 1); PG8_STAGE(PG8_SA(0, 0), a2, voffA);
            PG8_BAR; PG8_WAIT_L(0); PG8_MMA(1, 0, At, B0); PG8_BAR; PG8_SCHED;
            PG8_STAGE(PG8_SB(0, 1), b2 + hstepB, voffB);
            PG8_WAIT_V(6); PG8_BAR; PG8_MMA(1, 1, At, B1); PG8_BAR;
            PG8_LDB(B0, 1, 0); PG8_SCHED; PG8_LDA(At, 1, 0); PG8_STAGE(PG8_SA(0, 1), a2 + hstepA, voffA);
            PG8_WAIT_L(8); PG8_BAR; PG8_WAIT_L(0); PG8_MMA(0, 0, At, B0); PG8_BAR; PG8_SCHED;
            PG8_LDB(B1, 1, 1); PG8_STAGE(PG8_SB(1, 0), b3, voffB);
            PG8_BAR; PG8_WAIT_L(0); PG8_MMA(0, 1, At, B1); PG8_BAR;
            PG8_LDA(At, 1, 1); PG8_STAGE(PG8_SA(1, 0), a3, voffA);
            PG8_BAR; PG8_WAIT_L(0); PG8_MMA(1, 0, At, B0); PG8_BAR; PG8_SCHED;
            PG8_STAGE(PG8_SB(1, 1), b3 + hstepB, voffB);
            PG8_WAIT_V(6); PG8_BAR; PG8_MMA(1, 1, At, B1); PG8_BAR;
            }
        }
        if constexpr (ALIGN_EPI) { if (wr == 0) PG8_BAR; }
        E(acc, cur, wr, wc, fr, fq, pre);
        if (!has_next) break;
#pragma unroll
        for (int a = 0; a < 2; ++a)
#pragma unroll
            for (int b = 0; b < 2; ++b)
#pragma unroll
                for (int m = 0; m < 4; ++m)
#pragma unroll
                    for (int n = 0; n < 2; ++n) acc[a][b][m][n] = (f32x4){0.f, 0.f, 0.f, 0.f};
        cur = nxt; cA = nA; cB = nB; ++ui;
        pre = E.pre(cur, wid, lane);
        if constexpr (ALIGN_EPI) { if (wr == 1) PG8_BAR; }
    }
    PG8_WAIT_V(0);
    if constexpr (!ALIGN_EPI) { if (wr == 0) PG8_BAR; }
    PG8_BAR;
#undef PG8_SA
#undef PG8_SB
#undef PG8_STAGE
#undef PG8_LDA
#undef PG8_LDB
#undef PG8_MMA
#undef PG8_WAIT_V
#undef PG8_WAIT_L
#undef PG8_BAR
#undef PG8_SCHED
}
}

#define XB_TMO      128
#define XB_XCNT(j)  (256  + 64 * (j))
#define XB_XSUB(j)  (1280 + 64 * (j))
#define XB_XGEN(j)  (2304 + 64 * (j))
#define XB_TOP      3328
#define XB_TOPGEN   3392
#define XCD_BAR_WORDS 3456
#define XB_SPIN_CAP (1u << 18)
__device__ __forceinline__ unsigned xb_ld(unsigned* p)              { return __hip_atomic_load(p, __ATOMIC_RELAXED, __HIP_MEMORY_SCOPE_AGENT); }
__device__ __forceinline__ unsigned xb_add(unsigned* p, unsigned v) { return __hip_atomic_fetch_add(p, v, __ATOMIC_RELAXED, __HIP_MEMORY_SCOPE_AGENT); }
__device__ __forceinline__ unsigned xb_xcc_id() { return (unsigned)__builtin_amdgcn_s_getreg((3 << 11) | 20) & 0xFu; }
#define XB_SPIN(cond, bar) do { unsigned _sp = 0; while (cond) { __builtin_amdgcn_s_sleep(1); \
    if ((++_sp & 255u) == 0u) { if (xb_ld(&(bar)[XB_TMO])) break; if (_sp > XB_SPIN_CAP) { atomicAdd(&(bar)[XB_TMO], 1u); break; } } } } while (0)
struct XcdBarrier { unsigned* bar; unsigned x; volatile LAS unsigned* st; };
__device__ __forceinline__ XcdBarrier xcd_barrier_post(unsigned* bar, volatile LAS unsigned* st) {
    XcdBarrier b; b.bar = bar; b.x = xb_xcc_id(); b.st = st;
    if (threadIdx.x == 0) (void)xb_add(&bar[XB_XCNT(b.x)], 1u);
    return b;
}
__device__ __forceinline__ void xcd_barrier_complete(unsigned* bar, unsigned x, unsigned& nloc, unsigned& nx) {
    const unsigned G = gridDim.x * gridDim.y * gridDim.z;
    unsigned sum, cnt, mine, sp = 0u;
    for (;;) {
        sum = 0u; cnt = 0u; mine = 0u;
#pragma unroll
        for (unsigned j = 0; j < 16; ++j) { const unsigned c = xb_ld(&bar[XB_XCNT(j)]); sum += c; cnt += (c > 0u) ? 1u : 0u; mine = (j == x) ? c : mine; }
        if (sum == G) break;
        __builtin_amdgcn_s_sleep(1);
        if ((++sp & 255u) == 0u) { if (xb_ld(&bar[XB_TMO])) break; if (sp > XB_SPIN_CAP) { atomicAdd(&bar[XB_TMO], 1u); break; } }
    }
    nloc = mine > 0u ? mine : 1u; nx = cnt > 0u ? cnt : 1u;
}
__device__ __forceinline__ void xcd_barrier(const XcdBarrier& b) {
    asm volatile("s_waitcnt vmcnt(0)" ::: "memory");
    __syncthreads();
    if (threadIdx.x == 0) {
        unsigned* bar = b.bar;
        __builtin_amdgcn_s_waitcnt(0);
        unsigned nloc = b.st[0], nx = b.st[1];
        if (nloc == 0u) { xcd_barrier_complete(bar, b.x, nloc, nx); b.st[0] = nloc; b.st[1] = nx; }
        const unsigned old = xb_add(&bar[XB_XSUB(b.x)], 1u);
        const unsigned gen = old / nloc;
        if (old + 1u == (gen + 1u) * nloc) {
            __builtin_amdgcn_fence(__ATOMIC_RELEASE, "agent");
            asm volatile("s_waitcnt vmcnt(0)" ::: "memory");
            const unsigned og = xb_add(&bar[XB_TOP], 1u);
            const unsigned tg = og / nx;
            if (og + 1u == (tg + 1u) * nx) xb_add(&bar[XB_TOPGEN], 1u);
            else XB_SPIN(xb_ld(&bar[XB_TOPGEN]) == tg, bar);
            __builtin_amdgcn_fence(__ATOMIC_ACQUIRE, "agent");
            xb_add(&bar[XB_XGEN(b.x)], 1u);
            asm volatile("s_waitcnt vmcnt(0)" ::: "memory");
        } else {
            XB_SPIN(xb_ld(&bar[XB_XGEN(b.x)]) == gen, bar);
            __builtin_amdgcn_fence(__ATOMIC_ACQUIRE, "agent");
            asm volatile("s_waitcnt vmcnt(0)" ::: "memory");
        }
    }
    __syncthreads();
}

#define TB_WORD(x, p) (26624 + 64 * ((x) * 8 + (p)))
__device__ __forceinline__ void team_barrier(unsigned* cnt, unsigned gen) {
    asm volatile("s_waitcnt vmcnt(0)" ::: "memory");
    __syncthreads();
    if (threadIdx.x == 0) {
        (void)xb_add(cnt, 1u);
        unsigned spins = 0;
        while (xb_ld(cnt) < 4u * gen) { __builtin_amdgcn_s_sleep(1); if (++spins > (1u << 22)) break; }
        __builtin_amdgcn_fence(__ATOMIC_ACQUIRE, "agent");
        asm volatile("s_waitcnt vmcnt(0)" ::: "memory");
    }
    __syncthreads();
}
#define GB_SUB(j)   (12288 + 64 * (j))
#define GB_GEN(j)   (13312 + 64 * (j))
#define GB_MISMATCH 14400
#define GB_TOPA     14976
#define GB_TOPB     15040
__device__ __forceinline__ void top_wait(unsigned* top) {
    if (threadIdx.x < 64) { unsigned spins = 0;
        while ((unsigned)__builtin_amdgcn_readfirstlane(xb_ld(top)) < 8u) { __builtin_amdgcn_s_sleep(2); if (++spins > (1u << 22)) break; }
        __builtin_amdgcn_fence(__ATOMIC_ACQUIRE, "agent"); asm volatile("s_waitcnt vmcnt(0)" ::: "memory"); }
    __syncthreads();
}
__device__ __forceinline__ void grp_barrier(const XcdBarrier& b, unsigned* top = nullptr) {
    asm volatile("s_waitcnt vmcnt(0)" ::: "memory");
    __syncthreads();
    if (threadIdx.x == 0) {
        unsigned* bar = b.bar;
        __builtin_amdgcn_s_waitcnt(0);
        const unsigned nloc = b.st[0];
        const unsigned old = xb_add(&bar[GB_SUB(b.x)], 1u);
        const unsigned gen = old / nloc;
        if (old + 1u == (gen + 1u) * nloc) {
            __builtin_amdgcn_fence(__ATOMIC_RELEASE, "agent");
            asm volatile("s_waitcnt vmcnt(0)" ::: "memory");
            if (top) (void)xb_add(top, 1u);
            __builtin_amdgcn_fence(__ATOMIC_ACQUIRE, "agent");
            xb_add(&bar[GB_GEN(b.x)], 1u);
            asm volatile("s_waitcnt vmcnt(0)" ::: "memory");
        } else {
            XB_SPIN(xb_ld(&bar[GB_GEN(b.x)]) == gen, bar);
            __builtin_amdgcn_fence(__ATOMIC_ACQUIRE, "agent");
            asm volatile("s_waitcnt vmcnt(0)" ::: "memory");
        }
    }
    __syncthreads();
}

constexpr int MK_LDS = 147456;
constexpr int NWV = 8;
#ifndef MK_HI
#define MK_HI 16
#endif
#ifndef S5_NAIVE
#define S5_NAIVE 0
#endif
#ifndef USE_XBAR
#define USE_XBAR 1
#endif
#ifndef X1_BF16
#define X1_BF16 1
#endif
#ifndef GRP_SEAMS
#define GRP_SEAMS 1
#endif
#ifndef STAGGER8_US
#define STAGGER8_US 0
#endif
#ifndef REPMASK
#define REPMASK 0x0
#endif
#define REPS(k) for (int rep_ = 0; rep_ <= ((REPMASK >> (k)) & 1); ++rep_)
struct MkArgs { const float* in[27]; float* out; unsigned char* ws; int ph_lo, ph_hi; };

template <int MAP> __device__ __forceinline__ void transpose_item(const float* __restrict__ W, int K, int N, bf16_t* __restrict__ WT, LAS float* scr, int item, int lane) {
    const int nblk = N / 32, kb = item / nblk, nb = item % nblk, k0 = 64 * kb, n0 = 32 * nb;
    { f32x4 v[8];
#pragma unroll
      for (int i = 0; i < 8; ++i) v[i] = *(const f32x4*)(W + (size_t)(k0 + 8 * i + (lane >> 3)) * N + n0 + (lane & 7) * 4);
#pragma unroll
      for (int i = 0; i < 8; ++i) { LAS float* d = scr + (8 * i + (lane >> 3)) * 33 + (lane & 7) * 4; d[0] = v[i][0]; d[1] = v[i][1]; d[2] = v[i][2]; d[3] = v[i][3]; } }
    asm volatile("s_waitcnt lgkmcnt(0)" ::: "memory");
    const int c = lane & 7;
#pragma unroll
    for (int j = 0; j < 4; ++j) { const int n = (lane >> 3) + 8 * j; const LAS float* s = scr + (8 * c) * 33 + n;
        u32x4 o; o.x = pk2(s[0 * 33], s[1 * 33]); o.y = pk2(s[2 * 33], s[3 * 33]); o.z = pk2(s[4 * 33], s[5 * 33]); o.w = pk2(s[6 * 33], s[7 * 33]);
        int dr = n0 + n; if (MAP == 1) { const int cc = dr >= DFF ? dr - DFF : dr; dr = (cc >> 7) * 256 + (dr >= DFF ? 128 : 0) + (cc & 127); }
        if (MAP == 2) { const int cc = dr & 1023; dr = (cc >> 7) * 256 + (dr >= 1024 ? 128 : 0) + (cc & 127); }
        *(u32x4*)(WT + (size_t)dr * K + k0 + 8 * c) = o; }
    asm volatile("s_waitcnt lgkmcnt(0)" ::: "memory");
}
__device__ __forceinline__ void norm_mod_rows4(const float* __restrict__ src, const float* __restrict__ w, const float* __restrict__ sh, const float* __restrict__ sc, bf16_t* __restrict__ dst, int lane) {
    f32x4 v[4][4]; float ss[4];
#pragma unroll
    for (int r = 0; r < 4; ++r)
#pragma unroll
        for (int j = 0; j < 4; ++j) v[r][j] = *(const f32x4*)(src + (size_t)r * DM + j * 256 + lane * 4);
#pragma unroll
    for (int r = 0; r < 4; ++r) { float s = 0.f;
#pragma unroll
        for (int j = 0; j < 4; ++j) s += (v[r][j][0] * v[r][j][0] + v[r][j][1] * v[r][j][1]) + (v[r][j][2] * v[r][j][2] + v[r][j][3] * v[r][j][3]);
        ss[r] = s; }
#pragma unroll
    for (int o = 1; o < 64; o <<= 1) {
#pragma unroll
        for (int r = 0; r < 4; ++r) ss[r] += __shfl_xor(ss[r], o); }
#pragma unroll
    for (int r = 0; r < 4; ++r) ss[r] = rsqrtf(ss[r] * (1.f / DM) + EPS);
#pragma unroll
    for (int j = 0; j < 4; ++j) { const int k = j * 256 + lane * 4; const f32x4 ww = *(const f32x4*)(w + k), s1 = *(const f32x4*)(sc + k) + 1.f, s0 = *(const f32x4*)(sh + k);
#pragma unroll
        for (int r = 0; r < 4; ++r) { const f32x4 y = (v[r][j] * ss[r] * ww) * s1 + s0; u32x2 o; o.x = pk2(y[0], y[1]); o.y = pk2(y[2], y[3]); *(u32x2*)(dst + (size_t)r * DM + k) = o; } }
}
__device__ __forceinline__ unsigned pack4_u8(float a, float b, float c, float d) { unsigned w = 0u; w = __builtin_amdgcn_cvt_pk_u8_f32(a * 255.f, 0u, w); w = __builtin_amdgcn_cvt_pk_u8_f32(b * 255.f, 1u, w); w = __builtin_amdgcn_cvt_pk_u8_f32(c * 255.f, 2u, w); w = __builtin_amdgcn_cvt_pk_u8_f32(d * 255.f, 3u, w); return w; }
__device__ __forceinline__ void unpack8_u8(const u32x2 w, float (&f)[8]) { constexpr float s = 1.f / 255.f;
    f[0] = (float)(w.x & 0xffu) * s; f[1] = (float)((w.x >> 8) & 0xffu) * s; f[2] = (float)((w.x >> 16) & 0xffu) * s; f[3] = (float)(w.x >> 24) * s;
    f[4] = (float)(w.y & 0xffu) * s; f[5] = (float)((w.y >> 8) & 0xffu) * s; f[6] = (float)((w.y >> 16) & 0xffu) * s; f[7] = (float)(w.y >> 24) * s; }
__device__ __forceinline__ size_t ll_idx(int t, int w, int S, int s, int l) { return ((size_t)(t * 8 + w) * S + s) * 64 + l; }
__device__ __forceinline__ size_t a_blk(int pm, int kt, int wr, int wcl, int ai, int m) { return ((((((size_t)pm * 44 + kt) * 2 + wr) * 2 + wcl) * 2 + ai) * 4 + m) * 1024 + (pm >= A_SPLIT_PM ? A_HI_SHIFT : (size_t)0); }
struct NoPre {};
#define EPI_NOPRE typedef NoPre Pre; __device__ __forceinline__ Pre pre(const pg8::Unit&, int, int) const { return Pre{}; }
__device__ __forceinline__ float xf_id(float v) { return v; }
struct EpiAfast {
    static constexpr bool PERM = true;
    EPI_NOPRE
    bf16_t *Q, *Kb, *Vb, *Ucat, *SG; const float *qnw, *knw; LAS float* SS;
    __device__ __forceinline__ void operator()(const f32x4 (&acc)[2][2][4][2], const pg8::Unit& u, int wr, int wc, int fr, int fq, const Pre& pre_) const {
        using namespace pg8;
        const int row0 = u.pm * BM + wr * 64 + fr, cl = wc * 32 + 8 * fq;
        const bool lat = u.pm < ML / 256;
        if (u.pn < 5) {
            const bool isq = u.pn < 4; const float* nw = isq ? qnw : knw;
#pragma unroll
            for (int ai = 0; ai < 2; ++ai)
#pragma unroll
                for (int m = 0; m < 4; ++m)
#pragma unroll
                    for (int bj = 0; bj < 2; ++bj) { const f32x4 v0 = acc[ai][bj][m][0], v1 = acc[ai][bj][m][1];
                        float s = (v0[0] * v0[0] + v0[1] * v0[1]) + (v0[2] * v0[2] + v0[3] * v0[3]) + (v1[0] * v1[0] + v1[1] * v1[1]) + (v1[2] * v1[2] + v1[3] * v1[3]);
                        s += __shfl_xor(s, 16); s += __shfl_xor(s, 32);
                        if (fq == 0) SS[((ai * HALF + wr * 64 + m * 16 + fr) * 2 + bj) * 4 + wc] = s; }
            asm volatile("s_waitcnt lgkmcnt(0)" ::: "memory"); __builtin_amdgcn_s_barrier(); asm volatile("" ::: "memory");
            const f32x4 w0 = *(const f32x4*)(nw + cl), w1 = *(const f32x4*)(nw + cl + 4);
            float invf[4];
#pragma unroll
            for (int e = 0; e < 4; ++e) invf[e] = exp2f(-(float)(2 * (((cl >> 1) + e) & 31)) * (13.287712379549449f / 64.f));
#pragma unroll
            for (int ai = 0; ai < 2; ++ai)
#pragma unroll
                for (int m = 0; m < 4; ++m) { const int row = row0 + ai * HALF + m * 16;
                    float cs[4], sn[4];
                    if (lat) { const int t = row % SEQ; const float coord = (wc < 2) ? (float)(t >> 6) : (float)(t & 63);
#pragma unroll
                        for (int e = 0; e < 4; ++e) { const float ang = coord * invf[e]; cs[e] = __cosf(ang); sn[e] = __sinf(ang); } }
                    else {
#pragma unroll
                        for (int e = 0; e < 4; ++e) { cs[e] = 1.f; sn[e] = 0.f; } }
                    bf16_t* rp = isq ? Q + (size_t)row * 1024 + u.pn * 256 + cl
                                     : Kb + ((size_t)(lat ? (row / SEQ) * LKV + LC + (row % SEQ) : ((row - ML) / LC) * LKV + ((row - ML) % LC))) * 256 + cl;
#pragma unroll
                    for (int bj = 0; bj < 2; ++bj) {
                        const f32x4 p = *(const LAS f32x4*)(SS + ((ai * HALF + wr * 64 + m * 16 + fr) * 2 + bj) * 4);
                        const float rs = rsqrtf(((p[0] + p[1]) + (p[2] + p[3])) * (1.f / 128.f) + EPS);
                        const f32x4 y0 = acc[ai][bj][m][0] * rs * w0, y1 = acc[ai][bj][m][1] * rs * w1;
                        u32x4 w; w.x = cvt_pk_bf16(y0[0] * cs[0] - y0[1] * sn[0], y0[0] * sn[0] + y0[1] * cs[0]); w.y = cvt_pk_bf16(y0[2] * cs[1] - y0[3] * sn[1], y0[2] * sn[1] + y0[3] * cs[1]);
                        w.z = cvt_pk_bf16(y1[0] * cs[2] - y1[1] * sn[2], y1[0] * sn[2] + y1[1] * cs[2]); w.w = cvt_pk_bf16(y1[2] * cs[3] - y1[3] * sn[3], y1[2] * sn[3] + y1[3] * cs[3]);
                        *(u32x4*)(rp + bj * 128) = w; } }
        }
        else if (u.pn == 5) {
            EPI_ROWS_BF16(Vb + ((size_t)(lat ? (row / SEQ) * LKV + LC + (row % SEQ) : ((row - ML) / LC) * LKV + ((row - ML) % LC))) * 256 + cl, 128, xf_id); }
        else if (u.pn < 8) { const int ch0 = (u.pn - 6) * 256 + cl;
            if (lat) { EPI_ROWS_BF16(Ucat + ucat_idx(row / SEQ, row % SEQ, ch0), (size_t)8 * UROWS * KCAT, xf_id); }
            else { EPI_ROWS_BF16(Ucat + ucat_ctx_idx((row - ML) / LC, (row - ML) % LC, ch0), (size_t)8 * UROWS * KCAT, xf_id); } }
        else { unsigned char* sg8 = (unsigned char*)SG;
#pragma unroll
            for (int ai = 0; ai < 2; ++ai)
#pragma unroll
                for (int m = 0; m < 4; ++m) { const int row = row0 + ai * HALF + m * 16;
#pragma unroll
                    for (int bj = 0; bj < 2; ++bj) { const f32x4 v0 = acc[ai][bj][m][0], v1 = acc[ai][bj][m][1]; u32x2 w;
                        w.x = pack4_u8(sigmoidf_(v0[0]), sigmoidf_(v0[1]), sigmoidf_(v0[2]), sigmoidf_(v0[3])); w.y = pack4_u8(sigmoidf_(v1[0]), sigmoidf_(v1[1]), sigmoidf_(v1[2]), sigmoidf_(v1[3]));
                        ((u32x2*)sg8)[ll_idx(u.pm * 8 + (u.pn - 8), wr * 4 + wc, 16, ai * 8 + m * 2 + bj, fq * 16 + fr)] = w; } } }
    }
};
struct EpiStoreFast {
    static constexpr bool PERM = true; bf16_t* O; int ldo;
    EPI_NOPRE
    __device__ __forceinline__ void operator()(const f32x4 (&acc)[2][2][4][2], const pg8::Unit& u, int wr, int wc, int fr, int fq, const Pre& pre_) const {
        using namespace pg8; const int row0 = u.pm * BM + wr * 64 + fr, cl = u.pn * BM + wc * 32 + 8 * fq;
        EPI_ROWS_BF16(O + (size_t)row * ldo + cl, 128, xf_id);
    }
};
__device__ __forceinline__ void unpack8(const u32x4 w, float (&f)[8]) {
    f[0] = __uint_as_float(w.x << 16); f[1] = __uint_as_float(w.x & 0xffff0000u); f[2] = __uint_as_float(w.y << 16); f[3] = __uint_as_float(w.y & 0xffff0000u);
    f[4] = __uint_as_float(w.z << 16); f[5] = __uint_as_float(w.z & 0xffff0000u); f[6] = __uint_as_float(w.w << 16); f[7] = __uint_as_float(w.w & 0xffff0000u);
}
struct EpiGluPair {
    static constexpr bool PERM = true;
    EPI_NOPRE const bf16_t* SG; bf16_t* PS;
    __device__ __forceinline__ void operator()(const f32x4 (&acc)[2][2][4][2], const pg8::Unit& u, int wr, int wc, int fr, int fq, const Pre& pre_) const {
        using namespace pg8; const int row0 = u.pm * BM + wr * 64 + fr, c0 = u.pn * 128 + wc * 32 + 8 * fq;
        u32x2 gw[2][4]; const unsigned char* sg8 = (const unsigned char*)SG;
#pragma unroll
        for (int ai = 0; ai < 2; ++ai)
#pragma unroll
            for (int m = 0; m < 4; ++m) gw[ai][m] = ((const u32x2*)sg8)[ll_idx(u.pm * 8 + 4 + (u.pn >> 1), wr * 4 + wc, 16, ai * 8 + m * 2 + (u.pn & 1), fq * 16 + fr)];
#pragma unroll
        for (int ai = 0; ai < 2; ++ai)
#pragma unroll
            for (int m = 0; m < 4; ++m) { const int row = row0 + ai * HALF + m * 16; float gs[8], r[8];
                unpack8_u8(gw[ai][m], gs);
#pragma unroll
                for (int j = 0; j < 8; ++j) { const float av = (j < 4) ? acc[ai][0][m][0][j & 3] : acc[ai][0][m][1][j & 3], bv = (j < 4) ? acc[ai][1][m][0][j & 3] : acc[ai][1][m][1][j & 3]; r[j] = gs[j] * av * sigmoidf_(bv); }
                u32x4 w; w.x = cvt_pk_bf16(r[0], r[1]); w.y = cvt_pk_bf16(r[2], r[3]); w.z = cvt_pk_bf16(r[4], r[5]); w.w = cvt_pk_bf16(r[6], r[7]);
                ((u32x4*)PS)[ll_idx(u.pm * 8 + u.pn, wr * 4 + wc, 8, ai * 4 + m, fq * 16 + fr)] = w; }
    }
};
struct EpiMergeFast {
    static constexpr bool PERM = true;
    EPI_NOPRE const bf16_t *SG, *GLU; bf16_t* MG;
    __device__ __forceinline__ void operator()(const f32x4 (&acc)[2][2][4][2], const pg8::Unit& u, int wr, int wc, int fr, int fq, const Pre& pre_) const {
        using namespace pg8; const int row0 = u.pm * BM + wr * 64 + fr, cl = u.pn * BM + wc * 32 + 8 * fq;
#pragma unroll
        for (int ai = 0; ai < 2; ++ai) {
            u32x2 gw[4][2]; u32x4 pw[4][2]; const unsigned char* sg8 = (const unsigned char*)SG;
#pragma unroll
            for (int m = 0; m < 4; ++m)
#pragma unroll
                for (int bj = 0; bj < 2; ++bj) { gw[m][bj] = ((const u32x2*)sg8)[ll_idx(u.pm * 8 + u.pn, wr * 4 + wc, 16, ai * 8 + m * 2 + bj, fq * 16 + fr)]; pw[m][bj] = ((const u32x4*)GLU)[ll_idx(u.pm * 8 + 2 * u.pn + bj, wr * 4 + wc, 8, ai * 4 + m, fq * 16 + fr)]; }
#pragma unroll
            for (int m = 0; m < 4; ++m)
#pragma unroll
                for (int bj = 0; bj < 2; ++bj) { const int row = row0 + ai * HALF + m * 16; float ga[8], ps[8], r[8];
                    unpack8_u8(gw[m][bj], ga); unpack8(pw[m][bj], ps);
#pragma unroll
                    for (int j = 0; j < 8; ++j) { const float v = (j < 4) ? acc[ai][bj][m][0][j & 3] : acc[ai][bj][m][1][j & 3]; r[j] = ga[j] * v + ps[j]; }
                    u32x4 w; w.x = cvt_pk_bf16(r[0], r[1]); w.y = cvt_pk_bf16(r[2], r[3]); w.z = cvt_pk_bf16(r[4], r[5]); w.w = cvt_pk_bf16(r[6], r[7]);
                    *(u32x4*)((char*)MG + blk16x32(u.pm, 32, u.pn * 4 + bj * 2 + (wc >> 1), ai, wr * 4 + m, wc & 1) + (fr * 32 + 8 * fq) * 2) = w; } }
    }
};
struct EpiResidFast {
    static constexpr bool PERM = false; const float* base; float* out; const float* gate;
    EPI_NOPRE
    __device__ __forceinline__ void operator()(const f32x4 (&acc)[2][2][4][2], const pg8::Unit& u, int wr, int wc, int fr, int fq, const Pre& pre_) const {
        using namespace pg8; const int row0 = u.pm * BM + wr * 64 + fr, col0 = u.pn * BM + wc * 32 + 4 * fq;
        const float* gp = gate + (size_t)((u.pm * BM) / SEQ) * 6144 + col0;
        f32x4 gv[2][2];
#pragma unroll
        for (int bj = 0; bj < 2; ++bj)
#pragma unroll
            for (int n = 0; n < 2; ++n) gv[bj][n] = *(const f32x4*)(gp + bj * HALF + n * 16);
#pragma unroll
        for (int ai = 0; ai < 2; ++ai)
#pragma unroll
            for (int m = 0; m < 4; ++m) { const size_t off = (size_t)(row0 + ai * HALF + m * 16) * 1024 + col0;
#pragma unroll
                for (int bj = 0; bj < 2; ++bj)
#pragma unroll
                    for (int n = 0; n < 2; ++n) { const f32x4 bs = *(const f32x4*)(base + off + bj * HALF + n * 16); *(f32x4*)(out + off + bj * HALF + n * 16) = bs + gv[bj][n] * acc[ai][bj][m][n]; }
                asm volatile("" ::: "memory"); }
    }
};
template <int CTRL> __device__ __forceinline__ float dppf(float x) { return __builtin_bit_cast(float, __builtin_amdgcn_mov_dpp(__builtin_bit_cast(int, x), CTRL, 0xf, 0xf, true)); }
template <int CTRL> __device__ __forceinline__ float dpp_old(float old, float x) { return __builtin_bit_cast(float, __builtin_amdgcn_update_dpp(__builtin_bit_cast(int, old), __builtin_bit_cast(int, x), CTRL, 0xf, 0xf, false)); }
struct EpiUpConv {
    static constexpr bool PERM = true;
    struct Pre { f32x2 v; };
    __device__ __forceinline__ Pre pre(const pg8::Unit& u, int p, int lane) const { const int c = u.pn * 128 + lane * 2;
        const float* sp = p < 3 ? cw + p * NUP + c : p == 3 ? cb + c : p < 7 ? cw + (p - 4) * NUP + DFF + c : cb + DFF + c; Pre r; r.v = *(const f32x2*)sp; return r; }
    bf16_t* A; float* HALO; const float* cw; const float* cb; LAS float* Bd; LAS float* Pm;
    __device__ __forceinline__ void operator()(const f32x4 (&acc)[2][2][4][2], const pg8::Unit& u, int wr, int wc, int fr, int fq, const Pre& pre_) const {
        using namespace pg8;
        const int x0 = wc * 32 + 8 * fq;
        if (fr == 0) {
#pragma unroll
            for (int ai = 0; ai < 2; ++ai)
#pragma unroll
                for (int bj = 0; bj < 2; ++bj)
#pragma unroll
                    for (int n = 0; n < 2; ++n) *(LAS f32x4*)(Bd + (ai * 4 + wr * 2) * 256 + bj * 128 + x0 + 4 * n) = acc[ai][bj][0][n]; }
        if (fr == 15) {
#pragma unroll
            for (int ai = 0; ai < 2; ++ai)
#pragma unroll
                for (int bj = 0; bj < 2; ++bj)
#pragma unroll
                    for (int n = 0; n < 2; ++n) *(LAS f32x4*)(Bd + (ai * 4 + wr * 2 + 1) * 256 + bj * 128 + x0 + 4 * n) = acc[ai][bj][3][n]; }
        {
          const int p = wr * 4 + wc, xx = (fq * 16 + fr) * 2; Pm[p * 128 + xx] = pre_.v.x; Pm[p * 128 + xx + 1] = pre_.v.y; }
        asm volatile("s_waitcnt lgkmcnt(0)" ::: "memory"); __builtin_amdgcn_s_barrier(); asm volatile("" ::: "memory");
        const int cbase = u.pn * 128 + x0;
        float* hz = HALO + ((size_t)(u.pm * 22 + u.pn) * 4) * 256;
#pragma unroll
        for (int ai = 0; ai < 2; ++ai) {
            const int blk = 2 * ai + wr;
            const LAS float* pbp = Bd + (((blk - 1) >> 1) * 4 + ((blk - 1) & 1) * 2 + 1) * 256 + x0;
            const LAS float* nbp = Bd + (((blk + 1) >> 1) * 4 + ((blk + 1) & 1) * 2) * 256 + x0;
#pragma unroll
            for (int n = 0; n < 2; ++n) {
                const int c = cbase + 4 * n;
                const LAS float* pp = Pm + x0 + 4 * n;
                float o[4][4];
#pragma unroll
                for (int j = 0; j < 4; ++j) {
                    const float w0v = pp[j], w1v = pp[128 + j], w2v = pp[256 + j], bv = pp[384 + j], w0g = pp[512 + j], w1g = pp[640 + j], w2g = pp[768 + j], bg = pp[896 + j];
                    float pbv = 0.f, pbg = 0.f, nbv = 0.f, nbg = 0.f;
                    if (blk > 0) { pbv = pbp[4 * n + j]; pbg = pbp[128 + 4 * n + j]; }
                    if (blk < 3) { nbv = nbp[4 * n + j]; nbg = nbp[128 + 4 * n + j]; }
                    float zv[4], zg[4];
#pragma unroll
                    for (int m = 0; m < 4; ++m) { zv[m] = acc[ai][0][m][n][j]; zg[m] = acc[ai][1][m][n][j]; }
                    const float pv0 = dpp_old<0x111>(pbv, zv[3]), pg0 = dpp_old<0x111>(pbg, zg[3]), nv3 = dpp_old<0x101>(nbv, zv[0]), ng3 = dpp_old<0x101>(nbg, zg[0]);
#pragma unroll
                    for (int m = 0; m < 4; ++m) {
                        const float pv = m == 0 ? pv0 : zv[m > 0 ? m - 1 : 0], pg = m == 0 ? pg0 : zg[m > 0 ? m - 1 : 0], nv = m == 3 ? nv3 : zv[m < 3 ? m + 1 : 3], ng = m == 3 ? ng3 : zg[m < 3 ? m + 1 : 3];
                        const float cv = fmaf(w0v, pv, fmaf(w1v, zv[m], fmaf(w2v, nv, bv))), cg = fmaf(w0g, pg, fmaf(w1g, zg[m], fmaf(w2g, ng, bg)));
                        if (m == 0 && blk == 0 && fr == 0) { hz[0 * 256 + x0 + 4 * n + j] = zv[0]; hz[0 * 256 + 128 + x0 + 4 * n + j] = zg[0]; hz[2 * 256 + x0 + 4 * n + j] = cv; hz[2 * 256 + 128 + x0 + 4 * n + j] = cg; }
                        if (m == 3 && blk == 3 && fr == 15) { hz[1 * 256 + x0 + 4 * n + j] = zv[3]; hz[1 * 256 + 128 + x0 + 4 * n + j] = zg[3]; hz[3 * 256 + x0 + 4 * n + j] = cv; hz[3 * 256 + 128 + x0 + 4 * n + j] = cg; }
                        o[m][j] = siluf_(cg) * cv; }
                }
#pragma unroll
                for (int m = 0; m < 4; ++m) { u32x2 w; w.x = cvt_pk_bf16(o[m][0], o[m][1]); w.y = cvt_pk_bf16(o[m][2], o[m][3]);
                    *(u32x2*)((char*)A + a_blk(u.pm, u.pn * 2 + (wc >> 1), wr, wc & 1, ai, m) + (fr * 4 + fq) * 16 + n * 8) = w; }
                asm volatile("" ::: "memory");
            }
        }
    }
};
__device__ __forceinline__ void conv_fix_panel(int pm, const float* __restrict__ HALO, const float* __restrict__ cw, bf16_t* __restrict__ A, int tid) {
#pragma unroll
    for (int rk = 0; rk < 2; ++rk) {
        if (rk == 0 ? (pm & 7) == 0 : (pm & 7) == 7) continue;
        const int nb = rk == 0 ? pm - 1 : pm + 1;
        for (int c = tid; c < DFF; c += NWV * 64) { const int pn = c >> 7, x = c & 127;
            const float* hp = HALO + ((size_t)(pm * 22 + pn) * 4 + 2 + rk) * 256; const float* hn = HALO + ((size_t)(nb * 22 + pn) * 4 + (rk == 0 ? 1 : 0)) * 256;
            const float wv = cw[(rk == 0 ? 0 : 2) * NUP + c], wg = cw[(rk == 0 ? 0 : 2) * NUP + DFF + c];
            const float val = hp[x] + wv * hn[x], gate = hp[128 + x] + wg * hn[128 + x];
            const int wc = x >> 5, fq = (x >> 3) & 3;
            *(bf16_t*)((char*)A + a_blk(pm, pn * 2 + (wc >> 1), rk, wc & 1, rk, rk ? 3 : 0) + ((rk ? 15 : 0) * 4 + fq) * 16 + (x & 7) * 2) = f2bf(siluf_(gate) * val); }
    }
}
__device__ __forceinline__ int sidx(int d, int ri, int n) { return d * 128 + ri * 64 + n; }
__device__ __forceinline__ void s5_tables_block(const S5In& P, int g, int qr, bf16_t* __restrict__ W1, bf16_t* __restrict__ B3, float* __restrict__ A32, LAS unsigned char* lds, int tid) {
    LAS float* BBs = (LAS float*)lds;
    LAS float* PWs = BBs + 4096;
    LAS float* CCs = PWs + 66 * 130;
    LAS float* KT = CCs + 32 * 130;
    if (tid < 128) {
        const int d = tid >> 6, n = tid & 63, dg = d * NG + g;
        const float dt = expf(P.ldt[dg]), lr = P.lre[dg * NS + n], li = P.lim[dg * NS + n];
        const float mag = expf(lr * dt), ang = li * dt, are = mag * cosf(ang), aim = mag * sinf(ang);
        const float den = lr * lr + li * li, nr = are - 1.f, ni = aim, fre = (nr * lr + ni * li) / den, fim = (ni * lr - nr * li) / den;
#pragma unroll
        for (int q = 0; q < PG; ++q) { const float br = P.bre[((size_t)dg * NS + n) * PG + q], bi = P.bim[((size_t)dg * NS + n) * PG + q];
            BBs[((d * 64 + n) * 16 + q) * 2] = fre * br - fim * bi; BBs[((d * 64 + n) * 16 + q) * 2 + 1] = fre * bi + fim * br; }
        double pr = 1.0, pi = 0.0; const double ar = (double)are, ai = (double)aim;
        for (int k = 0; k <= 32; ++k) { PWs[(d * 33 + k) * 130 + n * 2] = (float)pr; PWs[(d * 33 + k) * 130 + n * 2 + 1] = (float)pi; const double t0 = pr * ar - pi * ai, t1 = pr * ai + pi * ar; pr = t0; pi = t1; }
        if (qr == 0) { A32[(dg * NS + n) * 2] = PWs[(d * 33 + 32) * 130 + n * 2]; A32[(dg * NS + n) * 2 + 1] = PWs[(d * 33 + 32) * 130 + n * 2 + 1]; }
    }
    for (int i = tid; i < 2048; i += 512) { const int d = i >> 10, p = (i >> 6) & 15, n = i & 63; CCs[(i >> 6) * 130 + (i & 63) * 2] = P.cre[((size_t)(d * NG + g) * PG + p) * NS + n]; CCs[(i >> 6) * 130 + (i & 63) * 2 + 1] = P.cim[((size_t)(d * NG + g) * PG + p) * NS + n]; }
    __syncthreads();
    REPS(22) { const int d = tid >> 8, lagA = (tid >> 4) & 15, p = tid & 15; float accA[16], accB[16];
#pragma unroll
        for (int q = 0; q < 16; ++q) { accA[q] = 0.f; accB[q] = 0.f; }
        const LAS float* cp = CCs + (d * 16 + p) * 130; const LAS float* pa = PWs + (d * 33 + lagA) * 130; const LAS float* pb = PWs + (d * 33 + lagA + 16) * 130;
#pragma unroll 2
        for (int n = 0; n < 64; ++n) { const float cr = cp[2 * n], ci = cp[2 * n + 1], par = pa[2 * n], pai = pa[2 * n + 1], pbr = pb[2 * n], pbi = pb[2 * n + 1];
            const float xr = cr * par - ci * pai, xi = cr * pai + ci * par, yr = cr * pbr - ci * pbi, yi = cr * pbi + ci * pbr; const LAS float* bb = BBs + ((d * 64 + n) * 16) * 2;
#pragma unroll
            for (int q = 0; q < 16; ++q) { const float br = bb[2 * q], bi = bb[2 * q + 1]; accA[q] += xr * br - xi * bi; accB[q] += yr * br - yi * bi; } }
#pragma unroll
        for (int q = 0; q < 16; ++q) { KT[(d * 32 + lagA) * 260 + p * 16 + q] = accA[q]; KT[(d * 32 + lagA + 16) * 260 + p * 16 + q] = accB[q]; } }
    __syncthreads();
    for (int ch = tid; ch < 128 * 96; ch += 512) { const int r = ch / 96, cc = ch % 96, j = qr * 8 + (r >> 4), p = r & 15; float v[8];
        if (cc < 64) { const int i = cc >> 1, q0 = (cc & 1) * 8, lag = j - i;
#pragma unroll
            for (int e = 0; e < 8; ++e) { const int q = q0 + e; float x;
                if (lag > 0) x = KT[lag * 260 + p * 16 + q]; else if (lag < 0) x = KT[(32 - lag) * 260 + p * 16 + q];
                else x = KT[p * 16 + q] + KT[32 * 260 + p * 16 + q] + (q == p ? P.dsk[g * PG + p] : 0.f);
                v[e] = x; } }
        else { const int s0 = (cc - 64) * 8, d = s0 >> 7, ri = (s0 >> 6) & 1, n0 = s0 & 63, k = d == 0 ? j + 1 : 32 - j;
#pragma unroll
            for (int e = 0; e < 8; ++e) { const int n = n0 + e; const float cr = CCs[(d * 16 + p) * 130 + n * 2], ci = CCs[(d * 16 + p) * 130 + n * 2 + 1], pr = PWs[(d * 33 + k) * 130 + n * 2], pi = PWs[(d * 33 + k) * 130 + n * 2 + 1];
                v[e] = ri == 0 ? (cr * pr - ci * pi) : -(cr * pi + ci * pr); } }
        u32x4 w; w.x = pk2(v[0], v[1]); w.y = pk2(v[2], v[3]); w.z = pk2(v[4], v[5]); w.w = pk2(v[6], v[7]);
        *(u32x4*)(B3 + ((size_t)(g * 512 + j * 16 + p)) * KCAT + cc * 8) = w; }
    { const int d = qr >> 1, ri = qr & 1;
      for (int ch = tid; ch < 64 * 64; ch += 512) { const int n = ch >> 6, cc = ch & 63, i = cc >> 1, q0 = (cc & 1) * 8, k = d == 0 ? 31 - i : i; float v[8];
          const float pr = PWs[(d * 33 + k) * 130 + n * 2], pi = PWs[(d * 33 + k) * 130 + n * 2 + 1];
#pragma unroll
          for (int e = 0; e < 8; ++e) { const float br = BBs[((d * 64 + n) * 16 + q0 + e) * 2], bi = BBs[((d * 64 + n) * 16 + q0 + e) * 2 + 1]; v[e] = ri == 0 ? (pr * br - pi * bi) : (pr * bi + pi * br); }
          u32x4 w; w.x = pk2(v[0], v[1]); w.y = pk2(v[2], v[3]); w.z = pk2(v[4], v[5]); w.w = pk2(v[6], v[7]);
          *(u32x4*)(W1 + ((size_t)(g * 256 + qr * 64 + n)) * 512 + cc * 8) = w; } }
    __syncthreads();
}
struct EpiS1 {
    static constexpr bool PERM = true; float* L;
    EPI_NOPRE
    __device__ __forceinline__ void operator()(const f32x4 (&acc)[2][2][4][2], const pg8::Unit& u, int wr, int wc, int fr, int fq, const Pre& pre_) const {
        using namespace pg8; const int row0 = u.pm * BM + wr * 64 + fr, col0 = wc * 32 + 8 * fq;
#pragma unroll
        for (int ai = 0; ai < 2; ++ai)
#pragma unroll
            for (int m = 0; m < 4; ++m) { bf16_t* rp = (bf16_t*)L + ((size_t)u.grp * UROWS + row0 + ai * HALF + m * 16) * 256 + col0;
#pragma unroll
                for (int bj = 0; bj < 2; ++bj) { const f32x4 v0 = acc[ai][bj][m][0], v1 = acc[ai][bj][m][1];
                    u32x4 w; w.x = cvt_pk_bf16(v0[0], v0[1]); w.y = cvt_pk_bf16(v0[2], v0[3]); w.z = cvt_pk_bf16(v1[0], v1[1]); w.w = cvt_pk_bf16(v1[2], v1[3]);
                    *(u32x4*)(rp + bj * HALF) = w; } }
    }
};
struct EpiS3 {
    static constexpr bool PERM = true; bf16_t* SSM;
    EPI_NOPRE
    __device__ __forceinline__ void operator()(const f32x4 (&acc)[2][2][4][2], const pg8::Unit& u, int wr, int wc, int fr, int fq, const Pre& pre_) const {
        using namespace pg8; const int row0 = u.pm * BM + wr * 64 + fr, cl = u.pn * BM + wc * 32 + 8 * fq;
        EPI_ROWS_BF16(SSM + ((size_t)(u.grp * 1024 + row)) * 512 + cl, 128, gelu_tanh);
    }
};
struct OrderS1 { int G, c; bool xm;
    __device__ __forceinline__ bool next(int i, pg8::Unit& u) const {
        if (xm) { const int k = c >> 3; if (i != 0 || k >= 20) return false; u.grp = (c & 7) + 8 * (k / 5); u.pm = k % 5; u.pn = 0; return true; }
        const int L = i * G + c; if (L >= NG * 5) return false; u.grp = L / 5; u.pm = L % 5; u.pn = 0; return true; } };
struct OrderOne { pg8::Unit u0; __device__ __forceinline__ bool next(int i, pg8::Unit& u) const { if (i != 0) return false; u = u0; return true; } };
template <int MODE> struct EpiResNorm {
    static constexpr bool PERM = true;
    EPI_NOPRE
    const float* base; float* out; const float* gate; const float* fw; unsigned* xs; unsigned* cnt; LAS float* P;
    bf16_t* H2; const float* sh; const float* sc;
    bf16_t* x1b;
    __device__ __forceinline__ void operator()(f32x4 (&acc)[2][2][4][2], const pg8::Unit& u, int wr, int wc, int fr, int fq, const Pre& pre_) const {
        using namespace pg8; const int row0 = u.pm * BM + wr * 64 + fr, col0 = u.pn * BM + wc * 32 + 8 * fq;
        const int wid = wr * 4 + wc, lane = fq * 16 + fr;
        { const float* gp = gate + (size_t)((u.pm * BM) / SEQ) * 6144 + col0; f32x4 gv[2][2];
#pragma unroll
          for (int bj = 0; bj < 2; ++bj)
#pragma unroll
              for (int n = 0; n < 2; ++n) gv[bj][n] = *(const f32x4*)(gp + bj * HALF + n * 4);
#pragma unroll
          for (int ai = 0; ai < 2; ++ai) {
#pragma unroll
              for (int mh = 0; mh < 2; ++mh) {
              f32x4 xb[2][2][2];
#pragma unroll
              for (int m2 = 0; m2 < 2; ++m2)
#pragma unroll
                  for (int bj = 0; bj < 2; ++bj)
                      { const size_t o_ = (size_t)(row0 + ai * HALF + (2 * mh + m2) * 16) * 1024 + col0 + bj * HALF;
                          if (X1_BF16 && MODE == 0) { const u32x4 w_ = ((const u32x4*)x1b)[ll_idx(u.pm * 4 + u.pn, wr * 4 + wc, 16, ai * 8 + (2 * mh + m2) * 2 + bj, fq * 16 + fr)];
                              xb[m2][bj][0] = (f32x4){__uint_as_float(w_.x << 16), __uint_as_float(w_.x & 0xffff0000u), __uint_as_float(w_.y << 16), __uint_as_float(w_.y & 0xffff0000u)};
                              xb[m2][bj][1] = (f32x4){__uint_as_float(w_.z << 16), __uint_as_float(w_.z & 0xffff0000u), __uint_as_float(w_.w << 16), __uint_as_float(w_.w & 0xffff0000u)}; }
                          else { xb[m2][bj][0] = *(const f32x4*)(base + o_); xb[m2][bj][1] = *(const f32x4*)(base + o_ + 4); } }
#pragma unroll
              for (int m2 = 0; m2 < 2; ++m2) { const int m = 2 * mh + m2; float s = 0.f;
#pragma unroll
                  for (int bj = 0; bj < 2; ++bj)
#pragma unroll
                      for (int n = 0; n < 2; ++n) { const f32x4 x = xb[m2][bj][n] + gv[bj][n] * acc[ai][bj][m][n]; acc[ai][bj][m][n] = x; s += (x[0] * x[0] + x[1] * x[1]) + (x[2] * x[2] + x[3] * x[3]); }
                  s += __shfl_xor(s, 16); s += __shfl_xor(s, 32);
                  if (fq == 0) P[(ai * HALF + wr * 64 + m * 16 + fr) * 4 + wc] = s; } } } }
        asm volatile("s_waitcnt lgkmcnt(0)" ::: "memory"); __builtin_amdgcn_s_barrier(); asm volatile("" ::: "memory");
        const int prow = wid * 32 + (lane & 31);
        if (lane < 32) { const f32x4 p = *(const LAS f32x4*)(P + prow * 4);
            __hip_atomic_store(xs + ((size_t)(u.pm * BM + prow)) * 4 + u.pn, __float_as_uint((p[0] + p[1]) + (p[2] + p[3])), __ATOMIC_RELAXED, __HIP_MEMORY_SCOPE_AGENT); }
        asm volatile("s_waitcnt vmcnt(0)" ::: "memory");
        if (lane == 0) __hip_atomic_fetch_add(cnt + 64 * u.pm, 1u, __ATOMIC_RELAXED, __HIP_MEMORY_SCOPE_AGENT);
        if (wid == 0) {
            unsigned spins = 0;
            while ((unsigned)__builtin_amdgcn_readfirstlane(__hip_atomic_load(cnt + 64 * u.pm, __ATOMIC_RELAXED, __HIP_MEMORY_SCOPE_AGENT)) < 32u) { __builtin_amdgcn_s_sleep(2); if (++spins > (1u << 22)) break; }
            __builtin_amdgcn_fence(__ATOMIC_ACQUIRE, "agent");
        }
        asm volatile("s_waitcnt vmcnt(0) lgkmcnt(0)" ::: "memory"); __builtin_amdgcn_s_barrier(); asm volatile("" ::: "memory");
        if (lane < 32) { const unsigned* sl = xs + ((size_t)(u.pm * BM + prow)) * 4; float t = 0.f;
#pragma unroll
            for (int k = 0; k < 4; ++k) t += __uint_as_float(__hip_atomic_load(sl + k, __ATOMIC_RELAXED, __HIP_MEMORY_SCOPE_AGENT));
            P[1024 + prow] = rsqrtf(t * (1.f / DM) + EPS); }
        asm volatile("s_waitcnt lgkmcnt(0)" ::: "memory"); __builtin_amdgcn_s_barrier(); asm volatile("" ::: "memory");
        if (MODE == 0) {
            f32x4 fv[2][2];
#pragma unroll
            for (int bj = 0; bj < 2; ++bj)
#pragma unroll
                for (int n = 0; n < 2; ++n) fv[bj][n] = *(const f32x4*)(fw + col0 + bj * HALF + n * 4);
#pragma unroll
            for (int ai = 0; ai < 2; ++ai)
#pragma unroll
                for (int m = 0; m < 4; ++m) { const int r = ai * HALF + wr * 64 + m * 16 + fr; const float rs = P[1024 + r]; const size_t off = (size_t)(u.pm * BM + r) * 1024 + col0;
#pragma unroll
                    for (int bj = 0; bj < 2; ++bj)
#pragma unroll
                        for (int n = 0; n < 2; ++n) *(f32x4*)(out + off + bj * HALF + n * 4) = acc[ai][bj][m][n] * rs * fv[bj][n]; }
        } else {
            float rsv[2][4];
#pragma unroll
            for (int ai = 0; ai < 2; ++ai)
#pragma unroll
                for (int m = 0; m < 4; ++m) rsv[ai][m] = P[1024 + ai * HALF + wr * 64 + m * 16 + fr];
            const size_t mo = (size_t)((u.pm * BM) / SEQ) * 6144 + col0;
#pragma unroll
            for (int bj = 0; bj < 2; ++bj) { const int cc = bj * HALF;
                const f32x4 wwa = *(const f32x4*)(fw + col0 + cc), wwb = *(const f32x4*)(fw + col0 + cc + 4), s1a = *(const f32x4*)(sc + mo + cc) + 1.f, s1b = *(const f32x4*)(sc + mo + cc + 4) + 1.f, s0a = *(const f32x4*)(sh + mo + cc), s0b = *(const f32x4*)(sh + mo + cc + 4);
#pragma unroll
                for (int ai = 0; ai < 2; ++ai)
#pragma unroll
                    for (int m = 0; m < 4; ++m) { const size_t ro = (size_t)(row0 + ai * HALF + m * 16) * 1024 + col0 + cc; const f32x4 xa = acc[ai][bj][m][0], xb_ = acc[ai][bj][m][1];
                        if (X1_BF16) { u32x4 xw; xw.x = cvt_pk_bf16(xa[0], xa[1]); xw.y = cvt_pk_bf16(xa[2], xa[3]); xw.z = cvt_pk_bf16(xb_[0], xb_[1]); xw.w = cvt_pk_bf16(xb_[2], xb_[3]); ((u32x4*)x1b)[ll_idx(u.pm * 4 + u.pn, wr * 4 + wc, 16, ai * 8 + m * 2 + bj, fq * 16 + fr)] = xw; }
                        else { *(f32x4*)(out + ro) = xa; *(f32x4*)(out + ro + 4) = xb_; }
                        const f32x4 ya = (xa * rsv[ai][m] * wwa) * s1a + s0a, yb = (xb_ * rsv[ai][m] * wwb) * s1b + s0b; u32x4 w; w.x = cvt_pk_bf16(ya[0], ya[1]); w.y = cvt_pk_bf16(ya[2], ya[3]); w.z = cvt_pk_bf16(yb[0], yb[1]); w.w = cvt_pk_bf16(yb[2], yb[3]);
                        { const int t64 = m * 16 + fr, rv = ((t64 & 3) << 4) | (t64 >> 2);
                          *(u32x4*)((char*)H2 + blk16x32(u.pm, 16, u.pn * 4 + bj * 2 + (wc >> 1), ai, wr * 4 + (rv >> 4), wc & 1) + ((rv & 15) * 32 + 8 * fq) * 2) = w; } }
                asm volatile("" ::: "memory"); }
        }
    }
};
struct OrderRect { pg8::StaticOrder so; __device__ __forceinline__ bool next(int i, pg8::Unit& u) const { return so.next(i, u); } };
struct OrderRot { pg8::StaticOrder so; __device__ __forceinline__ bool next(int i, pg8::Unit& u) const { if (!so.next(i, u)) return false; u.pn = (u.pn & ~3) | ((u.pn + ((u.pm >> 3) & 1)) & 3); return true; } };
struct OrderA {
    pg8::StaticOrder so;
    __device__ __forceinline__ bool next(int i, pg8::Unit& u) const {
        if (so.next(i, u)) return true;
        const long L = (long)i * so.G + so.c - so.nwg; if (L < 0 || L >= 64) return false;
        u.pm = 128 + (int)(L >> 2); u.pn = 4 + (int)(L & 3); u.grp = 0; return true;
    }
};

__global__ void __launch_bounds__(NWV * 64, 2) mk_fwd(MkArgs a) {
    extern __shared__ __attribute__((aligned(16))) unsigned char lds_raw[];
    LAS unsigned char* lds = (LAS unsigned char*)lds_raw;
#if !USE_XBAR
    cg::grid_group grid = cg::this_grid();
#endif
    const int tid0 = threadIdx.x, wave = __builtin_amdgcn_readfirstlane(tid0 >> 6);
#define PHASE_IDS const int tid = opaque_tid(wave), lane = tid & 63; (void)tid; (void)lane
    const int G = gridDim.x, bx = blockIdx.x;
    const int gw = bx * NWV + wave, NGW = G * NWV;
    unsigned char* ws = a.ws;
#define mod ((float*)(ws + WS_MOD))
#define WTin ((bf16_t*)(ws + WS_WIN))
#define WTbr ((bf16_t*)(ws + WS_WBR))
#define WTglu ((bf16_t*)(ws + WS_WGLU))
#define WTout ((bf16_t*)(ws + WS_WOUT))
#define WTup ((bf16_t*)(ws + WS_WUP))
#define WTdn ((bf16_t*)(ws + WS_WDN))
#define H ((bf16_t*)(ws + WS_H))
#define Q ((bf16_t*)(ws + WS_Q))
#define Kb ((bf16_t*)(ws + WS_K))
#define Vb ((bf16_t*)(ws + WS_V))
#define Ucat ((bf16_t*)(ws + WS_UCAT))
#define Uctx Ucat
#define SG ((bf16_t*)(ws + WS_SG))
#define O ((bf16_t*)(ws + WS_O))
#define SSM ((bf16_t*)(ws + WS_SSM))
#define GLU ((bf16_t*)(ws + WS_GLU))
#define MG ((bf16_t*)out)
#define H2 ((bf16_t*)(ws + WS_H2))
#define Ab ((bf16_t*)(ws + WS_A))
#define Ytmp ((float*)(ws + WS_YTMP))
    float* const out = a.out;
    const int lo = a.ph_lo, hi = a.ph_hi;
    volatile LAS unsigned* bst = (volatile LAS unsigned*)(lds + MK_LDS - 16);
    if (tid0 < 3) bst[tid0] = 0u;
    __syncthreads();
    XcdBarrier xbar = xcd_barrier_post((unsigned*)(ws + WS_CTL), bst);
    if (tid0 == 0 && xbar.x != (unsigned)(bx & 7)) (void)xb_add((unsigned*)(ws + WS_CTL) + GB_MISMATCH, 1u);
    bool grp_ok = false; unsigned tgen = 0u; (void)tgen;
#define IN(k) (lo <= (k) && (k) < hi)
#if USE_XBAR
#define SEAM(k) do { if (IN(k) && IN((k) + 1)) xcd_barrier(xbar); } while (0)
#define SEAMG(k) do { if (IN(k) && IN((k) + 1)) { if (grp_ok) grp_barrier(xbar); else xcd_barrier(xbar); } } while (0)
#define SEAMGT(k, topw) do { if (IN(k) && IN((k) + 1)) { if (grp_ok) grp_barrier(xbar, (unsigned*)(ws + WS_CTL) + (topw)); else xcd_barrier(xbar); } } while (0)
#define SEAMT(k) do { if (IN(k) && IN((k) + 1)) { if (grp_ok) team_barrier((unsigned*)(ws + WS_CTL) + TB_WORD(bx & 7, (bx >> 3) & 7), ++tgen); else xcd_barrier(xbar); } } while (0)
#else
#define SEAM(k) do { if (IN(k) && IN((k) + 1)) grid.sync(); } while (0)
#define SEAMG(k) SEAM(k)
#define SEAMGT(k, topw) SEAM(k)
#define SEAMT(k) SEAM(k)
#endif

    if (IN(0)) REPS(0) { PHASE_IDS;
        if (bx < 256) {
            LAS float* sc = (LAS float*)lds;
            LAS float* red = (LAS float*)(lds + 17 * 1024 * 4);
            for (int i = tid; i < 17 * 1024; i += NWV * 64) { const int r = i >> 10, k = i & 1023; sc[i] = siluf_(r < NB ? a.in[1][(size_t)r * DM + k] : a.in[3][k]); }
            __syncthreads();
            const float* wm = a.in[4]; const int ks = tid >> 5, c = tid & 31;
            for (int ch = bx; ch < 256; ch += G) {
                float acc[17];
#pragma unroll
                for (int r = 0; r < 17; ++r) acc[r] = 0.f;
                if (c < 24) { const float* wp = wm + (size_t)(ks * 64) * 6144 + ch * 24 + c;
#pragma unroll 4
                    for (int k = 0; k < 64; ++k) { const float w = wp[(size_t)k * 6144];
#pragma unroll
                        for (int r = 0; r < 17; ++r) acc[r] = fmaf(sc[r * 1024 + ks * 64 + k], w, acc[r]); }
#pragma unroll
                    for (int r = 0; r < 17; ++r) red[(ks * 17 + r) * 24 + c] = acc[r]; }
                __syncthreads();
                if (tid < 17 * 24) { const int r = tid / 24, cc = tid % 24; float s = a.in[5][ch * 24 + cc];
#pragma unroll
                    for (int w = 0; w < 16; ++w) s += red[(w * 17 + r) * 24 + cc];
                    mod[(size_t)r * 6144 + ch * 24 + cc] = s; }
                __syncthreads();
            }
        }
        LAS float* scr = (LAS float*)(lds + wave * 16384);
        for (int it = gw; it < (DM / 64) * (DIN / 32); it += NGW) transpose_item<0>(a.in[8], DM, DIN, WTin, scr, it, lane);
    }
    SEAM(0);
#if USE_XBAR && GRP_SEAMS
    if (IN(0) && IN(1)) {
        if (tid0 == 0) bst[2] = (xb_ld((unsigned*)(ws + WS_CTL) + GB_MISMATCH) == 0u && bst[0] == 32u && bst[1] == 8u && G == 256) ? 1u : 0u;
        __syncthreads();
        grp_ok = bst[2] != 0u;
    }
#endif
    if (IN(1)) REPS(1) { PHASE_IDS;
        const bool full = G >= 256;
        unsigned* ctxcnt = (unsigned*)(ws + WS_CTL + 98304) + 64 * 8;
        constexpr int I_SQ = (DM / 64) * (DM / 32), I_GLU = (512 / 64) * (2048 / 32), I_UP = (DM / 64) * (NUP / 32), I_DN = (DFF / 64) * (DM / 32);
        constexpr int NITEMS = 2 * I_SQ + I_GLU + I_UP + I_DN, A_ITEMS = 1664;
#define COPY_ITEM(r_) do { int r = (r_); \
            if (r < I_SQ) { transpose_item<0>(a.in[11], DM, DM, WTbr, scr, r, lane); break; } r -= I_SQ; \
            if (r < I_GLU) { transpose_item<2>(a.in[20], 512, 2048, WTglu, scr, r, lane); break; } r -= I_GLU; \
            if (r < I_SQ) { transpose_item<0>(a.in[21], DM, DM, WTout, scr, r, lane); break; } r -= I_SQ; \
            if (r < I_UP) { transpose_item<1>(a.in[22], DM, NUP, WTup, scr, r, lane); break; } r -= I_UP; \
            transpose_item<0>(a.in[25], DFF, DM, WTdn, scr, r, lane); } while (0)
        if (full) {
            if (bx >= 192) {
                const int lane = opaque_tid(wave) & 63; const int r0 = ML + 64 * (bx - 192);
                for (int r = r0 + 4 * wave; r < r0 + 64; r += 4 * NWV) norm_mod_rows4(a.in[2] + (size_t)(r - ML) * DM, a.in[6], mod + (size_t)NB * 6144, mod + (size_t)NB * 6144 + 1024, H + (size_t)r * DM, lane);
                asm volatile("s_waitcnt vmcnt(0)" ::: "memory"); __syncthreads();
                if (threadIdx.x == 0) { __builtin_amdgcn_fence(__ATOMIC_RELEASE, "agent"); asm volatile("s_waitcnt vmcnt(0)" ::: "memory"); __hip_atomic_fetch_add(ctxcnt, 1u, __ATOMIC_RELAXED, __HIP_MEMORY_SCOPE_AGENT); }
            }
            if (bx < 64) {
                const int L = bx; const int lane = opaque_tid(wave) & 63; LAS float* scr = (LAS float*)(lds + wave * 16384);
                for (int it = bx * NWV + wave; it < A_ITEMS; it += 64 * NWV) COPY_ITEM(it);
                if (threadIdx.x < 64) { unsigned spins = 0;
                    while ((unsigned)__builtin_amdgcn_readfirstlane(__hip_atomic_load(ctxcnt, __ATOMIC_RELAXED, __HIP_MEMORY_SCOPE_AGENT)) < 64u) { __builtin_amdgcn_s_sleep(2); if (++spins > (1u << 22)) break; }
                    __builtin_amdgcn_fence(__ATOMIC_ACQUIRE, "agent"); asm volatile("s_waitcnt vmcnt(0)" ::: "memory"); }
                __syncthreads();
                pg8::Gemm g{H, WTin, DM, DM, DM, 0, 0, 0}; OrderOne S{{128 + (L >> 2), 4 + (L & 3), 0}}; EpiAfast E{Q, Kb, Vb, Ucat, SG, a.in[9], a.in[10], (LAS float*)(lds + 131072)};
                pg8::gemm_phase<EpiAfast, OrderOne>(lds, g, S, E, wave);
            }
            if (bx >= 64 && bx < 192) {
                const int ib = bx - 64; const int tid = opaque_tid(wave), lane = tid & 63;
                S5In s5{a.in[12], a.in[13], a.in[14], a.in[15], a.in[16], a.in[17], a.in[18], a.in[19]};
                __syncthreads();
                REPS(17) s5_tables_block(s5, ib >> 2, ib & 3, (bf16_t*)((char*)a.out + OUT_W1), (bf16_t*)((char*)a.out + OUT_B3), (float*)(ws + WS_A32), lds, tid);
                LAS float* scr = (LAS float*)(lds + wave * 16384);
                REPS(18) for (int it = A_ITEMS + ib * NWV + wave; it < NITEMS; it += 128 * NWV) COPY_ITEM(it);
            }
        } else {
            { const int tid = opaque_tid(wave), lane = tid & 63; S5In s5{a.in[12], a.in[13], a.in[14], a.in[15], a.in[16], a.in[17], a.in[18], a.in[19]};
              __syncthreads();
              for (int it = bx; it < 128; it += G) s5_tables_block(s5, it >> 2, it & 3, (bf16_t*)((char*)a.out + OUT_W1), (bf16_t*)((char*)a.out + OUT_B3), (float*)(ws + WS_A32), lds, tid);
              LAS float* scr = (LAS float*)(lds + wave * 16384);
              for (int it = bx * NWV + wave; it < NITEMS; it += G * NWV) COPY_ITEM(it); }
            for (int L = bx; L < 64; L += G) {
                const int r0 = ML + 256 * (L >> 2); const int lane = opaque_tid(wave) & 63;
                __syncthreads();
                for (int r = r0 + 4 * wave; r < r0 + 256; r += 4 * NWV) norm_mod_rows4(a.in[2] + (size_t)(r - ML) * DM, a.in[6], mod + (size_t)NB * 6144, mod + (size_t)NB * 6144 + 1024, H + (size_t)r * DM, lane);
                asm volatile("s_waitcnt vmcnt(0)" ::: "memory"); __syncthreads();
                pg8::Gemm g{H, WTin, DM, DM, DM, 0, 0, 0}; OrderOne S{{128 + (L >> 2), 4 + (L & 3), 0}}; EpiAfast E{Q, Kb, Vb, Ucat, SG, a.in[9], a.in[10], (LAS float*)(lds + 131072)};
                pg8::gemm_phase<EpiAfast, OrderOne>(lds, g, S, E, wave);
            }
        }
#undef COPY_ITEM
        { const int lane = opaque_tid(wave) & 63; const int xl = bx & 7; unsigned* head = (unsigned*)(ws + WS_CTL + 98304) + 64 * xl;
          for (;;) { unsigned c = 0; if (lane == 0) c = __hip_atomic_fetch_add(head, 1u, __ATOMIC_RELAXED, __HIP_MEMORY_SCOPE_AGENT); c = (unsigned)__builtin_amdgcn_readfirstlane((int)c);
              if (c >= 256u) break;
              const int r0 = xl * 4096 + (int)c * 16; const int mb = r0 / SEQ;
#pragma unroll 1
              for (int r = r0; r < r0 + 16; r += 4) norm_mod_rows4(a.in[0] + (size_t)r * DM, a.in[6], mod + (size_t)mb * 6144, mod + (size_t)mb * 6144 + 1024, H + (size_t)r * DM, lane); } }
    }
    SEAMGT(1, GB_TOPA);
    if (IN(2)) REPS(2) {
        pg8::Gemm g{H, WTin, DM, DM, DM, 0, 0, 0}; OrderRot S; S.so.init(ML / 256, DIN / 256, G, bx);
        EpiAfast E{Q, Kb, Vb, Ucat, SG, a.in[9], a.in[10], (LAS float*)(lds + 131072)};
        pg8::gemm_phase<EpiAfast, OrderRot>(lds, g, S, E, wave);
    }
    SEAMGT(2, GB_TOPB);
    const float* Lb = (const float*)((char*)a.out + OUT_L); const float* A32 = (const float*)(ws + WS_A32);
    unsigned* s1cnt = (unsigned*)(ws + WS_CTL) + 14464 + 64 * (bx & 7);
#define S5_RECUR(g, pm) do { const int bl = tid >> 7, d = (tid >> 6) & 1, n = tid & 63, b = pm * 4 + bl; \
              const float ar = A32[((d * NG + g) * NS + n) * 2], ai = A32[((d * NG + g) * NS + n) * 2 + 1]; \
              const unsigned short* Lg = (const unsigned short*)Lb + (size_t)g * UROWS * 256 + sidx(d, 0, n); bf16_t* Sg = Ucat + (size_t)g * UROWS * KCAT + 512 + sidx(d, 0, n); \
              float sr = 0.f, si = 0.f; \
              { float lr[8], li[8]; \
_Pragma("unroll") \
                for (int i = 0; i < 8; ++i) { const int row = 1024 + b * 8 + (d == 0 ? i : 7 - i); lr[i] = __uint_as_float((unsigned)Lg[(size_t)row * 256] << 16); li[i] = __uint_as_float((unsigned)Lg[(size_t)row * 256 + 64] << 16); } \
_Pragma("unroll") \
                for (int i = 0; i < 8; ++i) { const float t0 = ar * sr - ai * si + lr[i], t1 = ar * si + ai * sr + li[i]; sr = t0; si = t1; } } \
_Pragma("unroll 1") \
              for (int i0 = 0; i0 < 64; i0 += 32) { float lr[32], li[32]; \
_Pragma("unroll") \
                  for (int i = 0; i < 32; ++i) { const int row = b * 64 + (d == 0 ? i0 + i : 63 - i0 - i); lr[i] = __uint_as_float((unsigned)Lg[(size_t)row * 256] << 16); li[i] = __uint_as_float((unsigned)Lg[(size_t)row * 256 + 64] << 16); } \
_Pragma("unroll") \
                  for (int i = 0; i < 32; ++i) { const int row = b * 64 + (d == 0 ? i0 + i : 63 - i0 - i); \
                      Sg[(size_t)row * KCAT] = f2bf(sr); Sg[(size_t)row * KCAT + 64] = f2bf(si); \
                      const float t0 = ar * sr - ai * si + lr[i], t1 = ar * si + ai * sr + li[i]; sr = t0; si = t1; } } \
              asm volatile("s_waitcnt vmcnt(0)" ::: "memory"); __syncthreads(); } while (0)
    if (IN(4)) REPS(4) {
        if (grp_ok) top_wait((unsigned*)(ws + WS_CTL) + GB_TOPA);
        const int nrounds = (NB * 2 * 32 + G - 1) / G;
        for (int i = 0; i < nrounds; ++i) {
#if !S5_NAIVE
            if (i == (grp_ok ? 1 : 0)) {
                if (grp_ok && (bx >> 3) < 20) top_wait((unsigned*)(ws + WS_CTL) + GB_TOPB);
                pg8::Gemm g{Ucat, (const bf16_t*)((char*)a.out + OUT_W1), KCAT, 512, 512, (size_t)UROWS * KCAT * 2, (size_t)256 * 512 * 2, 0}; OrderS1 S{G, bx, grp_ok}; EpiS1 E{(float*)((char*)a.out + OUT_L)}; pg8::gemm_phase<EpiS1, OrderS1>(lds, g, S, E, wave);
                if (grp_ok && (bx >> 3) < 20 && tid0 == 0) (void)xb_add(s1cnt, 1u); }
#endif
            int unit; if (G == 256) { const int bk = grp_ok ? (2 * (bx & 7) + (i >> 1)) * 2 + (i & 1) : i * 8 + (bx & 7), s = bx >> 3; unit = bk * 32 + s; } else unit = i * G + bx;
            if (unit >= NB * 2 * 32) break;
            const int bk = unit >> 5, s = unit & 31, b = bk >> 1, kvh = bk & 1, h = kvh * 4 + (s >> 3), qb = s & 7;
            const size_t q0 = ((size_t)b * SEQ + (size_t)qb * 256) * 1024 + h * 128, k0 = (size_t)b * LKV * 256 + kvh * 128;
            att::attn_dense_body(Q + q0, Kb + k0, Vb + k0, O, LKV, (char*)lds_raw, wave, b * 8 + qb, h);
        }
#if !S5_NAIVE
        if (grp_ok && (bx >> 3) >= 20) {
            const int tid = opaque_tid(wave);
            if (tid0 < 64) { unsigned spins = 0;
                while ((unsigned)__builtin_amdgcn_readfirstlane(xb_ld(s1cnt)) < 20u) { __builtin_amdgcn_s_sleep(2); if (++spins > (1u << 22)) break; }
                __builtin_amdgcn_fence(__ATOMIC_ACQUIRE, "agent"); asm volatile("s_waitcnt vmcnt(0)" ::: "memory"); }
            __syncthreads();
            for (int it = (bx >> 3) - 20; it < 16; it += 12) { const int g = (bx & 7) + 8 * (it >> 2), pm = it & 3; S5_RECUR(g, pm); }
        }
#endif
    }
    SEAMG(4);
    if (IN(5)) REPS(5) { PHASE_IDS;
#if S5_NAIVE
        S5In s5{a.in[12], a.in[13], a.in[14], a.in[15], a.in[16], a.in[17], a.in[18], a.in[19]};
        for (int it = bx * 2 + wave; wave < 2 && it < NB * NG; it += G * 2) s5_naive_wave(s5, Ucat, Uctx, Ytmp, SSM, lane, it & 31, it >> 5);
#else
        for (int un = bx; un < 256; un += G) {
            const int g = grp_ok ? (un & 7) + 8 * (un >> 6) : un >> 3, pm = grp_ok ? (un >> 4) & 3 : (un >> 1) & 3, pn = grp_ok ? (un >> 3) & 1 : un & 1;
            if (!grp_ok) S5_RECUR(g, pm);
            pg8::Gemm gm{Ucat, (const bf16_t*)((char*)a.out + OUT_B3), KCAT, KCAT, KCAT, (size_t)UROWS * KCAT * 2, (size_t)512 * KCAT * 2, 0}; OrderOne S{{pm, pn, g}}; EpiS3 E{SSM};
            REPS(20) pg8::gemm_phase<EpiS3, OrderOne>(lds, gm, S, E, wave);
        }
#endif
    }
    SEAM(5);
#undef S5_RECUR
    if (IN(6)) REPS(6) { pg8::Gemm g{SSM, WTglu, 512, 512, 512, 0, 0, 1}; OrderRect S; S.so.init(ML / 256, 2048 / 256, G, bx); EpiGluPair E{SG, GLU}; pg8::gemm_phase<EpiGluPair, OrderRect>(lds, g, S, E, wave); }
    SEAMT(6);
    if (IN(7)) REPS(7) { pg8::Gemm g{O, WTbr, DM, DM, DM, 0, 0, 4}; OrderRect S; S.so.init(ML / 256, DM / 256, G, bx); EpiMergeFast E{SG, GLU, MG}; pg8::gemm_phase<EpiMergeFast, OrderRect>(lds, g, S, E, wave); }
    SEAMT(7);
    if (IN(8)) REPS(8) {
#if STAGGER8_US > 0
        if ((bx & 7) >= 4) { const unsigned long long t0 = __builtin_amdgcn_s_memrealtime(); while (__builtin_amdgcn_s_memrealtime() - t0 < (unsigned long long)(STAGGER8_US * 100)) __builtin_amdgcn_s_sleep(32); }
#endif
        pg8::Gemm g{MG, WTout, DM, DM, DM, 0, 0, 5}; OrderRect S; S.so.init(ML / 256, DM / 256, G, bx); EpiResNorm<1> E{a.in[0], out, mod + 2048, a.in[7], (unsigned*)(ws + WS_XS2), (unsigned*)(ws + WS_CTL + 65536), (LAS float*)(lds + 131072), H2, mod + 3072, mod + 4096, (bf16_t*)(ws + WS_X1B)}; pg8::gemm_phase<EpiResNorm<1>, OrderRect>(lds, g, S, E, wave); }
    SEAMT(8);
    if (IN(10)) REPS(10) { pg8::Gemm g{H2, WTup, DM, DM, DM, 0, 0, 4}; OrderRect S; S.so.init(ML / 256, NUP / 256, G, bx);
        EpiUpConv E{Ab, (float*)(ws + WS_HALO), a.in[23], a.in[24], (LAS float*)(lds + 131072), (LAS float*)(lds + 131072 + 8192)}; pg8::gemm_phase<EpiUpConv, OrderRect>(lds, g, S, E, wave); }
    SEAMG(10);
    if (IN(14)) { PHASE_IDS; pg8::Gemm g{Ab, WTdn, DFF, DFF, DFF, 0, 0, 3}; OrderRect S; S.so.init(ML / 256, DM / 256, G, bx);
        { pg8::Unit u; for (int i = 0; S.next(i, u); ++i) conv_fix_panel(u.pm, (const float*)(ws + WS_HALO), a.in[23], Ab, tid); asm volatile("s_waitcnt vmcnt(0)" ::: "memory"); __syncthreads(); }
        EpiResNorm<0> E{out, out, mod + 5120, a.in[26], (unsigned*)(ws + WS_XS), (unsigned*)(ws + WS_CTL + 16384), (LAS float*)(lds + 131072), nullptr, nullptr, nullptr, (bf16_t*)(ws + WS_X1B)}; pg8::gemm_phase<EpiResNorm<0>, OrderRect>(lds, g, S, E, wave); }
#undef IN
#undef SEAM
#undef SEAMG
#undef SEAMGT
#undef SEAMT
#undef mod
#undef WTin
#undef WTbr
#undef WTglu
#undef WTout
#undef WTup
#undef WTdn
#undef H
#undef Q
#undef Kb
#undef Vb
#undef Ucat
#undef Uctx
#undef SG
#undef O
#undef SSM
#undef GLU
#undef MG
#undef H2
#undef Ab
#undef Ytmp
}

extern "C" void kernel_launch(void* const* d_in, const int* in_sizes, int n_in, void* d_out, int out_size, void* d_ws, size_t ws_size, hipStream_t stream) {
    static int grid_blocks = 0;
    if (grid_blocks == 0) {
        if (n_in != 27 || in_sizes[0] != ML * DM || out_size != ML * DM || ws_size < WS_NEED) {
            fprintf(stderr, "kernel_launch: unexpected shapes: n_in %d in0 %d out %d ws %zu (need >= %zu)\n", n_in, n_in > 0 ? in_sizes[0] : -1, out_size, ws_size, (size_t)WS_NEED); grid_blocks = -1; return; }
        int dev = 0, cus = 0, per_cu = 0;
        if (hipGetDevice(&dev) != hipSuccess || hipDeviceGetAttribute(&cus, hipDeviceAttributeMultiprocessorCount, dev) != hipSuccess) { fprintf(stderr, "kernel_launch: device query failed\n"); grid_blocks = -1; return; }
        if (hipFuncSetAttribute((const void*)mk_fwd, hipFuncAttributeMaxDynamicSharedMemorySize, MK_LDS) != hipSuccess) { fprintf(stderr, "kernel_launch: hipFuncSetAttribute(mk_fwd) failed\n"); grid_blocks = -1; return; }
        if (hipOccupancyMaxActiveBlocksPerMultiprocessor(&per_cu, (const void*)mk_fwd, NWV * 64, MK_LDS) != hipSuccess || per_cu < 1) { fprintf(stderr, "kernel_launch: occupancy query says %d blocks/CU\n", per_cu); grid_blocks = -1; return; }
        grid_blocks = cus;
    }
    if (grid_blocks < 0) return;
    if (hipMemsetAsync((char*)d_ws + WS_CTL, 0, 131072, stream) != hipSuccess) fprintf(stderr, "kernel_launch: memset failed\n");
    MkArgs a{};
    for (int i = 0; i < 27; ++i) a.in[i] = (const float*)d_in[i];
    a.out = (float*)d_out; a.ws = (unsigned char*)d_ws; a.ph_lo = 0; a.ph_hi = 16;
    void* args[] = {&a};
    hipError_t e = hipLaunchCooperativeKernel((const void*)mk_fwd, dim3(grid_blocks), dim3(NWV * 64), args, MK_LDS, stream);
    if (e != hipSuccess) fprintf(stderr, "kernel_launch: cooperative launch failed: %s (grid %d)\n", hipGetErrorString(e), grid_blocks);
}
```

```cpp
#include <hip/hip_runtime.h>
#include <cstdio>
#include <cstdint>

typedef unsigned short bf16_t;
typedef short bf16x8 __attribute__((ext_vector_type(8)));
typedef short s16x4 __attribute__((ext_vector_type(4)));
typedef float f32x4 __attribute__((ext_vector_type(4)));
typedef float f32x16 __attribute__((ext_vector_type(16)));
typedef unsigned u32x4 __attribute__((ext_vector_type(4)));
typedef unsigned u32x2 __attribute__((ext_vector_type(2)));
typedef float f32x2 __attribute__((ext_vector_type(2)));

constexpr int NB = 16, SEQ = 2048, DM = 1024, LC = 256, LKV = LC + SEQ;
constexpr int ML = NB * SEQ, MC = NB * LC, MT = ML + MC;
constexpr int DIN = 4096, DFF = 2816, NUP = 2 * DFF;
constexpr int NG = 32, NS = 64, PG = 16;
constexpr int TCH = 32, NCH = SEQ / TCH, KCAT = TCH * PG + 256;
constexpr int UROWS = 1280;
constexpr float EPS = 1e-6f;

constexpr size_t MiB = 1u << 20;
constexpr size_t WS_CTL = 0, WS_MOD = 1 * MiB;
constexpr size_t WS_WIN = 16 * MiB, WS_WBR = 24 * MiB, WS_WGLU = 26 * MiB, WS_WOUT = 28 * MiB, WS_WUP = 30 * MiB, WS_WDN = 41 * MiB;
constexpr size_t WS_H = 48 * MiB;
constexpr size_t WS_Q = 120 * MiB;
constexpr size_t WS_K = 184 * MiB;
constexpr size_t WS_V = 202 * MiB;
constexpr size_t WS_UCAT = 220 * MiB;
constexpr size_t WS_SG = 280 * MiB;
constexpr size_t WS_O = 408 * MiB;
constexpr size_t WS_SSM = 472 * MiB;
constexpr size_t WS_A32 = 2 * MiB;
constexpr size_t OUT_W1 = 0, OUT_B3 = 8 * MiB, OUT_L = 32 * MiB;
constexpr size_t WS_YTMP = 48 * MiB;
constexpr size_t WS_GLU = 48 * MiB;
constexpr size_t WS_H2 = 48 * MiB;
constexpr size_t WS_A = 112 * MiB;
constexpr size_t WS_HALO = 368 * MiB;
constexpr size_t WS_XS = 380 * MiB;
constexpr size_t WS_XS2 = 381 * MiB;
constexpr size_t WS_X1B = 280 * MiB;
constexpr int A_SPLIT_PM = 122; constexpr size_t A_HI_SHIFT = 384 * MiB - (112 * MiB + (size_t)A_SPLIT_PM * 44 * 32768);
constexpr size_t WS_NEED = 512 * MiB;

__device__ __forceinline__ int opaque_tid(int wave) { int t = wave * 64 + (int)__builtin_amdgcn_mbcnt_hi(~0u, __builtin_amdgcn_mbcnt_lo(~0u, 0u)); asm volatile("" : "+v"(t)); return t; }
__device__ __forceinline__ float bf2f(bf16_t v) { return __uint_as_float(((unsigned)v) << 16); }
typedef __bf16 bf16v2_t __attribute__((ext_vector_type(2)));
__device__ __forceinline__ unsigned pk2(float lo, float hi) { const f32x2 v = {lo, hi}; return __builtin_bit_cast(unsigned, __builtin_convertvector(v, bf16v2_t)); }
__device__ __forceinline__ bf16_t f2bf(float f) { return (bf16_t)(pk2(f, f) & 0xffffu); }
__device__ __forceinline__ float sigmoidf_(float x) { return __builtin_amdgcn_rcpf(1.f + __expf(-x)); }
__device__ __forceinline__ float siluf_(float x) { return x * __builtin_amdgcn_rcpf(1.f + __expf(-x)); }
__device__ __forceinline__ float gelu_tanh(float x) { const float u = 0.7978845608028654f * (x + 0.044715f * x * x * x); return x * __builtin_amdgcn_rcpf(1.f + __expf(-2.f * u)); }
__device__ __forceinline__ float wave_sum(float v) {
#pragma unroll
    for (int o = 1; o < 64; o <<= 1) v += __shfl_xor(v, o);
    return v;
}
__device__ __forceinline__ size_t ucat_idx(int b, int t, int ch) { const int g = ch >> 4, q = ch & 15, c = t >> 5, j = t & 31; return ((size_t)(g * UROWS + b * NCH + c)) * KCAT + j * PG + q; }
__device__ __forceinline__ size_t ucat_ctx_idx(int b, int tc, int ch) { const int g = ch >> 4, q = ch & 15, c = tc >> 5, j = tc & 31; return ((size_t)(g * UROWS + 1024 + b * 8 + c)) * KCAT + j * PG + q; }

__device__ __forceinline__ void qk_norm_rope_row(bf16_t* p, const float* __restrict__ w, int pos, int lane) {
    const unsigned raw = *(const unsigned*)(p + 2 * lane);
    const float v0 = bf2f((bf16_t)(raw & 0xffff)), v1 = bf2f((bf16_t)(raw >> 16));
    const float rs = rsqrtf(wave_sum(v0 * v0 + v1 * v1) * (1.f / 128.f) + EPS);
    float y0 = v0 * rs * w[2 * lane], y1 = v1 * rs * w[2 * lane + 1];
    if (pos >= 0) {
        const float coord = (lane < 32) ? (float)(pos >> 6) : (float)(pos & 63);
        const float invf = exp2f(-(float)(2 * (lane & 31)) * (13.287712379549449f / 64.f));
        const float ang = coord * invf; const float cs = cosf(ang), sn = sinf(ang);
        const float o0 = y0 * cs - y1 * sn, o1 = y0 * sn + y1 * cs; y0 = o0; y1 = o1;
    }
    *(unsigned*)(p + 2 * lane) = (unsigned)f2bf(y0) | ((unsigned)f2bf(y1) << 16);
}
__device__ __forceinline__ size_t blk16x32(int pm, int KT, int kt, int half, int rb8, int kb2) { return ((((((size_t)pm * KT + kt) * 2 + half) * 8 + rb8) * 2 + kb2)) * 1024; }
namespace att {
constexpr int D = 128, NW = 8, QBLK = 32, KVBLK = 64;
constexpr float SCALE = 0.088388347648318440f;
constexpr float THR = 8.f;
#ifndef ATT_SDEPTH
#define ATT_SDEPTH 2
#endif
constexpr int LDQ = 1024, LDK = 256, LDO = 1024;
constexpr size_t SHM_V = KVBLK * D * 2, SHM_K = KVBLK * D * 2, SHM_ATTN = 2 * SHM_V + 2 * SHM_K + NW * 64 * 4;
#define KSWZ(row, colB) ((row) * 256 + ((colB) ^ (((row) & 7) << 4)))
#define SBAR() __builtin_amdgcn_sched_barrier(0)
__device__ __forceinline__ int crow(int r, int hi) { return (r & 3) + 8 * (r >> 2) + 4 * hi; }
__device__ __forceinline__ unsigned cvtpk(float lo, float hi) { unsigned r; asm volatile("v_cvt_pk_bf16_f32 %0, %1, %2" : "=v"(r) : "v"(lo), "v"(hi)); return r; }
__device__ __forceinline__ void partialSM(f32x16& p0, f32x16& p1, float& m_reg, float& mn, float& alpha) {
    constexpr float C = SCALE * 1.4426950408889634f;
    float pmax = p0[0]; for (int r = 1; r < 16; ++r) pmax = fmaxf(pmax, p0[r]); for (int r = 0; r < 16; ++r) pmax = fmaxf(pmax, p1[r]);
    { auto rr = __builtin_amdgcn_permlane32_swap(__float_as_uint(pmax), __float_as_uint(pmax), false, false);
      pmax = fmaxf(__uint_as_float(rr[0]), __uint_as_float(rr[1])); }
    if (__builtin_expect(__all(pmax - m_reg <= THR / SCALE), 1)) { mn = m_reg; alpha = 1.f; }
    else { mn = fmaxf(m_reg, pmax); alpha = __builtin_amdgcn_exp2f((m_reg - mn) * C); m_reg = mn; }
    float mnC = -mn * C;
    for (int r = 0; r < 16; ++r) p0[r] = fmaf(p0[r], C, mnC); for (int r = 0; r < 16; ++r) p1[r] = fmaf(p1[r], C, mnC);
    for (int r = 0; r < 16; ++r) p0[r] = __builtin_amdgcn_exp2f(p0[r]);
}
__device__ __forceinline__ void finishSM(f32x16& p0, f32x16& p1, float alpha, float& l_reg, bf16x8& pa0, bf16x8& pa1, bf16x8& pa2, bf16x8& pa3) {
    for (int r = 0; r < 16; ++r) p1[r] = __builtin_amdgcn_exp2f(p1[r]);
    float ps = 0; for (int r = 0; r < 16; ++r) ps += p0[r]; for (int r = 0; r < 16; ++r) ps += p1[r];
    { auto rr = __builtin_amdgcn_permlane32_swap(__float_as_uint(ps), __float_as_uint(ps), false, false);
      ps = __uint_as_float(rr[0]) + __uint_as_float(rr[1]); }
    l_reg = l_reg * alpha + ps;
#define PK4(P, BASE, OUT) do { unsigned a0 = cvtpk(P[BASE + 0], P[BASE + 1]), a1 = cvtpk(P[BASE + 2], P[BASE + 3]);   \
    unsigned b0 = cvtpk(P[BASE + 4], P[BASE + 5]), b1 = cvtpk(P[BASE + 6], P[BASE + 7]);                              \
    auto r0 = __builtin_amdgcn_permlane32_swap(a0, b0, false, false); auto r1 = __builtin_amdgcn_permlane32_swap(a1, b1, false, false); \
    u32x4 w = {r0[0], r1[0], r0[1], r1[1]}; OUT = *reinterpret_cast<bf16x8*>(&w); } while (0)
    PK4(p0, 0, pa0); PK4(p0, 8, pa1); PK4(p1, 0, pa2); PK4(p1, 8, pa3);
#undef PK4
}
__device__ __forceinline__ void qkt(f32x16& p0, f32x16& p1, const bf16_t* Ks, const bf16x8* qr, int r32, int hi) {
    p0 = f32x16{}; p1 = f32x16{};
    for (int d0 = 0; d0 < 8; ++d0) { int cb = (d0 * 16 + hi * 8) * 2;
        bf16x8 b0 = *reinterpret_cast<const bf16x8*>((const char*)Ks + KSWZ(r32, cb));
        bf16x8 b1 = *reinterpret_cast<const bf16x8*>((const char*)Ks + KSWZ(32 + r32, cb));
        p0 = __builtin_amdgcn_mfma_f32_32x32x16_bf16(b0, qr[d0], p0, 0, 0, 0);
        p1 = __builtin_amdgcn_mfma_f32_32x32x16_bf16(b1, qr[d0], p1, 0, 0, 0); }
}
__device__ __forceinline__ int v_st(int k, int c) { const int kk = (k & ~0xC) | ((k & 4) << 1) | ((k & 8) >> 1); return ((kk >> 3) * 4 + (c >> 5)) * 512 + ((kk & 7) * 32 + (c & 31)) * 2; }
__device__ __forceinline__ int v_rd_base(int lane) { return ((lane & 3) << 3) | (((lane >> 2) & 3) << 6) | (((lane >> 4) & 1) << 5) | (((lane >> 5) & 1) << 8); }
constexpr int v_rd_off(int d0, int ks, int half) { return d0 * 512 + ks * 4096 + half * 2048; }
template <int OFF> __device__ __forceinline__ s16x4 tr_read(int vb) {
    s16x4 r; asm volatile("ds_read_b64_tr_b16 %0, %1 offset:%2" : "=&v"(r) : "v"(vb), "i"(OFF) : "memory"); return r;
}
template <int D0> __device__ __forceinline__ void pv_one(f32x16& od, int vb, bf16x8 pa0, bf16x8 pa1, bf16x8 pa2, bf16x8 pa3) {
    const s16x4 l0 = tr_read<v_rd_off(D0, 0, 0)>(vb), h0 = tr_read<v_rd_off(D0, 0, 1)>(vb), l1 = tr_read<v_rd_off(D0, 1, 0)>(vb), h1 = tr_read<v_rd_off(D0, 1, 1)>(vb);
    const s16x4 l2 = tr_read<v_rd_off(D0, 2, 0)>(vb), h2 = tr_read<v_rd_off(D0, 2, 1)>(vb), l3 = tr_read<v_rd_off(D0, 3, 0)>(vb), h3 = tr_read<v_rd_off(D0, 3, 1)>(vb);
    asm volatile("s_waitcnt lgkmcnt(0)" ::: "memory"); SBAR();
#define PK(L, H) (bf16x8){L[0], L[1], L[2], L[3], H[0], H[1], H[2], H[3]}
    od = __builtin_amdgcn_mfma_f32_32x32x16_bf16(pa0, PK(l0, h0), od, 0, 0, 0);
    od = __builtin_amdgcn_mfma_f32_32x32x16_bf16(pa1, PK(l1, h1), od, 0, 0, 0);
    od = __builtin_amdgcn_mfma_f32_32x32x16_bf16(pa2, PK(l2, h2), od, 0, 0, 0);
    od = __builtin_amdgcn_mfma_f32_32x32x16_bf16(pa3, PK(l3, h3), od, 0, 0, 0);
#undef PK
}
__device__ __forceinline__ void pv_d0(f32x16* o, int vb, bf16x8 pa0, bf16x8 pa1, bf16x8 pa2, bf16x8 pa3) {
    pv_one<0>(o[0], vb, pa0, pa1, pa2, pa3); pv_one<1>(o[1], vb, pa0, pa1, pa2, pa3); pv_one<2>(o[2], vb, pa0, pa1, pa2, pa3); pv_one<3>(o[3], vb, pa0, pa1, pa2, pa3);
}
__device__ __forceinline__ void qkt_fsm(f32x16& pn0, f32x16& pn1, const bf16_t* Ks, const bf16x8* qr, int r32, int hi, f32x16& pp0, f32x16& pp1, float alpha, float& l_reg, bf16x8& pa0, bf16x8& pa1, bf16x8& pa2, bf16x8& pa3) {
#define QF_READ(D0, B0, B1) const bf16x8 B0 = *reinterpret_cast<const bf16x8*>((const char*)Ks + KSWZ(r32, ((D0) * 16 + hi * 8) * 2)), B1 = *reinterpret_cast<const bf16x8*>((const char*)Ks + KSWZ(32 + r32, ((D0) * 16 + hi * 8) * 2))
#define QF_MMA(D0, B0, B1) do { pn0 = __builtin_amdgcn_mfma_f32_32x32x16_bf16(B0, qr[D0], pn0, 0, 0, 0); pn1 = __builtin_amdgcn_mfma_f32_32x32x16_bf16(B1, qr[D0], pn1, 0, 0, 0); } while (0)
    pn0 = f32x16{}; pn1 = f32x16{};
    QF_READ(0, k00, k01); QF_READ(1, k10, k11);
    QF_MMA(0, k00, k01); QF_READ(2, k20, k21);
#pragma unroll
    for (int r = 0; r < 4; ++r) pp1[r] = __builtin_amdgcn_exp2f(pp1[r]);
    asm volatile("" : "+v"(pp1)); SBAR();
    QF_MMA(1, k10, k11); QF_READ(3, k30, k31);
#pragma unroll
    for (int r = 4; r < 8; ++r) pp1[r] = __builtin_amdgcn_exp2f(pp1[r]);
    asm volatile("" : "+v"(pp1)); SBAR();
    QF_MMA(2, k20, k21); QF_READ(4, k40, k41);
#pragma unroll
    for (int r = 8; r < 12; ++r) pp1[r] = __builtin_amdgcn_exp2f(pp1[r]);
    asm volatile("" : "+v"(pp1)); SBAR();
    QF_MMA(3, k30, k31); QF_READ(5, k50, k51);
#pragma unroll
    for (int r = 12; r < 16; ++r) pp1[r] = __builtin_amdgcn_exp2f(pp1[r]);
    asm volatile("" : "+v"(pp1)); SBAR();
    QF_MMA(4, k40, k41); QF_READ(6, k60, k61);
    float ps = 0;
#pragma unroll
    for (int r = 0; r < 16; ++r) ps += pp0[r];
    asm volatile("" : "+v"(ps)); SBAR();
    QF_MMA(5, k50, k51); QF_READ(7, k70, k71);
#pragma unroll
    for (int r = 0; r < 16; ++r) ps += pp1[r];
    { auto rr = __builtin_amdgcn_permlane32_swap(__float_as_uint(ps), __float_as_uint(ps), false, false);
      ps = __uint_as_float(rr[0]) + __uint_as_float(rr[1]);
      l_reg = l_reg * alpha + ps; }
    asm volatile("" : "+v"(l_reg)); SBAR();
#define PK4(P, BASE, OUT) do { unsigned a0 = cvtpk(P[BASE + 0], P[BASE + 1]), a1 = cvtpk(P[BASE + 2], P[BASE + 3]);   \
    unsigned b0 = cvtpk(P[BASE + 4], P[BASE + 5]), b1 = cvtpk(P[BASE + 6], P[BASE + 7]);                              \
    auto r0 = __builtin_amdgcn_permlane32_swap(a0, b0, false, false); auto r1 = __builtin_amdgcn_permlane32_swap(a1, b1, false, false); \
    u32x4 w = {r0[0], r1[0], r0[1], r1[1]}; OUT = *reinterpret_cast<bf16x8*>(&w); } while (0)
    QF_MMA(6, k60, k61);
    PK4(pp0, 0, pa0); PK4(pp0, 8, pa1);
    asm volatile("" : "+v"(pa0), "+v"(pa1)); SBAR();
    QF_MMA(7, k70, k71);
    PK4(pp1, 0, pa2); PK4(pp1, 8, pa3);
#undef PK4
    asm volatile("" : "+v"(pa2), "+v"(pa3));
#undef QF_READ
#undef QF_MMA
}
__device__ __forceinline__ void pv_sm(f32x16* o, int vb, bf16x8 pa0, bf16x8 pa1, bf16x8 pa2, bf16x8 pa3, f32x16& p0, f32x16& p1, float& m_reg, float& mn, float& alpha) {
    constexpr float C = SCALE * 1.4426950408889634f;
#define PVS_READ(D0, L0, H0, L1, H1, L2, H2, L3, H3) const s16x4 L0 = tr_read<v_rd_off(D0, 0, 0)>(vb), H0 = tr_read<v_rd_off(D0, 0, 1)>(vb), L1 = tr_read<v_rd_off(D0, 1, 0)>(vb), H1 = tr_read<v_rd_off(D0, 1, 1)>(vb), \
        L2 = tr_read<v_rd_off(D0, 2, 0)>(vb), H2 = tr_read<v_rd_off(D0, 2, 1)>(vb), L3 = tr_read<v_rd_off(D0, 3, 0)>(vb), H3 = tr_read<v_rd_off(D0, 3, 1)>(vb)
#define PVS_PK(L, H) (bf16x8){L[0], L[1], L[2], L[3], H[0], H[1], H[2], H[3]}
#define PVS_MMA(D0, L0, H0, L1, H1, L2, H2, L3, H3) do { o[D0] = __builtin_amdgcn_mfma_f32_32x32x16_bf16(pa0, PVS_PK(L0, H0), o[D0], 0, 0, 0); o[D0] = __builtin_amdgcn_mfma_f32_32x32x16_bf16(pa1, PVS_PK(L1, H1), o[D0], 0, 0, 0); \
        o[D0] = __builtin_amdgcn_mfma_f32_32x32x16_bf16(pa2, PVS_PK(L2, H2), o[D0], 0, 0, 0); o[D0] = __builtin_amdgcn_mfma_f32_32x32x16_bf16(pa3, PVS_PK(L3, H3), o[D0], 0, 0, 0); } while (0)
#define PVS_GO() do { asm volatile("s_waitcnt lgkmcnt(0)" ::: "memory"); SBAR(); } while (0)
    PVS_READ(0, a0, b0, a1, b1, a2, b2, a3, b3); PVS_GO();
    PVS_MMA(0, a0, b0, a1, b1, a2, b2, a3, b3);
    float pmax = p0[0];
#pragma unroll
    for (int r = 1; r < 16; ++r) pmax = fmaxf(pmax, p0[r]);
    PVS_READ(1, c0, d0, c1, d1, c2, d2, c3, d3); asm volatile("" : "+v"(pmax)); PVS_GO();
    PVS_MMA(1, c0, d0, c1, d1, c2, d2, c3, d3);
#pragma unroll
    for (int r = 0; r < 16; ++r) pmax = fmaxf(pmax, p1[r]);
    { auto rr = __builtin_amdgcn_permlane32_swap(__float_as_uint(pmax), __float_as_uint(pmax), false, false);
      pmax = fmaxf(__uint_as_float(rr[0]), __uint_as_float(rr[1])); }
    { const bool keep = __all(pmax - m_reg <= THR / SCALE);
      const float mx = fmaxf(m_reg, pmax);
      mn = keep ? m_reg : mx; alpha = keep ? 1.f : __builtin_amdgcn_exp2f((m_reg - mx) * C); m_reg = mn; }
    float mnC = -mn * C;
    PVS_READ(2, e0, f0, e1, f1, e2, f2, e3, f3); asm volatile("" : "+v"(mnC), "+v"(alpha)); PVS_GO();
    PVS_MMA(2, e0, f0, e1, f1, e2, f2, e3, f3);
#pragma unroll
    for (int r = 0; r < 16; ++r) p0[r] = fmaf(p0[r], C, mnC);
#pragma unroll
    for (int r = 0; r < 8; ++r) p0[r] = __builtin_amdgcn_exp2f(p0[r]);
    PVS_READ(3, g0, h0, g1, h1, g2, h2, g3, h3); asm volatile("" : "+v"(p0)); PVS_GO();
    PVS_MMA(3, g0, h0, g1, h1, g2, h2, g3, h3);
#pragma unroll
    for (int r = 0; r < 16; ++r) p1[r] = fmaf(p1[r], C, mnC);
#pragma unroll
    for (int r = 8; r < 16; ++r) p0[r] = __builtin_amdgcn_exp2f(p0[r]);
    asm volatile("" : "+v"(p0), "+v"(p1));
#undef PVS_READ
#undef PVS_PK
#undef PVS_MMA
#undef PVS_GO
}
__device__ __forceinline__ void attn_dense_body(const bf16_t* __restrict__ Qb, const bf16_t* __restrict__ Kh, const bf16_t* __restrict__ Vh, bf16_t* __restrict__ Ob, int seq, char* lds, int wave_id, int o_pm, int o_h) {
    const int tid = opaque_tid(wave_id), wid = tid >> 6, lane = tid & 63, r32 = lane & 31, hi = lane >> 5;
    bf16_t* V_lds = (bf16_t*)lds; bf16_t* K_lds = (bf16_t*)(lds + 2 * SHM_V);
    float* ws = (float*)(lds + 2 * SHM_V + 2 * SHM_K) + wid * 64; float* li_l = ws; float* al_l = ws + 32;
    float m_reg = -1e30f, l_reg = 0; f32x16 o[4] = {}; bf16x8 qr[8];
    const bf16_t* Qw = Qb + (long)(wid * QBLK + r32) * LDQ + hi * 8;
#pragma unroll
    for (int d0 = 0; d0 < 8; ++d0) qr[d0] = *reinterpret_cast<const bf16x8*>(Qw + d0 * 16);
    const int sr = tid >> 4, sc = (tid & 15) * 8, vst0 = v_st(sr, sc), vst1 = v_st(32 + sr, sc);
    const int vb0 = (int)(uintptr_t)V_lds + v_rd_base(lane);
    constexpr int SDEPTH = ATT_SDEPTH;
    struct { bf16x8 vs0, vs1, ks0, ks1; } sr_[SDEPTH];
    typedef const __attribute__((address_space(1))) char* gcp;
    gcp Vu, Ku;
    { const unsigned long long v_ = (unsigned long long)Vh, k_ = (unsigned long long)Kh;
      Vu = (gcp)(((unsigned long long)(unsigned)__builtin_amdgcn_readfirstlane((unsigned)(v_ >> 32)) << 32) | (unsigned)__builtin_amdgcn_readfirstlane((unsigned)v_));
      Ku = (gcp)(((unsigned long long)(unsigned)__builtin_amdgcn_readfirstlane((unsigned)(k_ >> 32)) << 32) | (unsigned)__builtin_amdgcn_readfirstlane((unsigned)k_)); }
    const unsigned vofs = (unsigned)(sr * LDK + sc) * 2u;
    typedef const __attribute__((address_space(1))) bf16x8* gv8p;
#define SLOAD(i, k0) do { gcp vb_ = Vu + (size_t)(k0) * (LDK * 2); gcp kb_ = Ku + (size_t)(k0) * (LDK * 2); \
    sr_[i].vs0 = *(gv8p)(vb_ + vofs); sr_[i].vs1 = *(gv8p)(vb_ + 32 * LDK * 2 + vofs); \
    sr_[i].ks0 = *(gv8p)(kb_ + vofs); sr_[i].ks1 = *(gv8p)(kb_ + 32 * LDK * 2 + vofs); } while (0)
#define SWRITE(b, i) do { *(bf16x8*)((char*)V_lds + (b) * SHM_V + vst0) = sr_[i].vs0;          \
    *(bf16x8*)((char*)V_lds + (b) * SHM_V + vst1) = sr_[i].vs1; int kc = sc * 2;               \
    *(bf16x8*)((char*)K_lds + (b) * SHM_K + KSWZ(sr, kc)) = sr_[i].ks0;                       \
    *(bf16x8*)((char*)K_lds + (b) * SHM_K + KSWZ(32 + sr, kc)) = sr_[i].ks1; } while (0)
#define SWAIT() do { if constexpr (SDEPTH == 2) asm volatile("s_waitcnt vmcnt(4)" ::: "memory"); else asm volatile("s_waitcnt vmcnt(0)" ::: "memory"); } while (0)
#define RESC(a) do { if (__any((a) < 1.f)) { if (hi == 0) al_l[r32] = (a); asm volatile("s_waitcnt lgkmcnt(0)" ::: "memory"); \
    for (int d = 0; d < 4; ++d) for (int r = 0; r < 16; ++r) o[d][r] *= al_l[crow(r, hi)]; } } while (0)
    f32x16 pA0, pA1, pB0, pB1; float mnA, mnB, alA, alB; bf16x8 pa0, pa1, pa2, pa3; const int NT = seq / KVBLK;
    constexpr int SE = 0, SO = SDEPTH - 1;
    SLOAD(SE, 0); asm volatile("s_waitcnt vmcnt(0)" ::: "memory"); SWRITE(0, SE); __syncthreads();
    qkt(pA0, pA1, K_lds, qr, r32, hi); partialSM(pA0, pA1, m_reg, mnA, alA);
    SLOAD(SO, KVBLK); if constexpr (SDEPTH == 2) { if (2 < NT) SLOAD(SE, 2 * KVBLK); }
    SWAIT(); SWRITE(1, SO); __syncthreads();
    for (int j = 1; j + 1 < NT; j += 2) {
        SBAR(); qkt_fsm(pB0, pB1, (bf16_t*)((char*)K_lds + SHM_K), qr, r32, hi, pA0, pA1, alA, l_reg, pa0, pa1, pa2, pa3); SBAR();
        SLOAD(SO, (j + SDEPTH) * KVBLK); SBAR();
        pv_sm(o, vb0, pa0, pa1, pa2, pa3, pB0, pB1, m_reg, mnB, alB);
        __syncthreads(); SWAIT(); SWRITE(0, SE);
        RESC(alB); __syncthreads();
        SBAR(); qkt_fsm(pA0, pA1, K_lds, qr, r32, hi, pB0, pB1, alB, l_reg, pa0, pa1, pa2, pa3); SBAR();
        if (SDEPTH == 1 || j + 3 < NT) SLOAD(SE, (j + 1 + SDEPTH) * KVBLK); SBAR();
        pv_sm(o, vb0 + (int)SHM_V, pa0, pa1, pa2, pa3, pA0, pA1, m_reg, mnA, alA);
        __syncthreads(); SWAIT(); SWRITE(1, SO);
        RESC(alA); __syncthreads();
    }
    SBAR(); qkt(pB0, pB1, (bf16_t*)((char*)K_lds + SHM_K), qr, r32, hi);
    finishSM(pA0, pA1, alA, l_reg, pa0, pa1, pa2, pa3); SBAR();
    pv_sm(o, vb0, pa0, pa1, pa2, pa3, pB0, pB1, m_reg, mnB, alB);
    __syncthreads(); RESC(alB);
    finishSM(pB0, pB1, alB, l_reg, pa0, pa1, pa2, pa3); SBAR();
    pv_d0(o, vb0 + (int)SHM_V, pa0, pa1, pa2, pa3);
    { const int tid2 = opaque_tid(wave_id), lane2 = tid2 & 63, r32b = lane2 & 31, hib = lane2 >> 5;
      float* li2 = (float*)(lds + 2 * SHM_V + 2 * SHM_K) + wave_id * 64;
      if (hib == 0) li2[r32b] = l_reg; asm volatile("s_waitcnt lgkmcnt(0)" ::: "memory");
      float rli[16];
#pragma unroll
      for (int r = 0; r < 16; ++r) rli[r] = __builtin_amdgcn_rcpf(li2[crow(r, hib)]);
      __syncthreads();
      bf16_t* ost = (bf16_t*)(lds + wave_id * 8704);
#pragma unroll
      for (int r = 0; r < 16; ++r) { const int orow = crow(r, hib);
#pragma unroll
          for (int d0 = 0; d0 < 4; ++d0) ost[orow * 136 + d0 * 32 + r32b] = f2bf(o[d0][r] * rli[r]); }
      asm volatile("s_waitcnt lgkmcnt(0)" ::: "memory");
#pragma unroll
      for (int i = 0; i < 8; ++i) { const int rb = i >> 2, cb = i & 3, rr = lane2 >> 2, c8 = (lane2 & 3) * 8;
          *(u32x4*)((char*)Ob + blk16x32(o_pm, 16, o_h * 2 + (cb >> 1), wave_id >> 2, (wave_id & 3) * 2 + rb, cb & 1) + (rr * 32 + c8) * 2) = *(const u32x4*)(ost + (rb * 16 + rr) * 136 + cb * 32 + c8); } }
    __syncthreads();
#undef SLOAD
#undef SWRITE
#undef SWAIT
#undef RESC
}
}

struct S5In { const float *lre, *lim, *ldt, *bre, *bim, *cre, *cim, *dsk; };
__device__ __forceinline__ void s5_naive_wave(const S5In& P, const bf16_t* __restrict__ Ucat, const bf16_t* __restrict__ Uctx, float* __restrict__ Ytmp, bf16_t* __restrict__ SSM, int n, int g, int b) {
    const float dskip = P.dsk[g * PG + (n & 15)];
    for (int dir = 0; dir < 2; ++dir) {
        const int dg = dir * NG + g;
        const float dt = expf(P.ldt[dg]), lr = P.lre[dg * NS + n], li = P.lim[dg * NS + n];
        const float mag = expf(lr * dt), ang = li * dt, are = mag * cosf(ang), aim = mag * sinf(ang);
        const float den = lr * lr + li * li, nr = are - 1.f, ni = aim, fre = (nr * lr + ni * li) / den, fim = (ni * lr - nr * li) / den;
        float bbr[PG], bbi[PG], cr[PG], ci[PG];
#pragma unroll
        for (int p = 0; p < PG; ++p) { const float br = P.bre[((size_t)dg * NS + n) * PG + p], bi = P.bim[((size_t)dg * NS + n) * PG + p];
            bbr[p] = fre * br - fim * bi; bbi[p] = fre * bi + fim * br; cr[p] = P.cre[((size_t)dg * PG + p) * NS + n]; ci[p] = P.cim[((size_t)dg * PG + p) * NS + n]; }
        float sre = 0.f, sim = 0.f;
        for (int i = 0; i < LC; ++i) { const int tc = dir == 0 ? i : LC - 1 - i;
            const bf16_t* upc = Ucat + ucat_ctx_idx(b, tc, g * PG); const bf16x8 u0 = *(const bf16x8*)upc, u1 = *(const bf16x8*)(upc + 8);
            float bur = 0.f, bui = 0.f;
#pragma unroll
            for (int p = 0; p < 8; ++p) { const float ua = bf2f((bf16_t)u0[p]), ub = bf2f((bf16_t)u1[p]); bur += bbr[p] * ua + bbr[p + 8] * ub; bui += bbi[p] * ua + bbi[p + 8] * ub; }
            const float nre = are * sre - aim * sim + bur, nim = are * sim + aim * sre + bui; sre = nre; sim = nim; }
        for (int i = 0; i < SEQ; ++i) { const int t = dir == 0 ? i : SEQ - 1 - i;
            const bf16_t* up = Ucat + ucat_idx(b, t, g * PG);
            const bf16x8 u0 = *(const bf16x8*)up, u1 = *(const bf16x8*)(up + 8);
            float uu[PG]; float bur = 0.f, bui = 0.f;
#pragma unroll
            for (int p = 0; p < 8; ++p) { uu[p] = bf2f((bf16_t)u0[p]); uu[p + 8] = bf2f((bf16_t)u1[p]); }
#pragma unroll
            for (int p = 0; p < PG; ++p) { bur += bbr[p] * uu[p]; bui += bbi[p] * uu[p]; }
            const float nre = are * sre - aim * sim + bur, nim = are * sim + aim * sre + bui; sre = nre; sim = nim;
            float mine = 0.f, myu = 0.f;
#pragma unroll
            for (int p = 0; p < PG; ++p) { const float y = wave_sum(cr[p] * sre - ci[p] * sim); if (n == p) { mine = y; myu = uu[p]; } }
            if (n < PG) { const size_t oi = ((size_t)(b * SEQ + t)) * 512 + g * PG + n;
                if (dir == 0) Ytmp[oi] = myu * dskip + mine;
                else SSM[oi] = f2bf(gelu_tanh(Ytmp[oi] + mine)); }
        }
    }
}

#include <hip/hip_cooperative_groups.h>
namespace cg = cooperative_groups;
#define LAS __attribute__((address_space(3)))
#define GAS __attribute__((address_space(1)))

namespace pg8 {
constexpr int BM = 256, BK = 64, HALF = 128, HTB = HALF * BK * 2, STAGE_BYTES = 8 * HTB, NXCD = 8, WGM = 8;
__host__ __device__ __forceinline__ int lds_byte(int r, int c) { const int st = (r >> 4) * 2 + (c >> 5), rr = r & 15, cc = c & 31, ob = rr * 64 + cc * 2; return st * 1024 + (ob ^ (((ob >> 9) & 1) << 5)); }
__host__ __device__ __forceinline__ void stage_rc(int b, int& R, int& C) { const int st = b / 1024, sb = b % 1024, swz = sb ^ (((sb >> 9) & 1) << 5); R = (st >> 1) * 16 + swz / 64; C = (st & 1) * 32 + (swz % 64) / 2; }
__host__ __device__ __forceinline__ int perm32(int rho) { const int n = rho >> 4, i = rho & 15; return 8 * (i >> 2) + 4 * n + (i & 3); }
struct Unit { int pm, pn, grp; };
struct Gemm { const bf16_t* A; const bf16_t* Bt; int lda, ldb, K; size_t a_grp, b_grp; int amode; };
struct StaticOrder {
    int nM, nN, nwg, G, c;
    __device__ __forceinline__ void init(int nM_, int nN_, int G_, int c_) { nM = nM_; nN = nN_; nwg = nM * nN; G = G_; c = c_; }
    __device__ __forceinline__ bool next(int i, Unit& u) const {
        const long L = (long)i * G + c; if (L >= nwg) return false;
        int wgid = (int)L; { const int q = nwg / NXCD, r = nwg % NXCD, xcd = wgid % NXCD, off = wgid / NXCD; wgid = (xcd < r ? xcd * (q + 1) : r * (q + 1) + (xcd - r) * q) + off; }
        const int nig = WGM * nN, gid = wgid / nig, fm = gid * WGM, gsz = (nM - fm) < WGM ? (nM - fm) : WGM;
        u.pm = fm + ((wgid % nig) % gsz); u.pn = (wgid % nig) / gsz; u.grp = 0; return true;
    }
};
__device__ __forceinline__ unsigned cvt_pk_bf16(float lo, float hi) { return pk2(lo, hi); }
#define EPI_ROWS_BF16(ROWPTR, BJSTRIDE, XF) do { \
    _Pragma("unroll") for (int ai = 0; ai < 2; ++ai) _Pragma("unroll") for (int m = 0; m < 4; ++m) { const int row = row0 + ai * HALF + m * 16; bf16_t* rp = (ROWPTR); \
        _Pragma("unroll") for (int bj = 0; bj < 2; ++bj) { f32x4 v0 = acc[ai][bj][m][0], v1 = acc[ai][bj][m][1]; \
            _Pragma("unroll") for (int j = 0; j < 4; ++j) { v0[j] = XF(v0[j]); v1[j] = XF(v1[j]); } \
            u32x4 w; w.x = cvt_pk_bf16(v0[0], v0[1]); w.y = cvt_pk_bf16(v0[2], v0[3]); w.z = cvt_pk_bf16(v1[0], v1[1]); w.w = cvt_pk_bf16(v1[2], v1[3]); \
            *(u32x4*)(rp + (size_t)bj * (BJSTRIDE)) = w; } } } while (0)
template <class Epi, class Sched, bool ALIGN_EPI = true, bool SP2 = true>
__device__ __forceinline__ void gemm_phase(LAS unsigned char* lds, const Gemm g, const Sched& S, const Epi& E, int wave_id) {
    const int tid = opaque_tid(wave_id), wid = __builtin_amdgcn_readfirstlane(tid >> 6), lane = tid & 63, wr = wid >> 2, wc = wid & 3, fr = lane & 15, fq = lane >> 4;
    const int K = g.K, nt = K / BK;
    unsigned voffA[2], voffB[2];
#pragma unroll
    for (int i = 0; i < 2; ++i) { int R, C; stage_rc(tid * 16 + i * 8192, R, C); const int Rb = Epi::PERM ? ((R & ~31) + perm32(R & 31)) : R;
        voffA[i] = g.amode == 1 ? (unsigned)((((C >> 4) * 1024 + (R >> 5)) * 512 + (R & 31) * 16 + (C & 15)) * 2) : g.amode == 2 ? (unsigned)((((R & ~63) | (4 * (R & 15) + ((R >> 4) & 3))) * g.lda + C) * 2) : g.amode == 3 ? (unsigned)((((((R >> 6) * 2 + (C >> 5)) * 2) * 4 + (R & 3)) * 1024) + ((((R & 63) >> 2) * 4 + ((C >> 3) & 3)) * 16)) : (g.amode == 4 || g.amode == 5) ? (unsigned)((((R >> 4) * 2 + (C >> 5)) * 1024) + (((R & 15) * 32 + (C & 31)) * 2)) : (unsigned)(R * g.lda + C) * 2u; voffB[i] = (unsigned)(Rb * g.ldb + C) * 2u; }
    const size_t kstep = (size_t)(BK * 2), kstepA = g.amode == 1 ? (size_t)4 * 1024 * 512 * 2 : (g.amode == 3 || g.amode == 4 || g.amode == 5) ? (size_t)32768 : kstep;
    const size_t hstepA = g.amode == 1 ? (size_t)4 * 512 * 2 : g.amode == 3 ? (size_t)4096 : (g.amode == 4 || g.amode == 5) ? (size_t)16384 : (size_t)HALF * g.lda * 2, hstepB = (size_t)HALF * g.ldb * 2;
    const size_t tstepA = g.amode == 3 ? (size_t)44 * 32768 : g.amode == 4 ? (size_t)(g.K / 64) * 32768 : g.amode == 5 ? (size_t)(g.K / 64) * 65536 : 2 * hstepA, tstepB = 2 * hstepB;
    const unsigned ldsw = (unsigned)wid * 1024u;
    const int aoff = lds_byte(wr * 64 + fr, fq * 8), boff = lds_byte(wc * 32 + fr, fq * 8);
#define PG8_SA(b, h) (((b) * 2 + (h)) * HTB)
#define PG8_SB(b, h) ((4 + (b) * 2 + (h)) * HTB)
#define PG8_STAGE(bufoff, gbase, voff) do { _Pragma("unroll") for (int _i = 0; _i < 2; ++_i) \
        __builtin_amdgcn_global_load_lds((const unsigned*)((const char*)(gbase) + (voff)[_i]), (LAS unsigned*)(lds + (bufoff) + ldsw + _i * 8192), 16, 0, 0); } while (0)
#define PG8_LDA(dst, b, h) do { _Pragma("unroll") for (int m = 0; m < 4; ++m) _Pragma("unroll") for (int k = 0; k < 2; ++k) dst[m][k] = *(const LAS bf16x8*)(lds + PG8_SA(b, h) + aoff + m * 2048 + k * 1024); } while (0)
#define PG8_LDB(dst, b, h) do { _Pragma("unroll") for (int n = 0; n < 2; ++n) _Pragma("unroll") for (int k = 0; k < 2; ++k) dst[n][k] = *(const LAS bf16x8*)(lds + PG8_SB(b, h) + boff + n * 2048 + k * 1024); } while (0)
#define PG8_MMA(ai, bj, At, Bt) do { __builtin_amdgcn_s_setprio(1); _Pragma("unroll") for (int m = 0; m < 4; ++m) _Pragma("unroll") for (int n = 0; n < 2; ++n) _Pragma("unroll") for (int k = 0; k < 2; ++k) \
        acc[ai][bj][m][n] = __builtin_amdgcn_mfma_f32_16x16x32_bf16(Bt[n][k], At[m][k], acc[ai][bj][m][n], 0, 0, 0); __builtin_amdgcn_s_setprio(0); } while (0)
#define PG8_WAIT_V(n) asm volatile("s_waitcnt vmcnt(" #n ")" ::: "memory")
#define PG8_WAIT_L(n) asm volatile("s_waitcnt lgkmcnt(" #n ")" ::: "memory")
#define PG8_BAR __builtin_amdgcn_s_barrier()
#define PG8_SCHED __builtin_amdgcn_sched_barrier(0)
    Unit cur, nxt; int ui = 0;
    if (!S.next(0, cur)) return;
    f32x4 acc[2][2][4][2];
#pragma unroll
    for (int a = 0; a < 2; ++a)
#pragma unroll
        for (int b = 0; b < 2; ++b)
#pragma unroll
            for (int m = 0; m < 4; ++m)
#pragma unroll
                for (int n = 0; n < 2; ++n) acc[a][b][m][n] = (f32x4){0.f, 0.f, 0.f, 0.f};
    bf16x8 At[4][2], B0[2][2], B1[2][2];
    const char* cA = (const char*)g.A + (size_t)cur.grp * g.a_grp + (size_t)cur.pm * tstepA + ((g.amode == 3 && cur.pm >= A_SPLIT_PM) ? A_HI_SHIFT : (size_t)0); const char* cB = (const char*)g.Bt + (size_t)cur.grp * g.b_grp + (size_t)cur.pn * tstepB;
    typename Epi::Pre pre = E.pre(cur, wid, lane);
    if constexpr (SP2) {
        PG8_STAGE(PG8_SB(0, 0), cB, voffB); PG8_STAGE(PG8_SB(0, 1), cB + hstepB, voffB); PG8_STAGE(PG8_SA(0, 0), cA, voffA); PG8_STAGE(PG8_SA(0, 1), cA + hstepA, voffA);
        if (wr == 1) PG8_BAR;
        PG8_WAIT_V(2); PG8_BAR;
        PG8_STAGE(PG8_SB(1, 0), cB + kstep, voffB); PG8_STAGE(PG8_SA(1, 0), cA + kstepA, voffA); PG8_STAGE(PG8_SB(1, 1), cB + hstepB + kstep, voffB);
        PG8_WAIT_V(6); PG8_BAR;
    } else {
        PG8_STAGE(PG8_SB(0, 0), cB, voffB); PG8_STAGE(PG8_SA(0, 0), cA, voffA); PG8_STAGE(PG8_SB(0, 1), cB + hstepB, voffB); PG8_STAGE(PG8_SA(0, 1), cA + hstepA, voffA);
        if (wr == 1) PG8_BAR;
        PG8_WAIT_V(4); PG8_BAR;
        PG8_STAGE(PG8_SB(1, 0), cB + kstep, voffB); PG8_STAGE(PG8_SA(1, 0), cA + kstepA, voffA); PG8_STAGE(PG8_SB(1, 1), cB + hstepB + kstep, voffB);
        PG8_WAIT_V(6); PG8_BAR;
    }
    for (;;) {
        const bool has_next = S.next(ui + 1, nxt);
        const char* nA = has_next ? (const char*)g.A + (size_t)nxt.grp * g.a_grp + (size_t)nxt.pm * tstepA + ((g.amode == 3 && nxt.pm >= A_SPLIT_PM) ? A_HI_SHIFT : (size_t)0) : cA; const char* nB = has_next ? (const char*)g.Bt + (size_t)nxt.grp * g.b_grp + (size_t)nxt.pn * tstepB : cB;
        for (int t = 0; t < nt; t += 2) {
            const bool last = (t == nt - 2);
            const char* a1 = cA + (size_t)(t + 1) * kstepA;
            const char* a2 = last ? nA : cA + (size_t)(t + 2) * kstepA; const char* b2 = last ? nB : cB + (size_t)(t + 2) * kstep;
            const char* a3 = a2 + kstepA; const char* b3 = b2 + kstep;
            if constexpr (SP2) {
            PG8_LDB(B0, 0, 0); PG8_LDB(B1, 0, 1); PG8_SCHED; PG8_LDA(At, 0, 0); PG8_STAGE(PG8_SA(1, 1), a1 + hstepA, voffA);
            PG8_WAIT_V(8); PG8_WAIT_L(0); PG8_BAR; PG8_MMA(0, 0, At, B0); PG8_MMA(0, 1, At, B1); PG8_BAR; PG8_SCHED;
            PG8_LDA(At, 0, 1); PG8_STAGE(PG8_SB(0, 0), b2, voffB); PG8_STAGE(PG8_SB(0, 1), b2 + hstepB, voffB); PG8_STAGE(PG8_SA(0, 0), a2, voffA);
            PG8_WAIT_V(8); PG8_WAIT_L(0); PG8_BAR; PG8_MMA(1, 0, At, B0); PG8_MMA(1, 1, At, B1); PG8_BAR; PG8_SCHED;
            PG8_LDB(B0, 1, 0); PG8_LDB(B1, 1, 1); PG8_SCHED; PG8_LDA(At, 1, 0); PG8_STAGE(PG8_SA(0, 1), a2 + hstepA, voffA);
            PG8_WAIT_V(8); PG8_WAIT_L(0); PG8_BAR; PG8_MMA(0, 0, At, B0); PG8_MMA(0, 1, At, B1); PG8_BAR; PG8_SCHED;
            PG8_LDA(At, 1, 1); PG8_STAGE(PG8_SB(1, 0), b3, voffB); PG8_STAGE(PG8_SB(1, 1), b3 + hstepB, voffB); PG8_STAGE(PG8_SA(1, 0), a3, voffA);
            PG8_WAIT_V(8); PG8_WAIT_L(0); PG8_BAR; PG8_MMA(1, 0, At, B0); PG8_MMA(1, 1, At, B1); PG8_BAR; PG8_SCHED;
            } else {
            PG8_LDB(B0, 0, 0); PG8_SCHED; PG8_LDA(At, 0, 0); PG8_STAGE(PG8_SA(1, 1), a1 + hstepA, voffA);
            PG8_WAIT_L(8); PG8_BAR; PG8_WAIT_L(0); PG8_MMA(0, 0, At, B0); PG8_BAR; PG8_SCHED;
            PG8_LDB(B1, 0, 1); PG8_STAGE(PG8_SB(0, 0), b2, voffB);
            PG8_BAR; PG8_WAIT_L(0); PG8_MMA(0, 1, At, B1); PG8_BAR;
            PG8_LDA(At, 0, 1); PG8_STAGE(PG8_SA(0, 0), a2, voffA);
            PG8_BAR; PG8_WAIT_L(0); PG8_MMA(1, 0, At, B0); PG8_BAR; PG8_SCHED;
            PG8_STAGE(PG8_SB(0, 1), b2 + hstepB, voffB);
            PG8_WAIT_V(6); PG8_BAR; PG8_MMA(1, 1, At, B1); PG8_BAR;
            PG8_LDB(B0, 1, 0); PG8_SCHED; PG8_LDA(At, 1, 0); PG8_STAGE(PG8_SA(0, 1), a2 + hstepA, voffA);
            PG8_WAIT_L(8); PG8_BAR; PG8_WAIT_L(0); PG8_MMA(0, 0, At, B0); PG8_BAR; PG8_SCHED;
            PG8_LDB(B1, 1, 1); PG8_STAGE(PG8_SB(1, 0), b3, voffB);
            PG8_BAR; PG8_WAIT_L(0); PG8_MMA(0, 1, At, B1); PG8_BAR;
            PG8_LDA(At, 1, 1); PG8_STAGE(PG8_SA(1, 0), a3, voffA);
            PG8_BAR; PG8_WAIT_L(0); PG8_MMA(1, 0, At, B0); PG8_BAR; PG8_SCHED;
            PG8_STAGE(PG8_SB(1, 1), b3 + hstepB, voffB);
            PG8_WAIT_V(6); PG8_BAR; PG8_MMA(1, 1, At, B1); PG8_BAR;
            }
        }
        if constexpr (ALIGN_EPI) { if (wr == 0) PG8_BAR; }
        E(acc, cur, wr, wc, fr, fq, pre);
        if (!has_next) break;
#pragma unroll
        for (int a = 0; a < 2; ++a)
#pragma unroll
            for (int b = 0; b < 2; ++b)
#pragma unroll
                for (int m = 0; m < 4; ++m)
#pragma unroll
                    for (int n = 0; n < 2; ++n) acc[a][b][m][n] = (f32x4){0.f, 0.f, 0.f, 0.f};
        cur = nxt; cA = nA; cB = nB; ++ui;
        pre = E.pre(cur, wid, lane);
        if constexpr (ALIGN_EPI) { if (wr == 1) PG8_BAR; }
    }
    PG8_WAIT_V(0);
    if constexpr (!ALIGN_EPI) { if (wr == 0) PG8_BAR; }
    PG8_BAR;
#undef PG8_SA
#undef PG8_SB
#undef PG8_STAGE
#undef PG8_LDA
#undef PG8_LDB
#undef PG8_MMA
#undef PG8_WAIT_V
#undef PG8_WAIT_L
#undef PG8_BAR
#undef PG8_SCHED
}
}

#define XB_TMO      128
#define XB_XCNT(j)  (256  + 64 * (j))
#define XB_XSUB(j)  (1280 + 64 * (j))
#define XB_XGEN(j)  (2304 + 64 * (j))
#define XB_TOP      3328
#define XB_TOPGEN   3392
#define XCD_BAR_WORDS 3456
#define XB_SPIN_CAP (1u << 18)
__device__ __forceinline__ unsigned xb_ld(unsigned* p)              { return __hip_atomic_load(p, __ATOMIC_RELAXED, __HIP_MEMORY_SCOPE_AGENT); }
__device__ __forceinline__ unsigned xb_add(unsigned* p, unsigned v) { return __hip_atomic_fetch_add(p, v, __ATOMIC_RELAXED, __HIP_MEMORY_SCOPE_AGENT); }
__device__ __forceinline__ unsigned xb_xcc_id() { return (unsigned)__builtin_amdgcn_s_getreg((3 << 11) | 20) & 0xFu; }
#define XB_SPIN(cond, bar) do { unsigned _sp = 0; while (cond) { __builtin_amdgcn_s_sleep(1); \
    if ((++_sp & 255u) == 0u) { if (xb_ld(&(bar)[XB_TMO])) break; if (_sp > XB_SPIN_CAP) { atomicAdd(&(bar)[XB_TMO], 1u); break; } } } } while (0)
struct XcdBarrier { unsigned* bar; unsigned x; volatile LAS unsigned* st; };
__device__ __forceinline__ XcdBarrier xcd_barrier_post(unsigned* bar, volatile LAS unsigned* st) {
    XcdBarrier b; b.bar = bar; b.x = xb_xcc_id(); b.st = st;
    if (threadIdx.x == 0) (void)xb_add(&bar[XB_XCNT(b.x)], 1u);
    return b;
}
__device__ __forceinline__ void xcd_barrier_complete(unsigned* bar, unsigned x, unsigned& nloc, unsigned& nx) {
    const unsigned G = gridDim.x * gridDim.y * gridDim.z;
    unsigned sum, cnt, mine, sp = 0u;
    for (;;) {
        sum = 0u; cnt = 0u; mine = 0u;
#pragma unroll
        for (unsigned j = 0; j < 16; ++j) { const unsigned c = xb_ld(&bar[XB_XCNT(j)]); sum += c; cnt += (c > 0u) ? 1u : 0u; mine = (j == x) ? c : mine; }
        if (sum == G) break;
        __builtin_amdgcn_s_sleep(1);
        if ((++sp & 255u) == 0u) { if (xb_ld(&bar[XB_TMO])) break; if (sp > XB_SPIN_CAP) { atomicAdd(&bar[XB_TMO], 1u); break; } }
    }
    nloc = mine > 0u ? mine : 1u; nx = cnt > 0u ? cnt : 1u;
}
__device__ __forceinline__ void xcd_barrier(const XcdBarrier& b) {
    asm volatile("s_waitcnt vmcnt(0)" ::: "memory");
    __syncthreads();
    if (threadIdx.x == 0) {
        unsigned* bar = b.bar;
        __builtin_amdgcn_s_waitcnt(0);
        unsigned nloc = b.st[0], nx = b.st[1];
        if (nloc == 0u) { xcd_barrier_complete(bar, b.x, nloc, nx); b.st[0] = nloc; b.st[1] = nx; }
        const unsigned old = xb_add(&bar[XB_XSUB(b.x)], 1u);
        const unsigned gen = old / nloc;
        if (old + 1u == (gen + 1u) * nloc) {
            __builtin_amdgcn_fence(__ATOMIC_RELEASE, "agent");
            asm volatile("s_waitcnt vmcnt(0)" ::: "memory");
            const unsigned og = xb_add(&bar[XB_TOP], 1u);
            const unsigned tg = og / nx;
            if (og + 1u == (tg + 1u) * nx) xb_add(&bar[XB_TOPGEN], 1u);
            else XB_SPIN(xb_ld(&bar[XB_TOPGEN]) == tg, bar);
            __builtin_amdgcn_fence(__ATOMIC_ACQUIRE, "agent");
            xb_add(&bar[XB_XGEN(b.x)], 1u);
            asm volatile("s_waitcnt vmcnt(0)" ::: "memory");
        } else {
            XB_SPIN(xb_ld(&bar[XB_XGEN(b.x)]) == gen, bar);
            __builtin_amdgcn_fence(__ATOMIC_ACQUIRE, "agent");
            asm volatile("s_waitcnt vmcnt(0)" ::: "memory");
        }
    }
    __syncthreads();
}

#define TB_WORD(x, p) (26624 + 64 * ((x) * 8 + (p)))
__device__ __forceinline__ void team_barrier(unsigned* cnt, unsigned gen) {
    asm volatile("s_waitcnt vmcnt(0)" ::: "memory");
    __syncthreads();
    if (threadIdx.x == 0) {
        (void)xb_add(cnt, 1u);
        unsigned spins = 0;
        while (xb_ld(cnt) < 4u * gen) { __builtin_amdgcn_s_sleep(1); if (++spins > (1u << 22)) break; }
        __builtin_amdgcn_fence(__ATOMIC_ACQUIRE, "agent");
        asm volatile("s_waitcnt vmcnt(0)" ::: "memory");
    }
    __syncthreads();
}
#define GB_SUB(j)   (12288 + 64 * (j))
#define GB_GEN(j)   (13312 + 64 * (j))
#define GB_MISMATCH 14400
#define GB_TOPA     14976
#define GB_TOPB     15040
__device__ __forceinline__ void top_wait(unsigned* top) {
    if (threadIdx.x < 64) { unsigned spins = 0;
        while ((unsigned)__builtin_amdgcn_readfirstlane(xb_ld(top)) < 8u) { __builtin_amdgcn_s_sleep(2); if (++spins > (1u << 22)) break; }
        __builtin_amdgcn_fence(__ATOMIC_ACQUIRE, "agent"); asm volatile("s_waitcnt vmcnt(0)" ::: "memory"); }
    __syncthreads();
}
__device__ __forceinline__ void grp_barrier(const XcdBarrier& b, unsigned* top = nullptr) {
    asm volatile("s_waitcnt vmcnt(0)" ::: "memory");
    __syncthreads();
    if (threadIdx.x == 0) {
        unsigned* bar = b.bar;
        __builtin_amdgcn_s_waitcnt(0);
        const unsigned nloc = b.st[0];
        const unsigned old = xb_add(&bar[GB_SUB(b.x)], 1u);
        const unsigned gen = old / nloc;
        if (old + 1u == (gen + 1u) * nloc) {
            __builtin_amdgcn_fence(__ATOMIC_RELEASE, "agent");
            asm volatile("s_waitcnt vmcnt(0)" ::: "memory");
            if (top) (void)xb_add(top, 1u);
            __builtin_amdgcn_fence(__ATOMIC_ACQUIRE, "agent");
            xb_add(&bar[GB_GEN(b.x)], 1u);
            asm volatile("s_waitcnt vmcnt(0)" ::: "memory");
        } else {
            XB_SPIN(xb_ld(&bar[GB_GEN(b.x)]) == gen, bar);
            __builtin_amdgcn_fence(__ATOMIC_ACQUIRE, "agent");
            asm volatile("s_waitcnt vmcnt(0)" ::: "memory");
        }
    }
    __syncthreads();
}

constexpr int MK_LDS = 147456;
constexpr int NWV = 8;
#ifndef MK_HI
#define MK_HI 16
#endif
#ifndef S5_NAIVE
#define S5_NAIVE 0
#endif
#ifndef USE_XBAR
#define USE_XBAR 1
#endif
#ifndef X1_BF16
#define X1_BF16 1
#endif
#ifndef GRP_SEAMS
#define GRP_SEAMS 1
#endif
#ifndef STAGGER8_US
#define STAGGER8_US 0
#endif
#ifndef REPMASK
#define REPMASK 0x0
#endif
#define REPS(k) for (int rep_ = 0; rep_ <= ((REPMASK >> (k)) & 1); ++rep_)
struct MkArgs { const float* in[27]; float* out; unsigned char* ws; int ph_lo, ph_hi; };

template <int MAP> __device__ __forceinline__ void transpose_item(const float* __restrict__ W, int K, int N, bf16_t* __restrict__ WT, LAS float* scr, int item, int lane) {
    const int nblk = N / 32, kb = item / nblk, nb = item % nblk, k0 = 64 * kb, n0 = 32 * nb;
    { f32x4 v[8];
#pragma unroll
      for (int i = 0; i < 8; ++i) v[i] = *(const f32x4*)(W + (size_t)(k0 + 8 * i + (lane >> 3)) * N + n0 + (lane & 7) * 4);
#pragma unroll
      for (int i = 0; i < 8; ++i) { LAS float* d = scr + (8 * i + (lane >> 3)) * 33 + (lane & 7) * 4; d[0] = v[i][0]; d[1] = v[i][1]; d[2] = v[i][2]; d[3] = v[i][3]; } }
    asm volatile("s_waitcnt lgkmcnt(0)" ::: "memory");
    const int c = lane & 7;
#pragma unroll
    for (int j = 0; j < 4; ++j) { const int n = (lane >> 3) + 8 * j; const LAS float* s = scr + (8 * c) * 33 + n;
        u32x4 o; o.x = pk2(s[0 * 33], s[1 * 33]); o.y = pk2(s[2 * 33], s[3 * 33]); o.z = pk2(s[4 * 33], s[5 * 33]); o.w = pk2(s[6 * 33], s[7 * 33]);
        int dr = n0 + n; if (MAP == 1) { const int cc = dr >= DFF ? dr - DFF : dr; dr = (cc >> 7) * 256 + (dr >= DFF ? 128 : 0) + (cc & 127); }
        if (MAP == 2) { const int cc = dr & 1023; dr = (cc >> 7) * 256 + (dr >= 1024 ? 128 : 0) + (cc & 127); }
        *(u32x4*)(WT + (size_t)dr * K + k0 + 8 * c) = o; }
    asm volatile("s_waitcnt lgkmcnt(0)" ::: "memory");
}
__device__ __forceinline__ void norm_mod_rows4(const float* __restrict__ src, const float* __restrict__ w, const float* __restrict__ sh, const float* __restrict__ sc, bf16_t* __restrict__ dst, int lane) {
    f32x4 v[4][4]; float ss[4];
#pragma unroll
    for (int r = 0; r < 4; ++r)
#pragma unroll
        for (int j = 0; j < 4; ++j) v[r][j] = *(const f32x4*)(src + (size_t)r * DM + j * 256 + lane * 4);
#pragma unroll
    for (int r = 0; r < 4; ++r) { float s = 0.f;
#pragma unroll
        for (int j = 0; j < 4; ++j) s += (v[r][j][0] * v[r][j][0] + v[r][j][1] * v[r][j][1]) + (v[r][j][2] * v[r][j][2] + v[r][j][3] * v[r][j][3]);
        ss[r] = s; }
#pragma unroll
    for (int o = 1; o < 64; o <<= 1) {
#pragma unroll
        for (int r = 0; r < 4; ++r) ss[r] += __shfl_xor(ss[r], o); }
#pragma unroll
    for (int r = 0; r < 4; ++r) ss[r] = rsqrtf(ss[r] * (1.f / DM) + EPS);
#pragma unroll
    for (int j = 0; j < 4; ++j) { const int k = j * 256 + lane * 4; const f32x4 ww = *(const f32x4*)(w + k), s1 = *(const f32x4*)(sc + k) + 1.f, s0 = *(const f32x4*)(sh + k);
#pragma unroll
        for (int r = 0; r < 4; ++r) { const f32x4 y = (v[r][j] * ss[r] * ww) * s1 + s0; u32x2 o; o.x = pk2(y[0], y[1]); o.y = pk2(y[2], y[3]); *(u32x2*)(dst + (size_t)r * DM + k) = o; } }
}
__device__ __forceinline__ unsigned pack4_u8(float a, float b, float c, float d) { unsigned w = 0u; w = __builtin_amdgcn_cvt_pk_u8_f32(a * 255.f, 0u, w); w = __builtin_amdgcn_cvt_pk_u8_f32(b * 255.f, 1u, w); w = __builtin_amdgcn_cvt_pk_u8_f32(c * 255.f, 2u, w); w = __builtin_amdgcn_cvt_pk_u8_f32(d * 255.f, 3u, w); return w; }
__device__ __forceinline__ void unpack8_u8(const u32x2 w, float (&f)[8]) { constexpr float s = 1.f / 255.f;
    f[0] = (float)(w.x & 0xffu) * s; f[1] = (float)((w.x >> 8) & 0xffu) * s; f[2] = (float)((w.x >> 16) & 0xffu) * s; f[3] = (float)(w.x >> 24) * s;
    f[4] = (float)(w.y & 0xffu) * s; f[5] = (float)((w.y >> 8) & 0xffu) * s; f[6] = (float)((w.y >> 16) & 0xffu) * s; f[7] = (float)(w.y >> 24) * s; }
__device__ __forceinline__ size_t ll_idx(int t, int w, int S, int s, int l) { return ((size_t)(t * 8 + w) * S + s) * 64 + l; }
__device__ __forceinline__ size_t a_blk(int pm, int kt, int wr, int wcl, int ai, int m) { return ((((((size_t)pm * 44 + kt) * 2 + wr) * 2 + wcl) * 2 + ai) * 4 + m) * 1024 + (pm >= A_SPLIT_PM ? A_HI_SHIFT : (size_t)0); }
struct NoPre {};
#define EPI_NOPRE typedef NoPre Pre; __device__ __forceinline__ Pre pre(const pg8::Unit&, int, int) const { return Pre{}; }
__device__ __forceinline__ float xf_id(float v) { return v; }
struct EpiAfast {
    static constexpr bool PERM = true;
    EPI_NOPRE
    bf16_t *Q, *Kb, *Vb, *Ucat, *SG; const float *qnw, *knw; LAS float* SS;
    __device__ __forceinline__ void operator()(const f32x4 (&acc)[2][2][4][2], const pg8::Unit& u, int wr, int wc, int fr, int fq, const Pre& pre_) const {
        using namespace pg8;
        const int row0 = u.pm * BM + wr * 64 + fr, cl = wc * 32 + 8 * fq;
        const bool lat = u.pm < ML / 256;
        if (u.pn < 5) {
            const bool isq = u.pn < 4; const float* nw = isq ? qnw : knw;
#pragma unroll
            for (int ai = 0; ai < 2; ++ai)
#pragma unroll
                for (int m = 0; m < 4; ++m)
#pragma unroll
                    for (int bj = 0; bj < 2; ++bj) { const f32x4 v0 = acc[ai][bj][m][0], v1 = acc[ai][bj][m][1];
                        float s = (v0[0] * v0[0] + v0[1] * v0[1]) + (v0[2] * v0[2] + v0[3] * v0[3]) + (v1[0] * v1[0] + v1[1] * v1[1]) + (v1[2] * v1[2] + v1[3] * v1[3]);
                        s += __shfl_xor(s, 16); s += __shfl_xor(s, 32);
                        if (fq == 0) SS[((ai * HALF + wr * 64 + m * 16 + fr) * 2 + bj) * 4 + wc] = s; }
            asm volatile("s_waitcnt lgkmcnt(0)" ::: "memory"); __builtin_amdgcn_s_barrier(); asm volatile("" ::: "memory");
            const f32x4 w0 = *(const f32x4*)(nw + cl), w1 = *(const f32x4*)(nw + cl + 4);
            float invf[4];
#pragma unroll
            for (int e = 0; e < 4; ++e) invf[e] = exp2f(-(float)(2 * (((cl >> 1) + e) & 31)) * (13.287712379549449f / 64.f));
#pragma unroll
            for (int ai = 0; ai < 2; ++ai)
#pragma unroll
                for (int m = 0; m < 4; ++m) { const int row = row0 + ai * HALF + m * 16;
                    float cs[4], sn[4];
                    if (lat) { const int t = row % SEQ; const float coord = (wc < 2) ? (float)(t >> 6) : (float)(t & 63);
#pragma unroll
                        for (int e = 0; e < 4; ++e) { const float ang = coord * invf[e]; cs[e] = __cosf(ang); sn[e] = __sinf(ang); } }
                    else {
#pragma unroll
                        for (int e = 0; e < 4; ++e) { cs[e] = 1.f; sn[e] = 0.f; } }
                    bf16_t* rp = isq ? Q + (size_t)row * 1024 + u.pn * 256 + cl
                                     : Kb + ((size_t)(lat ? (row / SEQ) * LKV + LC + (row % SEQ) : ((row - ML) / LC) * LKV + ((row - ML) % LC))) * 256 + cl;
#pragma unroll
                    for (int bj = 0; bj < 2; ++bj) {
                        const f32x4 p = *(const LAS f32x4*)(SS + ((ai * HALF + wr * 64 + m * 16 + fr) * 2 + bj) * 4);
                        const float rs = rsqrtf(((p[0] + p[1]) + (p[2] + p[3])) * (1.f / 128.f) + EPS);
                        const f32x4 y0 = acc[ai][bj][m][0] * rs * w0, y1 = acc[ai][bj][m][1] * rs * w1;
                        u32x4 w; w.x = cvt_pk_bf16(y0[0] * cs[0] - y0[1] * sn[0], y0[0] * sn[0] + y0[1] * cs[0]); w.y = cvt_pk_bf16(y0[2] * cs[1] - y0[3] * sn[1], y0[2] * sn[1] + y0[3] * cs[1]);
                        w.z = cvt_pk_bf16(y1[0] * cs[2] - y1[1] * sn[2], y1[0] * sn[2] + y1[1] * cs[2]); w.w = cvt_pk_bf16(y1[2] * cs[3] - y1[3] * sn[3], y1[2] * sn[3] + y1[3] * cs[3]);
                        *(u32x4*)(rp + bj * 128) = w; } }
        }
        else if (u.pn == 5) {
            EPI_ROWS_BF16(Vb + ((size_t)(lat ? (row / SEQ) * LKV + LC + (row % SEQ) : ((row - ML) / LC) * LKV + ((row - ML) % LC))) * 256 + cl, 128, xf_id); }
        else if (u.pn < 8) { const int ch0 = (u.pn - 6) * 256 + cl;
            if (lat) { EPI_ROWS_BF16(Ucat + ucat_idx(row / SEQ, row % SEQ, ch0), (size_t)8 * UROWS * KCAT, xf_id); }
            else { EPI_ROWS_BF16(Ucat + ucat_ctx_idx((row - ML) / LC, (row - ML) % LC, ch0), (size_t)8 * UROWS * KCAT, xf_id); } }
        else { unsigned char* sg8 = (unsigned char*)SG;
#pragma unroll
            for (int ai = 0; ai < 2; ++ai)
#pragma unroll
                for (int m = 0; m < 4; ++m) { const int row = row0 + ai * HALF + m * 16;
#pragma unroll
                    for (int bj = 0; bj < 2; ++bj) { const f32x4 v0 = acc[ai][bj][m][0], v1 = acc[ai][bj][m][1]; u32x2 w;
                        w.x = pack4_u8(sigmoidf_(v0[0]), sigmoidf_(v0[1]), sigmoidf_(v0[2]), sigmoidf_(v0[3])); w.y = pack4_u8(sigmoidf_(v1[0]), sigmoidf_(v1[1]), sigmoidf_(v1[2]), sigmoidf_(v1[3]));
                        ((u32x2*)sg8)[ll_idx(u.pm * 8 + (u.pn - 8), wr * 4 + wc, 16, ai * 8 + m * 2 + bj, fq * 16 + fr)] = w; } } }
    }
};
struct EpiStoreFast {
    static constexpr bool PERM = true; bf16_t* O; int ldo;
    EPI_NOPRE
    __device__ __forceinline__ void operator()(const f32x4 (&acc)[2][2][4][2], const pg8::Unit& u, int wr, int wc, int fr, int fq, const Pre& pre_) const {
        using namespace pg8; const int row0 = u.pm * BM + wr * 64 + fr, cl = u.pn * BM + wc * 32 + 8 * fq;
        EPI_ROWS_BF16(O + (size_t)row * ldo + cl, 128, xf_id);
    }
};
__device__ __forceinline__ void unpack8(const u32x4 w, float (&f)[8]) {
    f[0] = __uint_as_float(w.x << 16); f[1] = __uint_as_float(w.x & 0xffff0000u); f[2] = __uint_as_float(w.y << 16); f[3] = __uint_as_float(w.y & 0xffff0000u);
    f[4] = __uint_as_float(w.z << 16); f[5] = __uint_as_float(w.z & 0xffff0000u); f[6] = __uint_as_float(w.w << 16); f[7] = __uint_as_float(w.w & 0xffff0000u);
}
struct EpiGluPair {
    static constexpr bool PERM = true;
    EPI_NOPRE const bf16_t* SG; bf16_t* PS;
    __device__ __forceinline__ void operator()(const f32x4 (&acc)[2][2][4][2], const pg8::Unit& u, int wr, int wc, int fr, int fq, const Pre& pre_) const {
        using namespace pg8; const int row0 = u.pm * BM + wr * 64 + fr, c0 = u.pn * 128 + wc * 32 + 8 * fq;
        u32x2 gw[2][4]; const unsigned char* sg8 = (const unsigned char*)SG;
#pragma unroll
        for (int ai = 0; ai < 2; ++ai)
#pragma unroll
            for (int m = 0; m < 4; ++m) gw[ai][m] = ((const u32x2*)sg8)[ll_idx(u.pm * 8 + 4 + (u.pn >> 1), wr * 4 + wc, 16, ai * 8 + m * 2 + (u.pn & 1), fq * 16 + fr)];
#pragma unroll
        for (int ai = 0; ai < 2; ++ai)
#pragma unroll
            for (int m = 0; m < 4; ++m) { const int row = row0 + ai * HALF + m * 16; float gs[8], r[8];
                unpack8_u8(gw[ai][m], gs);
#pragma unroll
                for (int j = 0; j < 8; ++j) { const float av = (j < 4) ? acc[ai][0][m][0][j & 3] : acc[ai][0][m][1][j & 3], bv = (j < 4) ? acc[ai][1][m][0][j & 3] : acc[ai][1][m][1][j & 3]; r[j] = gs[j] * av * sigmoidf_(bv); }
                u32x4 w; w.x = cvt_pk_bf16(r[0], r[1]); w.y = cvt_pk_bf16(r[2], r[3]); w.z = cvt_pk_bf16(r[4], r[5]); w.w = cvt_pk_bf16(r[6], r[7]);
                ((u32x4*)PS)[ll_idx(u.pm * 8 + u.pn, wr * 4 + wc, 8, ai * 4 + m, fq * 16 + fr)] = w; }
    }
};
struct EpiMergeFast {
    static constexpr bool PERM = true;
    EPI_NOPRE const bf16_t *SG, *GLU; bf16_t* MG;
    __device__ __forceinline__ void operator()(const f32x4 (&acc)[2][2][4][2], const pg8::Unit& u, int wr, int wc, int fr, int fq, const Pre& pre_) const {
        using namespace pg8; const int row0 = u.pm * BM + wr * 64 + fr, cl = u.pn * BM + wc * 32 + 8 * fq;
#pragma unroll
        for (int ai = 0; ai < 2; ++ai) {
            u32x2 gw[4][2]; u32x4 pw[4][2]; const unsigned char* sg8 = (const unsigned char*)SG;
#pragma unroll
            for (int m = 0; m < 4; ++m)
#pragma unroll
                for (int bj = 0; bj < 2; ++bj) { gw[m][bj] = ((const u32x2*)sg8)[ll_idx(u.pm * 8 + u.pn, wr * 4 + wc, 16, ai * 8 + m * 2 + bj, fq * 16 + fr)]; pw[m][bj] = ((const u32x4*)GLU)[ll_idx(u.pm * 8 + 2 * u.pn + bj, wr * 4 + wc, 8, ai * 4 + m, fq * 16 + fr)]; }
#pragma unroll
            for (int m = 0; m < 4; ++m)
#pragma unroll
                for (int bj = 0; bj < 2; ++bj) { const int row = row0 + ai * HALF + m * 16; float ga[8], ps[8], r[8];
                    unpack8_u8(gw[m][bj], ga); unpack8(pw[m][bj], ps);
#pragma unroll
                    for (int j = 0; j < 8; ++j) { const float v = (j < 4) ? acc[ai][bj][m][0][j & 3] : acc[ai][bj][m][1][j & 3]; r[j] = ga[j] * v + ps[j]; }
                    u32x4 w; w.x = cvt_pk_bf16(r[0], r[1]); w.y = cvt_pk_bf16(r[2], r[3]); w.z = cvt_pk_bf16(r[4], r[5]); w.w = cvt_pk_bf16(r[6], r[7]);
                    *(u32x4*)((char*)MG + blk16x32(u.pm, 32, u.pn * 4 + bj * 2 + (wc >> 1), ai, wr * 4 + m, wc & 1) + (fr * 32 + 8 * fq) * 2) = w; } }
    }
};
struct EpiResidFast {
    static constexpr bool PERM = false; const float* base; float* out; const float* gate;
    EPI_NOPRE
    __device__ __forceinline__ void operator()(const f32x4 (&acc)[2][2][4][2], const pg8::Unit& u, int wr, int wc, int fr, int fq, const Pre& pre_) const {
        using namespace pg8; const int row0 = u.pm * BM + wr * 64 + fr, col0 = u.pn * BM + wc * 32 + 4 * fq;
        const float* gp = gate + (size_t)((u.pm * BM) / SEQ) * 6144 + col0;
        f32x4 gv[2][2];
#pragma unroll
        for (int bj = 0; bj < 2; ++bj)
#pragma unroll
            for (int n = 0; n < 2; ++n) gv[bj][n] = *(const f32x4*)(gp + bj * HALF + n * 16);
#pragma unroll
        for (int ai = 0; ai < 2; ++ai)
#pragma unroll
            for (int m = 0; m < 4; ++m) { const size_t off = (size_t)(row0 + ai * HALF + m * 16) * 1024 + col0;
#pragma unroll
                for (int bj = 0; bj < 2; ++bj)
#pragma unroll
                    for (int n = 0; n < 2; ++n) { const f32x4 bs = *(const f32x4*)(base + off + bj * HALF + n * 16); *(f32x4*)(out + off + bj * HALF + n * 16) = bs + gv[bj][n] * acc[ai][bj][m][n]; }
                asm volatile("" ::: "memory"); }
    }
};
template <int CTRL> __device__ __forceinline__ float dppf(float x) { return __builtin_bit_cast(float, __builtin_amdgcn_mov_dpp(__builtin_bit_cast(int, x), CTRL, 0xf, 0xf, true)); }
template <int CTRL> __device__ __forceinline__ float dpp_old(float old, float x) { return __builtin_bit_cast(float, __builtin_amdgcn_update_dpp(__builtin_bit_cast(int, old), __builtin_bit_cast(int, x), CTRL, 0xf, 0xf, false)); }
struct EpiUpConv {
    static constexpr bool PERM = true;
    struct Pre { f32x2 v; };
    __device__ __forceinline__ Pre pre(const pg8::Unit& u, int p, int lane) const { const int c = u.pn * 128 + lane * 2;
        const float* sp = p < 3 ? cw + p * NUP + c : p == 3 ? cb + c : p < 7 ? cw + (p - 4) * NUP + DFF + c : cb + DFF + c; Pre r; r.v = *(const f32x2*)sp; return r; }
    bf16_t* A; float* HALO; const float* cw; const float* cb; LAS float* Bd; LAS float* Pm;
    __device__ __forceinline__ void operator()(const f32x4 (&acc)[2][2][4][2], const pg8::Unit& u, int wr, int wc, int fr, int fq, const Pre& pre_) const {
        using namespace pg8;
        const int x0 = wc * 32 + 8 * fq;
        if (fr == 0) {
#pragma unroll
            for (int ai = 0; ai < 2; ++ai)
#pragma unroll
                for (int bj = 0; bj < 2; ++bj)
#pragma unroll
                    for (int n = 0; n < 2; ++n) *(LAS f32x4*)(Bd + (ai * 4 + wr * 2) * 256 + bj * 128 + x0 + 4 * n) = acc[ai][bj][0][n]; }
        if (fr == 15) {
#pragma unroll
            for (int ai = 0; ai < 2; ++ai)
#pragma unroll
                for (int bj = 0; bj < 2; ++bj)
#pragma unroll
                    for (int n = 0; n < 2; ++n) *(LAS f32x4*)(Bd + (ai * 4 + wr * 2 + 1) * 256 + bj * 128 + x0 + 4 * n) = acc[ai][bj][3][n]; }
        {
          const int p = wr * 4 + wc, xx = (fq * 16 + fr) * 2; Pm[p * 128 + xx] = pre_.v.x; Pm[p * 128 + xx + 1] = pre_.v.y; }
        asm volatile("s_waitcnt lgkmcnt(0)" ::: "memory"); __builtin_amdgcn_s_barrier(); asm volatile("" ::: "memory");
        const int cbase = u.pn * 128 + x0;
        float* hz = HALO + ((size_t)(u.pm * 22 + u.pn) * 4) * 256;
#pragma unroll
        for (int ai = 0; ai < 2; ++ai) {
            const int blk = 2 * ai + wr;
            const LAS float* pbp = Bd + (((blk - 1) >> 1) * 4 + ((blk - 1) & 1) * 2 + 1) * 256 + x0;
            const LAS float* nbp = Bd + (((blk + 1) >> 1) * 4 + ((blk + 1) & 1) * 2) * 256 + x0;
#pragma unroll
            for (int n = 0; n < 2; ++n) {
                const int c = cbase + 4 * n;
                const LAS float* pp = Pm + x0 + 4 * n;
                float o[4][4];
#pragma unroll
                for (int j = 0; j < 4; ++j) {
                    const float w0v = pp[j], w1v = pp[128 + j], w2v = pp[256 + j], bv = pp[384 + j], w0g = pp[512 + j], w1g = pp[640 + j], w2g = pp[768 + j], bg = pp[896 + j];
                    float pbv = 0.f, pbg = 0.f, nbv = 0.f, nbg = 0.f;
                    if (blk > 0) { pbv = pbp[4 * n + j]; pbg = pbp[128 + 4 * n + j]; }
                    if (blk < 3) { nbv = nbp[4 * n + j]; nbg = nbp[128 + 4 * n + j]; }
                    float zv[4], zg[4];
#pragma unroll
                    for (int m = 0; m < 4; ++m) { zv[m] = acc[ai][0][m][n][j]; zg[m] = acc[ai][1][m][n][j]; }
                    const float pv0 = dpp_old<0x111>(pbv, zv[3]), pg0 = dpp_old<0x111>(pbg, zg[3]), nv3 = dpp_old<0x101>(nbv, zv[0]), ng3 = dpp_old<0x101>(nbg, zg[0]);
#pragma unroll
                    for (int m = 0; m < 4; ++m) {
                        const float pv = m == 0 ? pv0 : zv[m > 0 ? m - 1 : 0], pg = m == 0 ? pg0 : zg[m > 0 ? m - 1 : 0], nv = m == 3 ? nv3 : zv[m < 3 ? m + 1 : 3], ng = m == 3 ? ng3 : zg[m < 3 ? m + 1 : 3];
                        const float cv = fmaf(w0v, pv, fmaf(w1v, zv[m], fmaf(w2v, nv, bv))), cg = fmaf(w0g, pg, fmaf(w1g, zg[m], fmaf(w2g, ng, bg)));
                        if (m == 0 && blk == 0 && fr == 0) { hz[0 * 256 + x0 + 4 * n + j] = zv[0]; hz[0 * 256 + 128 + x0 + 4 * n + j] = zg[0]; hz[2 * 256 + x0 + 4 * n + j] = cv; hz[2 * 256 + 128 + x0 + 4 * n + j] = cg; }
                        if (m == 3 && blk == 3 && fr == 15) { hz[1 * 256 + x0 + 4 * n + j] = zv[3]; hz[1 * 256 + 128 + x0 + 4 * n + j] = zg[3]; hz[3 * 256 + x0 + 4 * n + j] = cv; hz[3 * 256 + 128 + x0 + 4 * n + j] = cg; }
                        o[m][j] = siluf_(cg) * cv; }
                }
#pragma unroll
                for (int m = 0; m < 4; ++m) { u32x2 w; w.x = cvt_pk_bf16(o[m][0], o[m][1]); w.y = cvt_pk_bf16(o[m][2], o[m][3]);
                    *(u32x2*)((char*)A + a_blk(u.pm, u.pn * 2 + (wc >> 1), wr, wc & 1, ai, m) + (fr * 4 + fq) * 16 + n * 8) = w; }
                asm volatile("" ::: "memory");
            }
        }
    }
};
__device__ __forceinline__ void conv_fix_panel(int pm, const float* __restrict__ HALO, const float* __restrict__ cw, bf16_t* __restrict__ A, int tid) {
#pragma unroll
    for (int rk = 0; rk < 2; ++rk) {
        if (rk == 0 ? (pm & 7) == 0 : (pm & 7) == 7) continue;
        const int nb = rk == 0 ? pm - 1 : pm + 1;
        for (int c = tid; c < DFF; c += NWV * 64) { const int pn = c >> 7, x = c & 127;
            const float* hp = HALO + ((size_t)(pm * 22 + pn) * 4 + 2 + rk) * 256; const float* hn = HALO + ((size_t)(nb * 22 + pn) * 4 + (rk == 0 ? 1 : 0)) * 256;
            const float wv = cw[(rk == 0 ? 0 : 2) * NUP + c], wg = cw[(rk == 0 ? 0 : 2) * NUP + DFF + c];
            const float val = hp[x] + wv * hn[x], gate = hp[128 + x] + wg * hn[128 + x];
            const int wc = x >> 5, fq = (x >> 3) & 3;
            *(bf16_t*)((char*)A + a_blk(pm, pn * 2 + (wc >> 1), rk, wc & 1, rk, rk ? 3 : 0) + ((rk ? 15 : 0) * 4 + fq) * 16 + (x & 7) * 2) = f2bf(siluf_(gate) * val); }
    }
}
__device__ __forceinline__ int sidx(int d, int ri, int n) { return d * 128 + ri * 64 + n; }
__device__ __forceinline__ void s5_tables_block(const S5In& P, int g, int qr, bf16_t* __restrict__ W1, bf16_t* __restrict__ B3, float* __restrict__ A32, LAS unsigned char* lds, int tid) {
    LAS float* BBs = (LAS float*)lds;
    LAS float* PWs = BBs + 4096;
    LAS float* CCs = PWs + 66 * 130;
    LAS float* KT = CCs + 32 * 130;
    if (tid < 128) {
        const int d = tid >> 6, n = tid & 63, dg = d * NG + g;
        const float dt = expf(P.ldt[dg]), lr = P.lre[dg * NS + n], li = P.lim[dg * NS + n];
        const float mag = expf(lr * dt), ang = li * dt, are = mag * cosf(ang), aim = mag * sinf(ang);
        const float den = lr * lr + li * li, nr = are - 1.f, ni = aim, fre = (nr * lr + ni * li) / den, fim = (ni * lr - nr * li) / den;
#pragma unroll
        for (int q = 0; q < PG; ++q) { const float br = P.bre[((size_t)dg * NS + n) * PG + q], bi = P.bim[((size_t)dg * NS + n) * PG + q];
            BBs[((d * 64 + n) * 16 + q) * 2] = fre * br - fim * bi; BBs[((d * 64 + n) * 16 + q) * 2 + 1] = fre * bi + fim * br; }
        double pr = 1.0, pi = 0.0; const double ar = (double)are, ai = (double)aim;
        for (int k = 0; k <= 32; ++k) { PWs[(d * 33 + k) * 130 + n * 2] = (float)pr; PWs[(d * 33 + k) * 130 + n * 2 + 1] = (float)pi; const double t0 = pr * ar - pi * ai, t1 = pr * ai + pi * ar; pr = t0; pi = t1; }
        if (qr == 0) { A32[(dg * NS + n) * 2] = PWs[(d * 33 + 32) * 130 + n * 2]; A32[(dg * NS + n) * 2 + 1] = PWs[(d * 33 + 32) * 130 + n * 2 + 1]; }
    }
    for (int i = tid; i < 2048; i += 512) { const int d = i >> 10, p = (i >> 6) & 15, n = i & 63; CCs[(i >> 6) * 130 + (i & 63) * 2] = P.cre[((size_t)(d * NG + g) * PG + p) * NS + n]; CCs[(i >> 6) * 130 + (i & 63) * 2 + 1] = P.cim[((size_t)(d * NG + g) * PG + p) * NS + n]; }
    __syncthreads();
    REPS(22) { const int d = tid >> 8, lagA = (tid >> 4) & 15, p = tid & 15; float accA[16], accB[16];
#pragma unroll
        for (int q = 0; q < 16; ++q) { accA[q] = 0.f; accB[q] = 0.f; }
        const LAS float* cp = CCs + (d * 16 + p) * 130; const LAS float* pa = PWs + (d * 33 + lagA) * 130; const LAS float* pb = PWs + (d * 33 + lagA + 16) * 130;
#pragma unroll 2
        for (int n = 0; n < 64; ++n) { const float cr = cp[2 * n], ci = cp[2 * n + 1], par = pa[2 * n], pai = pa[2 * n + 1], pbr = pb[2 * n], pbi = pb[2 * n + 1];
            const float xr = cr * par - ci * pai, xi = cr * pai + ci * par, yr = cr * pbr - ci * pbi, yi = cr * pbi + ci * pbr; const LAS float* bb = BBs + ((d * 64 + n) * 16) * 2;
#pragma unroll
            for (int q = 0; q < 16; ++q) { const float br = bb[2 * q], bi = bb[2 * q + 1]; accA[q] += xr * br - xi * bi; accB[q] += yr * br - yi * bi; } }
#pragma unroll
        for (int q = 0; q < 16; ++q) { KT[(d * 32 + lagA) * 260 + p * 16 + q] = accA[q]; KT[(d * 32 + lagA + 16) * 260 + p * 16 + q] = accB[q]; } }
    __syncthreads();
    for (int ch = tid; ch < 128 * 96; ch += 512) { const int r = ch / 96, cc = ch % 96, j = qr * 8 + (r >> 4), p = r & 15; float v[8];
        if (cc < 64) { const int i = cc >> 1, q0 = (cc & 1) * 8, lag = j - i;
#pragma unroll
            for (int e = 0; e < 8; ++e) { const int q = q0 + e; float x;
                if (lag > 0) x = KT[lag * 260 + p * 16 + q]; else if (lag < 0) x = KT[(32 - lag) * 260 + p * 16 + q];
                else x = KT[p * 16 + q] + KT[32 * 260 + p * 16 + q] + (q == p ? P.dsk[g * PG + p] : 0.f);
                v[e] = x; } }
        else { const int s0 = (cc - 64) * 8, d = s0 >> 7, ri = (s0 >> 6) & 1, n0 = s0 & 63, k = d == 0 ? j + 1 : 32 - j;
#pragma unroll
            for (int e = 0; e < 8; ++e) { const int n = n0 + e; const float cr = CCs[(d * 16 + p) * 130 + n * 2], ci = CCs[(d * 16 + p) * 130 + n * 2 + 1], pr = PWs[(d * 33 + k) * 130 + n * 2], pi = PWs[(d * 33 + k) * 130 + n * 2 + 1];
                v[e] = ri == 0 ? (cr * pr - ci * pi) : -(cr * pi + ci * pr); } }
        u32x4 w; w.x = pk2(v[0], v[1]); w.y = pk2(v[2], v[3]); w.z = pk2(v[4], v[5]); w.w = pk2(v[6], v[7]);
        *(u32x4*)(B3 + ((size_t)(g * 512 + j * 16 + p)) * KCAT + cc * 8) = w; }
    { const int d = qr >> 1, ri = qr & 1;
      for (int ch = tid; ch < 64 * 64; ch += 512) { const int n = ch >> 6, cc = ch & 63, i = cc >> 1, q0 = (cc & 1) * 8, k = d == 0 ? 31 - i : i; float v[8];
          const float pr = PWs[(d * 33 + k) * 130 + n * 2], pi = PWs[(d * 33 + k) * 130 + n * 2 + 1];
#pragma unroll
          for (int e = 0; e < 8; ++e) { const float br = BBs[((d * 64 + n) * 16 + q0 + e) * 2], bi = BBs[((d * 64 + n) * 16 + q0 + e) * 2 + 1]; v[e] = ri == 0 ? (pr * br - pi * bi) : (pr * bi + pi * br); }
          u32x4 w; w.x = pk2(v[0], v[1]); w.y = pk2(v[2], v[3]); w.z = pk2(v[4], v[5]); w.w = pk2(v[6], v[7]);
          *(u32x4*)(W1 + ((size_t)(g * 256 + qr * 64 + n)) * 512 + cc * 8) = w; } }
    __syncthreads();
}
__device__ __forceinline__ size_t l_idx(int row, int col) { return ((size_t)((row >> 4) * 16 + (col >> 4))) * 256 + (row & 15) * 16 + (col & 15); }
struct EpiS1 {
    static constexpr bool PERM = false; float* L;
    EPI_NOPRE
    __device__ __forceinline__ void operator()(const f32x4 (&acc)[2][2][4][2], const pg8::Unit& u, int wr, int wc, int fr, int fq, const Pre& pre_) const {
        using namespace pg8; const int row0 = u.pm * BM + wr * 64 + fr, col0 = wc * 32 + 4 * fq;
        float* Lg = L + (size_t)u.grp * UROWS * 256;
#pragma unroll
        for (int ai = 0; ai < 2; ++ai)
#pragma unroll
            for (int m = 0; m < 4; ++m)
#pragma unroll
                for (int bj = 0; bj < 2; ++bj)
#pragma unroll
                    for (int n = 0; n < 2; ++n) *(f32x4*)(Lg + l_idx(row0 + ai * HALF + m * 16, col0 + bj * HALF + n * 16)) = acc[ai][bj][m][n];
    }
};
struct EpiS3 {
    static constexpr bool PERM = true; bf16_t* SSM;
    EPI_NOPRE
    __device__ __forceinline__ void operator()(const f32x4 (&acc)[2][2][4][2], const pg8::Unit& u, int wr, int wc, int fr, int fq, const Pre& pre_) const {
        using namespace pg8; const int row0 = u.pm * BM + wr * 64 + fr, cl = u.pn * BM + wc * 32 + 8 * fq;
        EPI_ROWS_BF16(SSM + ((size_t)(u.grp * 1024 + row)) * 512 + cl, 128, gelu_tanh);
    }
};
struct OrderS1 { int G, c; bool xm;
    __device__ __forceinline__ bool next(int i, pg8::Unit& u) const {
        if (xm) { const int k = c >> 3; if (i != 0 || k >= 20) return false; u.grp = (c & 7) + 8 * (k / 5); u.pm = k % 5; u.pn = 0; return true; }
        const int L = i * G + c; if (L >= NG * 5) return false; u.grp = L / 5; u.pm = L % 5; u.pn = 0; return true; } };
struct OrderOne { pg8::Unit u0; __device__ __forceinline__ bool next(int i, pg8::Unit& u) const { if (i != 0) return false; u = u0; return true; } };
template <int MODE> struct EpiResNorm {
    static constexpr bool PERM = true;
    EPI_NOPRE
    const float* base; float* out; const float* gate; const float* fw; unsigned* xs; unsigned* cnt; LAS float* P;
    bf16_t* H2; const float* sh; const float* sc;
    bf16_t* x1b;
    __device__ __forceinline__ void operator()(f32x4 (&acc)[2][2][4][2], const pg8::Unit& u, int wr, int wc, int fr, int fq, const Pre& pre_) const {
        using namespace pg8; const int row0 = u.pm * BM + wr * 64 + fr, col0 = u.pn * BM + wc * 32 + 8 * fq;
        const int wid = wr * 4 + wc, lane = fq * 16 + fr;
        { const float* gp = gate + (size_t)((u.pm * BM) / SEQ) * 6144 + col0; f32x4 gv[2][2];
#pragma unroll
          for (int bj = 0; bj < 2; ++bj)
#pragma unroll
              for (int n = 0; n < 2; ++n) gv[bj][n] = *(const f32x4*)(gp + bj * HALF + n * 4);
#pragma unroll
          for (int ai = 0; ai < 2; ++ai) {
#pragma unroll
              for (int mh = 0; mh < 2; ++mh) {
              f32x4 xb[2][2][2];
#pragma unroll
              for (int m2 = 0; m2 < 2; ++m2)
#pragma unroll
                  for (int bj = 0; bj < 2; ++bj)
                      { const size_t o_ = (size_t)(row0 + ai * HALF + (2 * mh + m2) * 16) * 1024 + col0 + bj * HALF;
                          if (X1_BF16 && MODE == 0) { const u32x4 w_ = ((const u32x4*)x1b)[ll_idx(u.pm * 4 + u.pn, wr * 4 + wc, 16, ai * 8 + (2 * mh + m2) * 2 + bj, fq * 16 + fr)];
                              xb[m2][bj][0] = (f32x4){__uint_as_float(w_.x << 16), __uint_as_float(w_.x & 0xffff0000u), __uint_as_float(w_.y << 16), __uint_as_float(w_.y & 0xffff0000u)};
                              xb[m2][bj][1] = (f32x4){__uint_as_float(w_.z << 16), __uint_as_float(w_.z & 0xffff0000u), __uint_as_float(w_.w << 16), __uint_as_float(w_.w & 0xffff0000u)}; }
                          else { xb[m2][bj][0] = *(const f32x4*)(base + o_); xb[m2][bj][1] = *(const f32x4*)(base + o_ + 4); } }
#pragma unroll
              for (int m2 = 0; m2 < 2; ++m2) { const int m = 2 * mh + m2; float s = 0.f;
#pragma unroll
                  for (int bj = 0; bj < 2; ++bj)
#pragma unroll
                      for (int n = 0; n < 2; ++n) { const f32x4 x = xb[m2][bj][n] + gv[bj][n] * acc[ai][bj][m][n]; acc[ai][bj][m][n] = x; s += (x[0] * x[0] + x[1] * x[1]) + (x[2] * x[2] + x[3] * x[3]); }
                  s += __shfl_xor(s, 16); s += __shfl_xor(s, 32);
                  if (fq == 0) P[(ai * HALF + wr * 64 + m * 16 + fr) * 4 + wc] = s; } } } }
        asm volatile("s_waitcnt lgkmcnt(0)" ::: "memory"); __builtin_amdgcn_s_barrier(); asm volatile("" ::: "memory");
        const int prow = wid * 32 + (lane & 31);
        if (lane < 32) { const f32x4 p = *(const LAS f32x4*)(P + prow * 4);
            __hip_atomic_store(xs + ((size_t)(u.pm * BM + prow)) * 4 + u.pn, __float_as_uint((p[0] + p[1]) + (p[2] + p[3])), __ATOMIC_RELAXED, __HIP_MEMORY_SCOPE_AGENT); }
        asm volatile("s_waitcnt vmcnt(0)" ::: "memory");
        if (lane == 0) __hip_atomic_fetch_add(cnt + 64 * u.pm, 1u, __ATOMIC_RELAXED, __HIP_MEMORY_SCOPE_AGENT);
        if (wid == 0) {
            unsigned spins = 0;
            while ((unsigned)__builtin_amdgcn_readfirstlane(__hip_atomic_load(cnt + 64 * u.pm, __ATOMIC_RELAXED, __HIP_MEMORY_SCOPE_AGENT)) < 32u) { __builtin_amdgcn_s_sleep(2); if (++spins > (1u << 22)) break; }
            __builtin_amdgcn_fence(__ATOMIC_ACQUIRE, "agent");
        }
        asm volatile("s_waitcnt vmcnt(0) lgkmcnt(0)" ::: "memory"); __builtin_amdgcn_s_barrier(); asm volatile("" ::: "memory");
        if (lane < 32) { const unsigned* sl = xs + ((size_t)(u.pm * BM + prow)) * 4; float t = 0.f;
#pragma unroll
            for (int k = 0; k < 4; ++k) t += __uint_as_float(__hip_atomic_load(sl + k, __ATOMIC_RELAXED, __HIP_MEMORY_SCOPE_AGENT));
            P[1024 + prow] = rsqrtf(t * (1.f / DM) + EPS); }
        asm volatile("s_waitcnt lgkmcnt(0)" ::: "memory"); __builtin_amdgcn_s_barrier(); asm volatile("" ::: "memory");
        if (MODE == 0) {
            f32x4 fv[2][2];
#pragma unroll
            for (int bj = 0; bj < 2; ++bj)
#pragma unroll
                for (int n = 0; n < 2; ++n) fv[bj][n] = *(const f32x4*)(fw + col0 + bj * HALF + n * 4);
#pragma unroll
            for (int ai = 0; ai < 2; ++ai)
#pragma unroll
                for (int m = 0; m < 4; ++m) { const int r = ai * HALF + wr * 64 + m * 16 + fr; const float rs = P[1024 + r]; const size_t off = (size_t)(u.pm * BM + r) * 1024 + col0;
#pragma unroll
                    for (int bj = 0; bj < 2; ++bj)
#pragma unroll
                        for (int n = 0; n < 2; ++n) *(f32x4*)(out + off + bj * HALF + n * 4) = acc[ai][bj][m][n] * rs * fv[bj][n]; }
        } else {
            float rsv[2][4];
#pragma unroll
            for (int ai = 0; ai < 2; ++ai)
#pragma unroll
                for (int m = 0; m < 4; ++m) rsv[ai][m] = P[1024 + ai * HALF + wr * 64 + m * 16 + fr];
            const size_t mo = (size_t)((u.pm * BM) / SEQ) * 6144 + col0;
#pragma unroll
            for (int bj = 0; bj < 2; ++bj) { const int cc = bj * HALF;
                const f32x4 wwa = *(const f32x4*)(fw + col0 + cc), wwb = *(const f32x4*)(fw + col0 + cc + 4), s1a = *(const f32x4*)(sc + mo + cc) + 1.f, s1b = *(const f32x4*)(sc + mo + cc + 4) + 1.f, s0a = *(const f32x4*)(sh + mo + cc), s0b = *(const f32x4*)(sh + mo + cc + 4);
#pragma unroll
                for (int ai = 0; ai < 2; ++ai)
#pragma unroll
                    for (int m = 0; m < 4; ++m) { const size_t ro = (size_t)(row0 + ai * HALF + m * 16) * 1024 + col0 + cc; const f32x4 xa = acc[ai][bj][m][0], xb_ = acc[ai][bj][m][1];
                        if (X1_BF16) { u32x4 xw; xw.x = cvt_pk_bf16(xa[0], xa[1]); xw.y = cvt_pk_bf16(xa[2], xa[3]); xw.z = cvt_pk_bf16(xb_[0], xb_[1]); xw.w = cvt_pk_bf16(xb_[2], xb_[3]); ((u32x4*)x1b)[ll_idx(u.pm * 4 + u.pn, wr * 4 + wc, 16, ai * 8 + m * 2 + bj, fq * 16 + fr)] = xw; }
                        else { *(f32x4*)(out + ro) = xa; *(f32x4*)(out + ro + 4) = xb_; }
                        const f32x4 ya = (xa * rsv[ai][m] * wwa) * s1a + s0a, yb = (xb_ * rsv[ai][m] * wwb) * s1b + s0b; u32x4 w; w.x = cvt_pk_bf16(ya[0], ya[1]); w.y = cvt_pk_bf16(ya[2], ya[3]); w.z = cvt_pk_bf16(yb[0], yb[1]); w.w = cvt_pk_bf16(yb[2], yb[3]);
                        { const int t64 = m * 16 + fr, rv = ((t64 & 3) << 4) | (t64 >> 2);
                          *(u32x4*)((char*)H2 + blk16x32(u.pm, 16, u.pn * 4 + bj * 2 + (wc >> 1), ai, wr * 4 + (rv >> 4), wc & 1) + ((rv & 15) * 32 + 8 * fq) * 2) = w; } }
                asm volatile("" ::: "memory"); }
        }
    }
};
struct OrderRect { pg8::StaticOrder so; __device__ __forceinline__ bool next(int i, pg8::Unit& u) const { return so.next(i, u); } };
struct OrderRot { pg8::StaticOrder so; __device__ __forceinline__ bool next(int i, pg8::Unit& u) const { if (!so.next(i, u)) return false; u.pn = (u.pn & ~3) | ((u.pn + ((u.pm >> 3) & 1)) & 3); return true; } };
struct OrderA {
    pg8::StaticOrder so;
    __device__ __forceinline__ bool next(int i, pg8::Unit& u) const {
        if (so.next(i, u)) return true;
        const long L = (long)i * so.G + so.c - so.nwg; if (L < 0 || L >= 64) return false;
        u.pm = 128 + (int)(L >> 2); u.pn = 4 + (int)(L & 3); u.grp = 0; return true;
    }
};

__global__ void __launch_bounds__(NWV * 64, 2) mk_fwd(MkArgs a) {
    extern __shared__ __attribute__((aligned(16))) unsigned char lds_raw[];
    LAS unsigned char* lds = (LAS unsigned char*)lds_raw;
#if !USE_XBAR
    cg::grid_group grid = cg::this_grid();
#endif
    const int tid0 = threadIdx.x, wave = __builtin_amdgcn_readfirstlane(tid0 >> 6);
#define PHASE_IDS const int tid = opaque_tid(wave), lane = tid & 63; (void)tid; (void)lane
    const int G = gridDim.x, bx = blockIdx.x;
    const int gw = bx * NWV + wave, NGW = G * NWV;
    unsigned char* ws = a.ws;
#define mod ((float*)(ws + WS_MOD))
#define WTin ((bf16_t*)(ws + WS_WIN))
#define WTbr ((bf16_t*)(ws + WS_WBR))
#define WTglu ((bf16_t*)(ws + WS_WGLU))
#define WTout ((bf16_t*)(ws + WS_WOUT))
#define WTup ((bf16_t*)(ws + WS_WUP))
#define WTdn ((bf16_t*)(ws + WS_WDN))
#define H ((bf16_t*)(ws + WS_H))
#define Q ((bf16_t*)(ws + WS_Q))
#define Kb ((bf16_t*)(ws + WS_K))
#define Vb ((bf16_t*)(ws + WS_V))
#define Ucat ((bf16_t*)(ws + WS_UCAT))
#define Uctx Ucat
#define SG ((bf16_t*)(ws + WS_SG))
#define O ((bf16_t*)(ws + WS_O))
#define SSM ((bf16_t*)(ws + WS_SSM))
#define GLU ((bf16_t*)(ws + WS_GLU))
#define MG ((bf16_t*)out)
#define H2 ((bf16_t*)(ws + WS_H2))
#define Ab ((bf16_t*)(ws + WS_A))
#define Ytmp ((float*)(ws + WS_YTMP))
    float* const out = a.out;
    const int lo = a.ph_lo, hi = a.ph_hi;
    volatile LAS unsigned* bst = (volatile LAS unsigned*)(lds + MK_LDS - 16);
    if (tid0 < 3) bst[tid0] = 0u;
    __syncthreads();
    XcdBarrier xbar = xcd_barrier_post((unsigned*)(ws + WS_CTL), bst);
    if (tid0 == 0 && xbar.x != (unsigned)(bx & 7)) (void)xb_add((unsigned*)(ws + WS_CTL) + GB_MISMATCH, 1u);
    bool grp_ok = false; unsigned tgen = 0u; (void)tgen;
#define IN(k) (lo <= (k) && (k) < hi)
#if USE_XBAR
#define SEAM(k) do { if (IN(k) && IN((k) + 1)) xcd_barrier(xbar); } while (0)
#define SEAMG(k) do { if (IN(k) && IN((k) + 1)) { if (grp_ok) grp_barrier(xbar); else xcd_barrier(xbar); } } while (0)
#define SEAMGT(k, topw) do { if (IN(k) && IN((k) + 1)) { if (grp_ok) grp_barrier(xbar, (unsigned*)(ws + WS_CTL) + (topw)); else xcd_barrier(xbar); } } while (0)
#define SEAMT(k) do { if (IN(k) && IN((k) + 1)) { if (grp_ok) team_barrier((unsigned*)(ws + WS_CTL) + TB_WORD(bx & 7, (bx >> 3) & 7), ++tgen); else xcd_barrier(xbar); } } while (0)
#else
#define SEAM(k) do { if (IN(k) && IN((k) + 1)) grid.sync(); } while (0)
#define SEAMG(k) SEAM(k)
#define SEAMGT(k, topw) SEAM(k)
#define SEAMT(k) SEAM(k)
#endif

    if (IN(0)) REPS(0) { PHASE_IDS;
        if (bx < 256) {
            LAS float* sc = (LAS float*)lds;
            LAS float* red = (LAS float*)(lds + 17 * 1024 * 4);
            for (int i = tid; i < 17 * 1024; i += NWV * 64) { const int r = i >> 10, k = i & 1023; sc[i] = siluf_(r < NB ? a.in[1][(size_t)r * DM + k] : a.in[3][k]); }
            __syncthreads();
            const float* wm = a.in[4]; const int ks = tid >> 5, c = tid & 31;
            for (int ch = bx; ch < 256; ch += G) {
                float acc[17];
#pragma unroll
                for (int r = 0; r < 17; ++r) acc[r] = 0.f;
                if (c < 24) { const float* wp = wm + (size_t)(ks * 64) * 6144 + ch * 24 + c;
#pragma unroll 4
                    for (int k = 0; k < 64; ++k) { const float w = wp[(size_t)k * 6144];
#pragma unroll
                        for (int r = 0; r < 17; ++r) acc[r] = fmaf(sc[r * 1024 + ks * 64 + k], w, acc[r]); }
#pragma unroll
                    for (int r = 0; r < 17; ++r) red[(ks * 17 + r) * 24 + c] = acc[r]; }
                __syncthreads();
                if (tid < 17 * 24) { const int r = tid / 24, cc = tid % 24; float s = a.in[5][ch * 24 + cc];
#pragma unroll
                    for (int w = 0; w < 16; ++w) s += red[(w * 17 + r) * 24 + cc];
                    mod[(size_t)r * 6144 + ch * 24 + cc] = s; }
                __syncthreads();
            }
        }
        LAS float* scr = (LAS float*)(lds + wave * 16384);
        for (int it = gw; it < (DM / 64) * (DIN / 32); it += NGW) transpose_item<0>(a.in[8], DM, DIN, WTin, scr, it, lane);
    }
    SEAM(0);
#if USE_XBAR && GRP_SEAMS
    if (IN(0) && IN(1)) {
        if (tid0 == 0) bst[2] = (xb_ld((unsigned*)(ws + WS_CTL) + GB_MISMATCH) == 0u && bst[0] == 32u && bst[1] == 8u && G == 256) ? 1u : 0u;
        __syncthreads();
        grp_ok = bst[2] != 0u;
    }
#endif
    if (IN(1)) REPS(1) { PHASE_IDS;
        const bool full = G >= 256;
        unsigned* ctxcnt = (unsigned*)(ws + WS_CTL + 98304) + 64 * 8;
        constexpr int I_SQ = (DM / 64) * (DM / 32), I_GLU = (512 / 64) * (2048 / 32), I_UP = (DM / 64) * (NUP / 32), I_DN = (DFF / 64) * (DM / 32);
        constexpr int NITEMS = 2 * I_SQ + I_GLU + I_UP + I_DN, A_ITEMS = 1664;
#define COPY_ITEM(r_) do { int r = (r_); \
            if (r < I_SQ) { transpose_item<0>(a.in[11], DM, DM, WTbr, scr, r, lane); break; } r -= I_SQ; \
            if (r < I_GLU) { transpose_item<2>(a.in[20], 512, 2048, WTglu, scr, r, lane); break; } r -= I_GLU; \
            if (r < I_SQ) { transpose_item<0>(a.in[21], DM, DM, WTout, scr, r, lane); break; } r -= I_SQ; \
            if (r < I_UP) { transpose_item<1>(a.in[22], DM, NUP, WTup, scr, r, lane); break; } r -= I_UP; \
            transpose_item<0>(a.in[25], DFF, DM, WTdn, scr, r, lane); } while (0)
        if (full) {
            if (bx >= 192) {
                const int lane = opaque_tid(wave) & 63; const int r0 = ML + 64 * (bx - 192);
                for (int r = r0 + 4 * wave; r < r0 + 64; r += 4 * NWV) norm_mod_rows4(a.in[2] + (size_t)(r - ML) * DM, a.in[6], mod + (size_t)NB * 6144, mod + (size_t)NB * 6144 + 1024, H + (size_t)r * DM, lane);
                asm volatile("s_waitcnt vmcnt(0)" ::: "memory"); __syncthreads();
                if (threadIdx.x == 0) { __builtin_amdgcn_fence(__ATOMIC_RELEASE, "agent"); asm volatile("s_waitcnt vmcnt(0)" ::: "memory"); __hip_atomic_fetch_add(ctxcnt, 1u, __ATOMIC_RELAXED, __HIP_MEMORY_SCOPE_AGENT); }
            }
            if (bx < 64) {
                const int L = bx; const int lane = opaque_tid(wave) & 63; LAS float* scr = (LAS float*)(lds + wave * 16384);
                for (int it = bx * NWV + wave; it < A_ITEMS; it += 64 * NWV) COPY_ITEM(it);
                if (threadIdx.x < 64) { unsigned spins = 0;
                    while ((unsigned)__builtin_amdgcn_readfirstlane(__hip_atomic_load(ctxcnt, __ATOMIC_RELAXED, __HIP_MEMORY_SCOPE_AGENT)) < 64u) { __builtin_amdgcn_s_sleep(2); if (++spins > (1u << 22)) break; }
                    __builtin_amdgcn_fence(__ATOMIC_ACQUIRE, "agent"); asm volatile("s_waitcnt vmcnt(0)" ::: "memory"); }
                __syncthreads();
                pg8::Gemm g{H, WTin, DM, DM, DM, 0, 0, 0}; OrderOne S{{128 + (L >> 2), 4 + (L & 3), 0}}; EpiAfast E{Q, Kb, Vb, Ucat, SG, a.in[9], a.in[10], (LAS float*)(lds + 131072)};
                pg8::gemm_phase<EpiAfast, OrderOne>(lds, g, S, E, wave);
            }
            if (bx >= 64 && bx < 192) {
                const int ib = bx - 64; const int tid = opaque_tid(wave), lane = tid & 63;
                S5In s5{a.in[12], a.in[13], a.in[14], a.in[15], a.in[16], a.in[17], a.in[18], a.in[19]};
                __syncthreads();
                REPS(17) s5_tables_block(s5, ib >> 2, ib & 3, (bf16_t*)((char*)a.out + OUT_W1), (bf16_t*)((char*)a.out + OUT_B3), (float*)(ws + WS_A32), lds, tid);
                LAS float* scr = (LAS float*)(lds + wave * 16384);
                REPS(18) for (int it = A_ITEMS + ib * NWV + wave; it < NITEMS; it += 128 * NWV) COPY_ITEM(it);
            }
        } else {
            { const int tid = opaque_tid(wave), lane = tid & 63; S5In s5{a.in[12], a.in[13], a.in[14], a.in[15], a.in[16], a.in[17], a.in[18], a.in[19]};
              __syncthreads();
              for (int it = bx; it < 128; it += G) s5_tables_block(s5, it >> 2, it & 3, (bf16_t*)((char*)a.out + OUT_W1), (bf16_t*)((char*)a.out + OUT_B3), (float*)(ws + WS_A32), lds, tid);
              LAS float* scr = (LAS float*)(lds + wave * 16384);
              for (int it = bx * NWV + wave; it < NITEMS; it += G * NWV) COPY_ITEM(it); }
            for (int L = bx; L < 64; L += G) {
                const int r0 = ML + 256 * (L >> 2); const int lane = opaque_tid(wave) & 63;
                __syncthreads();
                for (int r = r0 + 4 * wave; r < r0 + 256; r += 4 * NWV) norm_mod_rows4(a.in[2] + (size_t)(r - ML) * DM, a.in[6], mod + (size_t)NB * 6144, mod + (size_t)NB * 6144 + 1024, H + (size_t)r * DM, lane);
                asm volatile("s_waitcnt vmcnt(0)" ::: "memory"); __syncthreads();
                pg8::Gemm g{H, WTin, DM, DM, DM, 0, 0, 0}; OrderOne S{{128 + (L >> 2), 4 + (L & 3), 0}}; EpiAfast E{Q, Kb, Vb, Ucat, SG, a.in[9], a.in[10], (LAS float*)(lds + 131072)};
                pg8::gemm_phase<EpiAfast, OrderOne>(lds, g, S, E, wave);
            }
        }
#undef COPY_ITEM
        { const int lane = opaque_tid(wave) & 63; const int xl = bx & 7; unsigned* head = (unsigned*)(ws + WS_CTL + 98304) + 64 * xl;
          for (;;) { unsigned c = 0; if (lane == 0) c = __hip_atomic_fetch_add(head, 1u, __ATOMIC_RELAXED, __HIP_MEMORY_SCOPE_AGENT); c = (unsigned)__builtin_amdgcn_readfirstlane((int)c);
              if (c >= 256u) break;
              const int r0 = xl * 4096 + (int)c * 16; const int mb = r0 / SEQ;
#pragma unroll 1
              for (int r = r0; r < r0 + 16; r += 4) norm_mod_rows4(a.in[0] + (size_t)r * DM, a.in[6], mod + (size_t)mb * 6144, mod + (size_t)mb * 6144 + 1024, H + (size_t)r * DM, lane); } }
    }
    SEAMGT(1, GB_TOPA);
    if (IN(2)) REPS(2) {
        pg8::Gemm g{H, WTin, DM, DM, DM, 0, 0, 0}; OrderRot S; S.so.init(ML / 256, DIN / 256, G, bx);
        EpiAfast E{Q, Kb, Vb, Ucat, SG, a.in[9], a.in[10], (LAS float*)(lds + 131072)};
        pg8::gemm_phase<EpiAfast, OrderRot>(lds, g, S, E, wave);
    }
    SEAMGT(2, GB_TOPB);
    const float* Lb = (const float*)((char*)a.out + OUT_L); const float* A32 = (const float*)(ws + WS_A32);
    unsigned* s1cnt = (unsigned*)(ws + WS_CTL) + 14464 + 64 * (bx & 7);
#define S5_RECUR(g, pm) do { const int bl = tid >> 7, d = (tid >> 6) & 1, n = tid & 63, b = pm * 4 + bl; \
              const float ar = A32[((d * NG + g) * NS + n) * 2], ai = A32[((d * NG + g) * NS + n) * 2 + 1]; \
              const float* Lg = Lb + (size_t)g * UROWS * 256; const int cre = sidx(d, 0, n), cim = cre + 64; bf16_t* Sg = Ucat + (size_t)g * UROWS * KCAT + 512 + sidx(d, 0, n); \
              float sr = 0.f, si = 0.f; \
              { float lr[8], li[8]; \
_Pragma("unroll") \
                for (int i = 0; i < 8; ++i) { const int row = 1024 + b * 8 + (d == 0 ? i : 7 - i); lr[i] = Lg[l_idx(row, cre)]; li[i] = Lg[l_idx(row, cim)]; } \
_Pragma("unroll") \
                for (int i = 0; i < 8; ++i) { const float t0 = ar * sr - ai * si + lr[i], t1 = ar * si + ai * sr + li[i]; sr = t0; si = t1; } } \
_Pragma("unroll 1") \
              for (int i0 = 0; i0 < 64; i0 += 32) { float lr[32], li[32]; \
_Pragma("unroll") \
                  for (int i = 0; i < 32; ++i) { const int row = b * 64 + (d == 0 ? i0 + i : 63 - i0 - i); lr[i] = Lg[l_idx(row, cre)]; li[i] = Lg[l_idx(row, cim)]; } \
_Pragma("unroll") \
                  for (int i = 0; i < 32; ++i) { const int row = b * 64 + (d == 0 ? i0 + i : 63 - i0 - i); \
                      Sg[(size_t)row * KCAT] = f2bf(sr); Sg[(size_t)row * KCAT + 64] = f2bf(si); \
                      const float t0 = ar * sr - ai * si + lr[i], t1 = ar * si + ai * sr + li[i]; sr = t0; si = t1; } } \
              asm volatile("s_waitcnt vmcnt(0)" ::: "memory"); __syncthreads(); } while (0)
    if (IN(4)) REPS(4) {
        if (grp_ok) top_wait((unsigned*)(ws + WS_CTL) + GB_TOPA);
        const int nrounds = (NB * 2 * 32 + G - 1) / G;
        for (int i = 0; i < nrounds; ++i) {
#if !S5_NAIVE
            if (i == (grp_ok ? 1 : 0)) {
                if (grp_ok && (bx >> 3) < 20) top_wait((unsigned*)(ws + WS_CTL) + GB_TOPB);
                pg8::Gemm g{Ucat, (const bf16_t*)((char*)a.out + OUT_W1), KCAT, 512, 512, (size_t)UROWS * KCAT * 2, (size_t)256 * 512 * 2, 0}; OrderS1 S{G, bx, grp_ok}; EpiS1 E{(float*)((char*)a.out + OUT_L)}; pg8::gemm_phase<EpiS1, OrderS1>(lds, g, S, E, wave);
                if (grp_ok && (bx >> 3) < 20 && tid0 == 0) (void)xb_add(s1cnt, 1u); }
#endif
            int unit; if (G == 256) { const int bk = grp_ok ? (2 * (bx & 7) + (i >> 1)) * 2 + (i & 1) : i * 8 + (bx & 7), s = bx >> 3; unit = bk * 32 + s; } else unit = i * G + bx;
            if (unit >= NB * 2 * 32) break;
            const int bk = unit >> 5, s = unit & 31, b = bk >> 1, kvh = bk & 1, h = kvh * 4 + (s >> 3), qb = s & 7;
            const size_t q0 = ((size_t)b * SEQ + (size_t)qb * 256) * 1024 + h * 128, k0 = (size_t)b * LKV * 256 + kvh * 128;
            att::attn_dense_body(Q + q0, Kb + k0, Vb + k0, O, LKV, (char*)lds_raw, wave, b * 8 + qb, h);
        }
#if !S5_NAIVE
        if (grp_ok && (bx >> 3) >= 20) {
            const int tid = opaque_tid(wave);
            if (tid0 < 64) { unsigned spins = 0;
                while ((unsigned)__builtin_amdgcn_readfirstlane(xb_ld(s1cnt)) < 20u) { __builtin_amdgcn_s_sleep(2); if (++spins > (1u << 22)) break; }
                __builtin_amdgcn_fence(__ATOMIC_ACQUIRE, "agent"); asm volatile("s_waitcnt vmcnt(0)" ::: "memory"); }
            __syncthreads();
            for (int it = (bx >> 3) - 20; it < 16; it += 12) { const int g = (bx & 7) + 8 * (it >> 2), pm = it & 3; S5_RECUR(g, pm); }
        }
#endif
    }
    SEAMG(4);
    if (IN(5)) REPS(5) { PHASE_IDS;
#if S5_NAIVE
        S5In s5{a.in[12], a.in[13], a.in[14], a.in[15], a.in[16], a.in[17], a.in[18], a.in[19]};
        for (int it = bx * 2 + wave; wave < 2 && it < NB * NG; it += G * 2) s5_naive_wave(s5, Ucat, Uctx, Ytmp, SSM, lane, it & 31, it >> 5);
#else
        for (int un = bx; un < 256; un += G) {
            const int g = grp_ok ? (un & 7) + 8 * (un >> 6) : un >> 3, pm = grp_ok ? (un >> 4) & 3 : (un >> 1) & 3, pn = grp_ok ? (un >> 3) & 1 : un & 1;
            if (!grp_ok) S5_RECUR(g, pm);
            pg8::Gemm gm{Ucat, (const bf16_t*)((char*)a.out + OUT_B3), KCAT, KCAT, KCAT, (size_t)UROWS * KCAT * 2, (size_t)512 * KCAT * 2, 0}; OrderOne S{{pm, pn, g}}; EpiS3 E{SSM};
            REPS(20) pg8::gemm_phase<EpiS3, OrderOne>(lds, gm, S, E, wave);
        }
#endif
    }
    SEAM(5);
#undef S5_RECUR
    if (IN(6)) REPS(6) { pg8::Gemm g{SSM, WTglu, 512, 512, 512, 0, 0, 1}; OrderRect S; S.so.init(ML / 256, 2048 / 256, G, bx); EpiGluPair E{SG, GLU}; pg8::gemm_phase<EpiGluPair, OrderRect>(lds, g, S, E, wave); }
    SEAMT(6);
    if (IN(7)) REPS(7) { pg8::Gemm g{O, WTbr, DM, DM, DM, 0, 0, 4}; OrderRect S; S.so.init(ML / 256, DM / 256, G, bx); EpiMergeFast E{SG, GLU, MG}; pg8::gemm_phase<EpiMergeFast, OrderRect>(lds, g, S, E, wave); }
    SEAMT(7);
    if (IN(8)) REPS(8) {
#if STAGGER8_US > 0
        if ((bx & 7) >= 4) { const unsigned long long t0 = __builtin_amdgcn_s_memrealtime(); while (__builtin_amdgcn_s_memrealtime() - t0 < (unsigned long long)(STAGGER8_US * 100)) __builtin_amdgcn_s_sleep(32); }
#endif
        pg8::Gemm g{MG, WTout, DM, DM, DM, 0, 0, 5}; OrderRect S; S.so.init(ML / 256, DM / 256, G, bx); EpiResNorm<1> E{a.in[0], out, mod + 2048, a.in[7], (unsigned*)(ws + WS_XS2), (unsigned*)(ws + WS_CTL + 65536), (LAS float*)(lds + 131072), H2, mod + 3072, mod + 4096, (bf16_t*)(ws + WS_X1B)}; pg8::gemm_phase<EpiResNorm<1>, OrderRect>(lds, g, S, E, wave); }
    SEAMT(8);
    if (IN(10)) REPS(10) { pg8::Gemm g{H2, WTup, DM, DM, DM, 0, 0, 4}; OrderRect S; S.so.init(ML / 256, NUP / 256, G, bx);
        EpiUpConv E{Ab, (float*)(ws + WS_HALO), a.in[23], a.in[24], (LAS float*)(lds + 131072), (LAS float*)(lds + 131072 + 8192)}; pg8::gemm_phase<EpiUpConv, OrderRect>(lds, g, S, E, wave); }
    SEAMG(10);
    if (IN(14)) { PHASE_IDS; pg8::Gemm g{Ab, WTdn, DFF, DFF, DFF, 0, 0, 3}; OrderRect S; S.so.init(ML / 256, DM / 256, G, bx);
        { pg8::Unit u; for (int i = 0; S.next(i, u); ++i) conv_fix_panel(u.pm, (const float*)(ws + WS_HALO), a.in[23], Ab, tid); asm volatile("s_waitcnt vmcnt(0)" ::: "memory"); __syncthreads(); }
        EpiResNorm<0> E{out, out, mod + 5120, a.in[26], (unsigned*)(ws + WS_XS), (unsigned*)(ws + WS_CTL + 16384), (LAS float*)(lds + 131072), nullptr, nullptr, nullptr, (bf16_t*)(ws + WS_X1B)}; pg8::gemm_phase<EpiResNorm<0>, OrderRect>(lds, g, S, E, wave); }
#undef IN
#undef SEAM
#undef SEAMG
#undef SEAMGT
#undef SEAMT
#undef mod
#undef WTin
#undef WTbr
#undef WTglu
#undef WTout
#undef WTup
#undef WTdn
#undef H
#undef Q
#undef Kb
#undef Vb
#undef Ucat
#undef Uctx
#undef SG
#undef O
#undef SSM
#undef GLU
#undef MG
#undef H2
#undef Ab
#undef Ytmp
}

extern "C" void kernel_launch(void* const* d_in, const int* in_sizes, int n_in, void* d_out, int out_size, void* d_ws, size_t ws_size, hipStream_t stream) {
    static int grid_blocks = 0;
    if (grid_blocks == 0) {
        if (n_in != 27 || in_sizes[0] != ML * DM || out_size != ML * DM || ws_size < WS_NEED) {
            fprintf(stderr, "kernel_launch: unexpected shapes: n_in %d in0 %d out %d ws %zu (need >= %zu)\n", n_in, n_in > 0 ? in_sizes[0] : -1, out_size, ws_size, (size_t)WS_NEED); grid_blocks = -1; return; }
        int dev = 0, cus = 0, per_cu = 0;
        if (hipGetDevice(&dev) != hipSuccess || hipDeviceGetAttribute(&cus, hipDeviceAttributeMultiprocessorCount, dev) != hipSuccess) { fprintf(stderr, "kernel_launch: device query failed\n"); grid_blocks = -1; return; }
        if (hipFuncSetAttribute((const void*)mk_fwd, hipFuncAttributeMaxDynamicSharedMemorySize, MK_LDS) != hipSuccess) { fprintf(stderr, "kernel_launch: hipFuncSetAttribute(mk_fwd) failed\n"); grid_blocks = -1; return; }
        if (hipOccupancyMaxActiveBlocksPerMultiprocessor(&per_cu, (const void*)mk_fwd, NWV * 64, MK_LDS) != hipSuccess || per_cu < 1) { fprintf(stderr, "kernel_launch: occupancy query says %d blocks/CU\n", per_cu); grid_blocks = -1; return; }
        grid_blocks = cus;
    }
    if (grid_blocks < 0) return;
    if (hipMemsetAsync((char*)d_ws + WS_CTL, 0, 131072, stream) != hipSuccess) fprintf(stderr, "kernel_launch: memset failed\n");
    MkArgs a{};
    for (int i = 0; i < 27; ++i) a.in[i] = (const float*)d_in[i];
    a.out = (float*)d_out; a.ws = (unsigned char*)d_ws; a.ph_lo = 0; a.ph_hi = 16;
    void* args[] = {&a};
    hipError_t e = hipLaunchCooperativeKernel((const void*)mk_fwd, dim3(grid_blocks), dim3(NWV * 64), args, MK_LDS, stream);
    if (e != hipSuccess) fprintf(stderr, "kernel_launch: cooperative launch failed: %s (grid %d)\n", hipGetErrorString(e), grid_blocks);
}
```

```cpp
#include <hip/hip_runtime.h>
#include <cstdio>
#include <cstdint>

typedef unsigned short bf16_t;
typedef short bf16x8 __attribute__((ext_vector_type(8)));
typedef short s16x4 __attribute__((ext_vector_type(4)));
typedef float f32x4 __attribute__((ext_vector_type(4)));
typedef float f32x16 __attribute__((ext_vector_type(16)));
typedef unsigned u32x4 __attribute__((ext_vector_type(4)));
typedef unsigned u32x2 __attribute__((ext_vector_type(2)));
typedef float f32x2 __attribute__((ext_vector_type(2)));

constexpr int NB = 16, SEQ = 2048, DM = 1024, LC = 256, LKV = LC + SEQ;
constexpr int ML = NB * SEQ, MC = NB * LC, MT = ML + MC;
constexpr int DIN = 4096, DFF = 2816, NUP = 2 * DFF;
constexpr int NG = 32, NS = 64, PG = 16;
constexpr int TCH = 32, NCH = SEQ / TCH, KCAT = TCH * PG + 256;
constexpr int UROWS = 1280;
constexpr float EPS = 1e-6f;

constexpr size_t MiB = 1u << 20;
constexpr size_t WS_CTL = 0, WS_MOD = 1 * MiB;
constexpr size_t WS_WIN = 16 * MiB, WS_WBR = 24 * MiB, WS_WGLU = 26 * MiB, WS_WOUT = 28 * MiB, WS_WUP = 30 * MiB, WS_WDN = 41 * MiB;
constexpr size_t WS_H = 48 * MiB;
constexpr size_t WS_Q = 120 * MiB;
constexpr size_t WS_K = 184 * MiB;
constexpr size_t WS_V = 202 * MiB;
constexpr size_t WS_UCAT = 220 * MiB;
constexpr size_t WS_SG = 280 * MiB;
constexpr size_t WS_O = 408 * MiB;
constexpr size_t WS_SSM = 472 * MiB;
constexpr size_t WS_A32 = 2 * MiB;
constexpr size_t OUT_W1 = 0, OUT_B3 = 8 * MiB, OUT_L = 32 * MiB;
constexpr size_t WS_YTMP = 48 * MiB;
constexpr size_t WS_GLU = 48 * MiB;
constexpr size_t WS_H2 = 48 * MiB;
constexpr size_t WS_A = 112 * MiB;
constexpr size_t WS_HALO = 368 * MiB;
constexpr size_t WS_XS = 380 * MiB;
constexpr size_t WS_XS2 = 381 * MiB;
constexpr size_t WS_X1B = 280 * MiB;
constexpr int A_SPLIT_PM = 122; constexpr size_t A_HI_SHIFT = 384 * MiB - (112 * MiB + (size_t)A_SPLIT_PM * 44 * 32768);
constexpr size_t WS_NEED = 512 * MiB;

__device__ __forceinline__ int opaque_tid(int wave) { int t = wave * 64 + (int)__builtin_amdgcn_mbcnt_hi(~0u, __builtin_amdgcn_mbcnt_lo(~0u, 0u)); asm volatile("" : "+v"(t)); return t; }
__device__ __forceinline__ float bf2f(bf16_t v) { return __uint_as_float(((unsigned)v) << 16); }
typedef __bf16 bf16v2_t __attribute__((ext_vector_type(2)));
__device__ __forceinline__ unsigned pk2(float lo, float hi) { const f32x2 v = {lo, hi}; return __builtin_bit_cast(unsigned, __builtin_convertvector(v, bf16v2_t)); }
__device__ __forceinline__ bf16_t f2bf(float f) { return (bf16_t)(pk2(f, f) & 0xffffu); }
__device__ __forceinline__ float sigmoidf_(float x) { return __builtin_amdgcn_rcpf(1.f + __expf(-x)); }
__device__ __forceinline__ float siluf_(float x) { return x * __builtin_amdgcn_rcpf(1.f + __expf(-x)); }
__device__ __forceinline__ float gelu_tanh(float x) { const float u = 0.7978845608028654f * (x + 0.044715f * x * x * x); return x * __builtin_amdgcn_rcpf(1.f + __expf(-2.f * u)); }
__device__ __forceinline__ float wave_sum(float v) {
#pragma unroll
    for (int o = 1; o < 64; o <<= 1) v += __shfl_xor(v, o);
    return v;
}
__device__ __forceinline__ size_t ucat_idx(int b, int t, int ch) { const int g = ch >> 4, q = ch & 15, c = t >> 5, j = t & 31; return ((size_t)(g * UROWS + b * NCH + c)) * KCAT + j * PG + q; }
__device__ __forceinline__ size_t ucat_ctx_idx(int b, int tc, int ch) { const int g = ch >> 4, q = ch & 15, c = tc >> 5, j = tc & 31; return ((size_t)(g * UROWS + 1024 + b * 8 + c)) * KCAT + j * PG + q; }

__device__ __forceinline__ void qk_norm_rope_row(bf16_t* p, const float* __restrict__ w, int pos, int lane) {
    const unsigned raw = *(const unsigned*)(p + 2 * lane);
    const float v0 = bf2f((bf16_t)(raw & 0xffff)), v1 = bf2f((bf16_t)(raw >> 16));
    const float rs = rsqrtf(wave_sum(v0 * v0 + v1 * v1) * (1.f / 128.f) + EPS);
    float y0 = v0 * rs * w[2 * lane], y1 = v1 * rs * w[2 * lane + 1];
    if (pos >= 0) {
        const float coord = (lane < 32) ? (float)(pos >> 6) : (float)(pos & 63);
        const float invf = exp2f(-(float)(2 * (lane & 31)) * (13.287712379549449f / 64.f));
        const float ang = coord * invf; const float cs = cosf(ang), sn = sinf(ang);
        const float o0 = y0 * cs - y1 * sn, o1 = y0 * sn + y1 * cs; y0 = o0; y1 = o1;
    }
    *(unsigned*)(p + 2 * lane) = (unsigned)f2bf(y0) | ((unsigned)f2bf(y1) << 16);
}
__device__ __forceinline__ size_t blk16x32(int pm, int KT, int kt, int half, int rb8, int kb2) { return ((((((size_t)pm * KT + kt) * 2 + half) * 8 + rb8) * 2 + kb2)) * 1024; }
namespace att {
constexpr int D = 128, NW = 8, QBLK = 32, KVBLK = 64;
constexpr float SCALE = 0.088388347648318440f;
constexpr float THR = 8.f;
#ifndef ATT_SDEPTH
#define ATT_SDEPTH 2
#endif
constexpr int LDQ = 1024, LDK = 256, LDO = 1024;
constexpr size_t SHM_V = KVBLK * D * 2, SHM_K = KVBLK * D * 2, SHM_ATTN = 2 * SHM_V + 2 * SHM_K + NW * 64 * 4;
#define KSWZ(row, colB) ((row) * 256 + ((colB) ^ (((row) & 7) << 4)))
#define SBAR() __builtin_amdgcn_sched_barrier(0)
__device__ __forceinline__ int crow(int r, int hi) { return (r & 3) + 8 * (r >> 2) + 4 * hi; }
__device__ __forceinline__ unsigned cvtpk(float lo, float hi) { unsigned r; asm volatile("v_cvt_pk_bf16_f32 %0, %1, %2" : "=v"(r) : "v"(lo), "v"(hi)); return r; }
__device__ __forceinline__ void partialSM(f32x16& p0, f32x16& p1, float& m_reg, float& mn, float& alpha) {
    constexpr float C = SCALE * 1.4426950408889634f;
    float pmax = p0[0]; for (int r = 1; r < 16; ++r) pmax = fmaxf(pmax, p0[r]); for (int r = 0; r < 16; ++r) pmax = fmaxf(pmax, p1[r]);
    { auto rr = __builtin_amdgcn_permlane32_swap(__float_as_uint(pmax), __float_as_uint(pmax), false, false);
      pmax = fmaxf(__uint_as_float(rr[0]), __uint_as_float(rr[1])); }
    if (__builtin_expect(__all(pmax - m_reg <= THR / SCALE), 1)) { mn = m_reg; alpha = 1.f; }
    else { mn = fmaxf(m_reg, pmax); alpha = __builtin_amdgcn_exp2f((m_reg - mn) * C); m_reg = mn; }
    float mnC = -mn * C;
    for (int r = 0; r < 16; ++r) p0[r] = fmaf(p0[r], C, mnC); for (int r = 0; r < 16; ++r) p1[r] = fmaf(p1[r], C, mnC);
    for (int r = 0; r < 16; ++r) p0[r] = __builtin_amdgcn_exp2f(p0[r]);
}
__device__ __forceinline__ void finishSM(f32x16& p0, f32x16& p1, float alpha, float& l_reg, bf16x8& pa0, bf16x8& pa1, bf16x8& pa2, bf16x8& pa3) {
    for (int r = 0; r < 16; ++r) p1[r] = __builtin_amdgcn_exp2f(p1[r]);
    float ps = 0; for (int r = 0; r < 16; ++r) ps += p0[r]; for (int r = 0; r < 16; ++r) ps += p1[r];
    { auto rr = __builtin_amdgcn_permlane32_swap(__float_as_uint(ps), __float_as_uint(ps), false, false);
      ps = __uint_as_float(rr[0]) + __uint_as_float(rr[1]); }
    l_reg = l_reg * alpha + ps;
#define PK4(P, BASE, OUT) do { unsigned a0 = cvtpk(P[BASE + 0], P[BASE + 1]), a1 = cvtpk(P[BASE + 2], P[BASE + 3]);   \
    unsigned b0 = cvtpk(P[BASE + 4], P[BASE + 5]), b1 = cvtpk(P[BASE + 6], P[BASE + 7]);                              \
    auto r0 = __builtin_amdgcn_permlane32_swap(a0, b0, false, false); auto r1 = __builtin_amdgcn_permlane32_swap(a1, b1, false, false); \
    u32x4 w = {r0[0], r1[0], r0[1], r1[1]}; OUT = *reinterpret_cast<bf16x8*>(&w); } while (0)
    PK4(p0, 0, pa0); PK4(p0, 8, pa1); PK4(p1, 0, pa2); PK4(p1, 8, pa3);
#undef PK4
}
__device__ __forceinline__ void qkt(f32x16& p0, f32x16& p1, const bf16_t* Ks, const bf16x8* qr, int r32, int hi) {
    p0 = f32x16{}; p1 = f32x16{};
    for (int d0 = 0; d0 < 8; ++d0) { int cb = (d0 * 16 + hi * 8) * 2;
        bf16x8 b0 = *reinterpret_cast<const bf16x8*>((const char*)Ks + KSWZ(r32, cb));
        bf16x8 b1 = *reinterpret_cast<const bf16x8*>((const char*)Ks + KSWZ(32 + r32, cb));
        p0 = __builtin_amdgcn_mfma_f32_32x32x16_bf16(b0, qr[d0], p0, 0, 0, 0);
        p1 = __builtin_amdgcn_mfma_f32_32x32x16_bf16(b1, qr[d0], p1, 0, 0, 0); }
}
__device__ __forceinline__ int v_st(int k, int c) { const int kk = (k & ~0xC) | ((k & 4) << 1) | ((k & 8) >> 1); return ((kk >> 3) * 4 + (c >> 5)) * 512 + ((kk & 7) * 32 + (c & 31)) * 2; }
__device__ __forceinline__ int v_rd_base(int lane) { return ((lane & 3) << 3) | (((lane >> 2) & 3) << 6) | (((lane >> 4) & 1) << 5) | (((lane >> 5) & 1) << 8); }
constexpr int v_rd_off(int d0, int ks, int half) { return d0 * 512 + ks * 4096 + half * 2048; }
template <int OFF> __device__ __forceinline__ s16x4 tr_read(int vb) {
    s16x4 r; asm volatile("ds_read_b64_tr_b16 %0, %1 offset:%2" : "=&v"(r) : "v"(vb), "i"(OFF) : "memory"); return r;
}
template <int D0> __device__ __forceinline__ void pv_one(f32x16& od, int vb, bf16x8 pa0, bf16x8 pa1, bf16x8 pa2, bf16x8 pa3) {
    const s16x4 l0 = tr_read<v_rd_off(D0, 0, 0)>(vb), h0 = tr_read<v_rd_off(D0, 0, 1)>(vb), l1 = tr_read<v_rd_off(D0, 1, 0)>(vb), h1 = tr_read<v_rd_off(D0, 1, 1)>(vb);
    const s16x4 l2 = tr_read<v_rd_off(D0, 2, 0)>(vb), h2 = tr_read<v_rd_off(D0, 2, 1)>(vb), l3 = tr_read<v_rd_off(D0, 3, 0)>(vb), h3 = tr_read<v_rd_off(D0, 3, 1)>(vb);
    asm volatile("s_waitcnt lgkmcnt(0)" ::: "memory"); SBAR();
#define PK(L, H) (bf16x8){L[0], L[1], L[2], L[3], H[0], H[1], H[2], H[3]}
    od = __builtin_amdgcn_mfma_f32_32x32x16_bf16(pa0, PK(l0, h0), od, 0, 0, 0);
    od = __builtin_amdgcn_mfma_f32_32x32x16_bf16(pa1, PK(l1, h1), od, 0, 0, 0);
    od = __builtin_amdgcn_mfma_f32_32x32x16_bf16(pa2, PK(l2, h2), od, 0, 0, 0);
    od = __builtin_amdgcn_mfma_f32_32x32x16_bf16(pa3, PK(l3, h3), od, 0, 0, 0);
#undef PK
}
__device__ __forceinline__ void pv_d0(f32x16* o, int vb, bf16x8 pa0, bf16x8 pa1, bf16x8 pa2, bf16x8 pa3) {
    pv_one<0>(o[0], vb, pa0, pa1, pa2, pa3); pv_one<1>(o[1], vb, pa0, pa1, pa2, pa3); pv_one<2>(o[2], vb, pa0, pa1, pa2, pa3); pv_one<3>(o[3], vb, pa0, pa1, pa2, pa3);
}
__device__ __forceinline__ void qkt_fsm(f32x16& pn0, f32x16& pn1, const bf16_t* Ks, const bf16x8* qr, int r32, int hi, f32x16& pp0, f32x16& pp1, float alpha, float& l_reg, bf16x8& pa0, bf16x8& pa1, bf16x8& pa2, bf16x8& pa3) {
#define QF_READ(D0, B0, B1) const bf16x8 B0 = *reinterpret_cast<const bf16x8*>((const char*)Ks + KSWZ(r32, ((D0) * 16 + hi * 8) * 2)), B1 = *reinterpret_cast<const bf16x8*>((const char*)Ks + KSWZ(32 + r32, ((D0) * 16 + hi * 8) * 2))
#define QF_MMA(D0, B0, B1) do { pn0 = __builtin_amdgcn_mfma_f32_32x32x16_bf16(B0, qr[D0], pn0, 0, 0, 0); pn1 = __builtin_amdgcn_mfma_f32_32x32x16_bf16(B1, qr[D0], pn1, 0, 0, 0); } while (0)
    pn0 = f32x16{}; pn1 = f32x16{};
    QF_READ(0, k00, k01); QF_READ(1, k10, k11);
    QF_MMA(0, k00, k01); QF_READ(2, k20, k21);
#pragma unroll
    for (int r = 0; r < 4; ++r) pp1[r] = __builtin_amdgcn_exp2f(pp1[r]);
    asm volatile("" : "+v"(pp1)); SBAR();
    QF_MMA(1, k10, k11); QF_READ(3, k30, k31);
#pragma unroll
    for (int r = 4; r < 8; ++r) pp1[r] = __builtin_amdgcn_exp2f(pp1[r]);
    asm volatile("" : "+v"(pp1)); SBAR();
    QF_MMA(2, k20, k21); QF_READ(4, k40, k41);
#pragma unroll
    for (int r = 8; r < 12; ++r) pp1[r] = __builtin_amdgcn_exp2f(pp1[r]);
    asm volatile("" : "+v"(pp1)); SBAR();
    QF_MMA(3, k30, k31); QF_READ(5, k50, k51);
#pragma unroll
    for (int r = 12; r < 16; ++r) pp1[r] = __builtin_amdgcn_exp2f(pp1[r]);
    asm volatile("" : "+v"(pp1)); SBAR();
    QF_MMA(4, k40, k41); QF_READ(6, k60, k61);
    float ps = 0;
#pragma unroll
    for (int r = 0; r < 16; ++r) ps += pp0[r];
    asm volatile("" : "+v"(ps)); SBAR();
    QF_MMA(5, k50, k51); QF_READ(7, k70, k71);
#pragma unroll
    for (int r = 0; r < 16; ++r) ps += pp1[r];
    { auto rr = __builtin_amdgcn_permlane32_swap(__float_as_uint(ps), __float_as_uint(ps), false, false);
      ps = __uint_as_float(rr[0]) + __uint_as_float(rr[1]);
      l_reg = l_reg * alpha + ps; }
    asm volatile("" : "+v"(l_reg)); SBAR();
#define PK4(P, BASE, OUT) do { unsigned a0 = cvtpk(P[BASE + 0], P[BASE + 1]), a1 = cvtpk(P[BASE + 2], P[BASE + 3]);   \
    unsigned b0 = cvtpk(P[BASE + 4], P[BASE + 5]), b1 = cvtpk(P[BASE + 6], P[BASE + 7]);                              \
    auto r0 = __builtin_amdgcn_permlane32_swap(a0, b0, false, false); auto r1 = __builtin_amdgcn_permlane32_swap(a1, b1, false, false); \
    u32x4 w = {r0[0], r1[0], r0[1], r1[1]}; OUT = *reinterpret_cast<bf16x8*>(&w); } while (0)
    QF_MMA(6, k60, k61);
    PK4(pp0, 0, pa0); PK4(pp0, 8, pa1);
    asm volatile("" : "+v"(pa0), "+v"(pa1)); SBAR();
    QF_MMA(7, k70, k71);
    PK4(pp1, 0, pa2); PK4(pp1, 8, pa3);
#undef PK4
    asm volatile("" : "+v"(pa2), "+v"(pa3));
#undef QF_READ
#undef QF_MMA
}
__device__ __forceinline__ void pv_sm(f32x16* o, int vb, bf16x8 pa0, bf16x8 pa1, bf16x8 pa2, bf16x8 pa3, f32x16& p0, f32x16& p1, float& m_reg, float& mn, float& alpha) {
    constexpr float C = SCALE * 1.4426950408889634f;
#define PVS_READ(D0, L0, H0, L1, H1, L2, H2, L3, H3) const s16x4 L0 = tr_read<v_rd_off(D0, 0, 0)>(vb), H0 = tr_read<v_rd_off(D0, 0, 1)>(vb), L1 = tr_read<v_rd_off(D0, 1, 0)>(vb), H1 = tr_read<v_rd_off(D0, 1, 1)>(vb), \
        L2 = tr_read<v_rd_off(D0, 2, 0)>(vb), H2 = tr_read<v_rd_off(D0, 2, 1)>(vb), L3 = tr_read<v_rd_off(D0, 3, 0)>(vb), H3 = tr_read<v_rd_off(D0, 3, 1)>(vb)
#define PVS_PK(L, H) (bf16x8){L[0], L[1], L[2], L[3], H[0], H[1], H[2], H[3]}
#define PVS_MMA(D0, L0, H0, L1, H1, L2, H2, L3, H3) do { o[D0] = __builtin_amdgcn_mfma_f32_32x32x16_bf16(pa0, PVS_PK(L0, H0), o[D0], 0, 0, 0); o[D0] = __builtin_amdgcn_mfma_f32_32x32x16_bf16(pa1, PVS_PK(L1, H1), o[D0], 0, 0, 0); \
        o[D0] = __builtin_amdgcn_mfma_f32_32x32x16_bf16(pa2, PVS_PK(L2, H2), o[D0], 0, 0, 0); o[D0] = __builtin_amdgcn_mfma_f32_32x32x16_bf16(pa3, PVS_PK(L3, H3), o[D0], 0, 0, 0); } while (0)
#define PVS_GO() do { asm volatile("s_waitcnt lgkmcnt(0)" ::: "memory"); SBAR(); } while (0)
    PVS_READ(0, a0, b0, a1, b1, a2, b2, a3, b3); PVS_GO();
    PVS_MMA(0, a0, b0, a1, b1, a2, b2, a3, b3);
    float pmax = p0[0];
#pragma unroll
    for (int r = 1; r < 16; ++r) pmax = fmaxf(pmax, p0[r]);
    PVS_READ(1, c0, d0, c1, d1, c2, d2, c3, d3); asm volatile("" : "+v"(pmax)); PVS_GO();
    PVS_MMA(1, c0, d0, c1, d1, c2, d2, c3, d3);
#pragma unroll
    for (int r = 0; r < 16; ++r) pmax = fmaxf(pmax, p1[r]);
    { auto rr = __builtin_amdgcn_permlane32_swap(__float_as_uint(pmax), __float_as_uint(pmax), false, false);
      pmax = fmaxf(__uint_as_float(rr[0]), __uint_as_float(rr[1])); }
    { const bool keep = __all(pmax - m_reg <= THR / SCALE);
      const float mx = fmaxf(m_reg, pmax);
      mn = keep ? m_reg : mx; alpha = keep ? 1.f : __builtin_amdgcn_exp2f((m_reg - mx) * C); m_reg = mn; }
    float mnC = -mn * C;
    PVS_READ(2, e0, f0, e1, f1, e2, f2, e3, f3); asm volatile("" : "+v"(mnC), "+v"(alpha)); PVS_GO();
    PVS_MMA(2, e0, f0, e1, f1, e2, f2, e3, f3);
#pragma unroll
    for (int r = 0; r < 16; ++r) p0[r] = fmaf(p0[r], C, mnC);
#pragma unroll
    for (int r = 0; r < 8; ++r) p0[r] = __builtin_amdgcn_exp2f(p0[r]);
    PVS_READ(3, g0, h0, g1, h1, g2, h2, g3, h3); asm volatile("" : "+v"(p0)); PVS_GO();
    PVS_MMA(3, g0, h0, g1, h1, g2, h2, g3, h3);
#pragma unroll
    for (int r = 0; r < 16; ++r) p1[r] = fmaf(p1[r], C, mnC);
#pragma unroll
    for (int r = 8; r < 16; ++r) p0[r] = __builtin_amdgcn_exp2f(p0[r]);
    asm volatile("" : "+v"(p0), "+v"(p1));
#undef PVS_READ
#undef PVS_PK
#undef PVS_MMA
#undef PVS_GO
}
__device__ __forceinline__ void attn_dense_body(const bf16_t* __restrict__ Qb, const bf16_t* __restrict__ Kh, const bf16_t* __restrict__ Vh, bf16_t* __restrict__ Ob, int seq, char* lds, int wave_id, int o_pm, int o_h) {
    const int tid = opaque_tid(wave_id), wid = tid >> 6, lane = tid & 63, r32 = lane & 31, hi = lane >> 5;
    bf16_t* V_lds = (bf16_t*)lds; bf16_t* K_lds = (bf16_t*)(lds + 2 * SHM_V);
    float* ws = (float*)(lds + 2 * SHM_V + 2 * SHM_K) + wid * 64; float* li_l = ws; float* al_l = ws + 32;
    float m_reg = -1e30f, l_reg = 0; f32x16 o[4] = {}; bf16x8 qr[8];
    const bf16_t* Qw = Qb + (long)(wid * QBLK + r32) * LDQ + hi * 8;
#pragma unroll
    for (int d0 = 0; d0 < 8; ++d0) qr[d0] = *reinterpret_cast<const bf16x8*>(Qw + d0 * 16);
    const int sr = tid >> 4, sc = (tid & 15) * 8, vst0 = v_st(sr, sc), vst1 = v_st(32 + sr, sc);
    const int vb0 = (int)(uintptr_t)V_lds + v_rd_base(lane);
    constexpr int SDEPTH = ATT_SDEPTH;
    struct { bf16x8 vs0, vs1, ks0, ks1; } sr_[SDEPTH];
    typedef const __attribute__((address_space(1))) char* gcp;
    gcp Vu, Ku;
    { const unsigned long long v_ = (unsigned long long)Vh, k_ = (unsigned long long)Kh;
      Vu = (gcp)(((unsigned long long)(unsigned)__builtin_amdgcn_readfirstlane((unsigned)(v_ >> 32)) << 32) | (unsigned)__builtin_amdgcn_readfirstlane((unsigned)v_));
      Ku = (gcp)(((unsigned long long)(unsigned)__builtin_amdgcn_readfirstlane((unsigned)(k_ >> 32)) << 32) | (unsigned)__builtin_amdgcn_readfirstlane((unsigned)k_)); }
    const unsigned vofs = (unsigned)(sr * LDK + sc) * 2u;
    typedef const __attribute__((address_space(1))) bf16x8* gv8p;
#define SLOAD(i, k0) do { gcp vb_ = Vu + (size_t)(k0) * (LDK * 2); gcp kb_ = Ku + (size_t)(k0) * (LDK * 2); \
    sr_[i].vs0 = *(gv8p)(vb_ + vofs); sr_[i].vs1 = *(gv8p)(vb_ + 32 * LDK * 2 + vofs); \
    sr_[i].ks0 = *(gv8p)(kb_ + vofs); sr_[i].ks1 = *(gv8p)(kb_ + 32 * LDK * 2 + vofs); } while (0)
#define SWRITE(b, i) do { *(bf16x8*)((char*)V_lds + (b) * SHM_V + vst0) = sr_[i].vs0;          \
    *(bf16x8*)((char*)V_lds + (b) * SHM_V + vst1) = sr_[i].vs1; int kc = sc * 2;               \
    *(bf16x8*)((char*)K_lds + (b) * SHM_K + KSWZ(sr, kc)) = sr_[i].ks0;                       \
    *(bf16x8*)((char*)K_lds + (b) * SHM_K + KSWZ(32 + sr, kc)) = sr_[i].ks1; } while (0)
#define SWAIT() do { if constexpr (SDEPTH == 2) asm volatile("s_waitcnt vmcnt(4)" ::: "memory"); else asm volatile("s_waitcnt vmcnt(0)" ::: "memory"); } while (0)
#define RESC(a) do { if (__any((a) < 1.f)) { if (hi == 0) al_l[r32] = (a); asm volatile("s_waitcnt lgkmcnt(0)" ::: "memory"); \
    for (int d = 0; d < 4; ++d) for (int r = 0; r < 16; ++r) o[d][r] *= al_l[crow(r, hi)]; } } while (0)
    f32x16 pA0, pA1, pB0, pB1; float mnA, mnB, alA, alB; bf16x8 pa0, pa1, pa2, pa3; const int NT = seq / KVBLK;
    constexpr int SE = 0, SO = SDEPTH - 1;
    SLOAD(SE, 0); asm volatile("s_waitcnt vmcnt(0)" ::: "memory"); SWRITE(0, SE); __syncthreads();
    qkt(pA0, pA1, K_lds, qr, r32, hi); partialSM(pA0, pA1, m_reg, mnA, alA);
    SLOAD(SO, KVBLK); if constexpr (SDEPTH == 2) { if (2 < NT) SLOAD(SE, 2 * KVBLK); }
    SWAIT(); SWRITE(1, SO); __syncthreads();
    for (int j = 1; j + 1 < NT; j += 2) {
        SBAR(); qkt_fsm(pB0, pB1, (bf16_t*)((char*)K_lds + SHM_K), qr, r32, hi, pA0, pA1, alA, l_reg, pa0, pa1, pa2, pa3); SBAR();
        SLOAD(SO, (j + SDEPTH) * KVBLK); SBAR();
        pv_sm(o, vb0, pa0, pa1, pa2, pa3, pB0, pB1, m_reg, mnB, alB);
        __syncthreads(); SWAIT(); SWRITE(0, SE);
        RESC(alB); __syncthreads();
        SBAR(); qkt_fsm(pA0, pA1, K_lds, qr, r32, hi, pB0, pB1, alB, l_reg, pa0, pa1, pa2, pa3); SBAR();
        if (SDEPTH == 1 || j + 3 < NT) SLOAD(SE, (j + 1 + SDEPTH) * KVBLK); SBAR();
        pv_sm(o, vb0 + (int)SHM_V, pa0, pa1, pa2, pa3, pA0, pA1, m_reg, mnA, alA);
        __syncthreads(); SWAIT(); SWRITE(1, SO);
        RESC(alA); __syncthreads();
    }
    SBAR(); qkt(pB0, pB1, (bf16_t*)((char*)K_lds + SHM_K), qr, r32, hi);
    finishSM(pA0, pA1, alA, l_reg, pa0, pa1, pa2, pa3); SBAR();
    pv_sm(o, vb0, pa0, pa1, pa2, pa3, pB0, pB1, m_reg, mnB, alB);
    __syncthreads(); RESC(alB);
    finishSM(pB0, pB1, alB, l_reg, pa0, pa1, pa2, pa3); SBAR();
    pv_d0(o, vb0 + (int)SHM_V, pa0, pa1, pa2, pa3);
    { const int tid2 = opaque_tid(wave_id), lane2 = tid2 & 63, r32b = lane2 & 31, hib = lane2 >> 5;
      float* li2 = (float*)(lds + 2 * SHM_V + 2 * SHM_K) + wave_id * 64;
      if (hib == 0) li2[r32b] = l_reg; asm volatile("s_waitcnt lgkmcnt(0)" ::: "memory");
      float rli[16];
#pragma unroll
      for (int r = 0; r < 16; ++r) rli[r] = __builtin_amdgcn_rcpf(li2[crow(r, hib)]);
      __syncthreads();
      bf16_t* ost = (bf16_t*)(lds + wave_id * 8704);
#pragma unroll
      for (int r = 0; r < 16; ++r) { const int orow = crow(r, hib);
#pragma unroll
          for (int d0 = 0; d0 < 4; ++d0) ost[orow * 136 + d0 * 32 + r32b] = f2bf(o[d0][r] * rli[r]); }
      asm volatile("s_waitcnt lgkmcnt(0)" ::: "memory");
#pragma unroll
      for (int i = 0; i < 8; ++i) { const int rb = i >> 2, cb = i & 3, rr = lane2 >> 2, c8 = (lane2 & 3) * 8;
          *(u32x4*)((char*)Ob + blk16x32(o_pm, 16, o_h * 2 + (cb >> 1), wave_id >> 2, (wave_id & 3) * 2 + rb, cb & 1) + (rr * 32 + c8) * 2) = *(const u32x4*)(ost + (rb * 16 + rr) * 136 + cb * 32 + c8); } }
    __syncthreads();
#undef SLOAD
#undef SWRITE
#undef SWAIT
#undef RESC
}
}

struct S5In { const float *lre, *lim, *ldt, *bre, *bim, *cre, *cim, *dsk; };
__device__ __forceinline__ void s5_naive_wave(const S5In& P, const bf16_t* __restrict__ Ucat, const bf16_t* __restrict__ Uctx, float* __restrict__ Ytmp, bf16_t* __restrict__ SSM, int n, int g, int b) {
    const float dskip = P.dsk[g * PG + (n & 15)];
    for (int dir = 0; dir < 2; ++dir) {
        const int dg = dir * NG + g;
        const float dt = expf(P.ldt[dg]), lr = P.lre[dg * NS + n], li = P.lim[dg * NS + n];
        const float mag = expf(lr * dt), ang = li * dt, are = mag * cosf(ang), aim = mag * sinf(ang);
        const float den = lr * lr + li * li, nr = are - 1.f, ni = aim, fre = (nr * lr + ni * li) / den, fim = (ni * lr - nr * li) / den;
        float bbr[PG], bbi[PG], cr[PG], ci[PG];
#pragma unroll
        for (int p = 0; p < PG; ++p) { const float br = P.bre[((size_t)dg * NS + n) * PG + p], bi = P.bim[((size_t)dg * NS + n) * PG + p];
            bbr[p] = fre * br - fim * bi; bbi[p] = fre * bi + fim * br; cr[p] = P.cre[((size_t)dg * PG + p) * NS + n]; ci[p] = P.cim[((size_t)dg * PG + p) * NS + n]; }
        float sre = 0.f, sim = 0.f;
        for (int i = 0; i < LC; ++i) { const int tc = dir == 0 ? i : LC - 1 - i;
            const bf16_t* upc = Ucat + ucat_ctx_idx(b, tc, g * PG); const bf16x8 u0 = *(const bf16x8*)upc, u1 = *(const bf16x8*)(upc + 8);
            float bur = 0.f, bui = 0.f;
#pragma unroll
            for (int p = 0; p < 8; ++p) { const float ua = bf2f((bf16_t)u0[p]), ub = bf2f((bf16_t)u1[p]); bur += bbr[p] * ua + bbr[p + 8] * ub; bui += bbi[p] * ua + bbi[p + 8] * ub; }
            const float nre = are * sre - aim * sim + bur, nim = are * sim + aim * sre + bui; sre = nre; sim = nim; }
        for (int i = 0; i < SEQ; ++i) { const int t = dir == 0 ? i : SEQ - 1 - i;
            const bf16_t* up = Ucat + ucat_idx(b, t, g * PG);
            const bf16x8 u0 = *(const bf16x8*)up, u1 = *(const bf16x8*)(up + 8);
            float uu[PG]; float bur = 0.f, bui = 0.f;
#pragma unroll
            for (int p = 0; p < 8; ++p) { uu[p] = bf2f((bf16_t)u0[p]); uu[p + 8] = bf2f((bf16_t)u1[p]); }
#pragma unroll
            for (int p = 0; p < PG; ++p) { bur += bbr[p] * uu[p]; bui += bbi[p] * uu[p]; }
            const float nre = are * sre - aim * sim + bur, nim = are * sim + aim * sre + bui; sre = nre; sim = nim;
            float mine = 0.f, myu = 0.f;
#pragma unroll
            for (int p = 0; p < PG; ++p) { const float y = wave_sum(cr[p] * sre - ci[p] * sim); if (n == p) { mine = y; myu = uu[p]; } }
            if (n < PG) { const size_t oi = ((size_t)(b * SEQ + t)) * 512 + g * PG + n;
                if (dir == 0) Ytmp[oi] = myu * dskip + mine;
                else SSM[oi] = f2bf(gelu_tanh(Ytmp[oi] + mine)); }
        }
    }
}

#include <hip/hip_cooperative_groups.h>
namespace cg = cooperative_groups;
#define LAS __attribute__((address_space(3)))
#define GAS __attribute__((address_space(1)))

namespace pg8 {
constexpr int BM = 256, BK = 64, HALF = 128, HTB = HALF * BK * 2, STAGE_BYTES = 8 * HTB, NXCD = 8, WGM = 8;
__host__ __device__ __forceinline__ int lds_byte(int r, int c) { const int st = (r >> 4) * 2 + (c >> 5), rr = r & 15, cc = c & 31, ob = rr * 64 + cc * 2; return st * 1024 + (ob ^ (((ob >> 9) & 1) << 5)); }
__host__ __device__ __forceinline__ void stage_rc(int b, int& R, int& C) { const int st = b / 1024, sb = b % 1024, swz = sb ^ (((sb >> 9) & 1) << 5); R = (st >> 1) * 16 + swz / 64; C = (st & 1) * 32 + (swz % 64) / 2; }
__host__ __device__ __forceinline__ int perm32(int rho) { const int n = rho >> 4, i = rho & 15; return 8 * (i >> 2) + 4 * n + (i & 3); }
struct Unit { int pm, pn, grp; };
struct Gemm { const bf16_t* A; const bf16_t* Bt; int lda, ldb, K; size_t a_grp, b_grp; int amode; };
struct StaticOrder {
    int nM, nN, nwg, G, c;
    __device__ __forceinline__ void init(int nM_, int nN_, int G_, int c_) { nM = nM_; nN = nN_; nwg = nM * nN; G = G_; c = c_; }
    __device__ __forceinline__ bool next(int i, Unit& u) const {
        const long L = (long)i * G + c; if (L >= nwg) return false;
        int wgid = (int)L; { const int q = nwg / NXCD, r = nwg % NXCD, xcd = wgid % NXCD, off = wgid / NXCD; wgid = (xcd < r ? xcd * (q + 1) : r * (q + 1) + (xcd - r) * q) + off; }
        const int nig = WGM * nN, gid = wgid / nig, fm = gid * WGM, gsz = (nM - fm) < WGM ? (nM - fm) : WGM;
        u.pm = fm + ((wgid % nig) % gsz); u.pn = (wgid % nig) / gsz; u.grp = 0; return true;
    }
};
__device__ __forceinline__ unsigned cvt_pk_bf16(float lo, float hi) { return pk2(lo, hi); }
#define EPI_ROWS_BF16(ROWPTR, BJSTRIDE, XF) do { \
    _Pragma("unroll") for (int ai = 0; ai < 2; ++ai) _Pragma("unroll") for (int m = 0; m < 4; ++m) { const int row = row0 + ai * HALF + m * 16; bf16_t* rp = (ROWPTR); \
        _Pragma("unroll") for (int bj = 0; bj < 2; ++bj) { f32x4 v0 = acc[ai][bj][m][0], v1 = acc[ai][bj][m][1]; \
            _Pragma("unroll") for (int j = 0; j < 4; ++j) { v0[j] = XF(v0[j]); v1[j] = XF(v1[j]); } \
            u32x4 w; w.x = cvt_pk_bf16(v0[0], v0[1]); w.y = cvt_pk_bf16(v0[2], v0[3]); w.z = cvt_pk_bf16(v1[0], v1[1]); w.w = cvt_pk_bf16(v1[2], v1[3]); \
            *(u32x4*)(rp + (size_t)bj * (BJSTRIDE)) = w; } } } while (0)
template <class Epi, class Sched, bool ALIGN_EPI = true, bool SP2 = true>
__device__ __forceinline__ void gemm_phase(LAS unsigned char* lds, const Gemm g, const Sched& S, const Epi& E, int wave_id) {
    const int tid = opaque_tid(wave_id), wid = __builtin_amdgcn_readfirstlane(tid >> 6), lane = tid & 63, wr = wid >> 2, wc = wid & 3, fr = lane & 15, fq = lane >> 4;
    const int K = g.K, nt = K / BK;
    unsigned voffA[2], voffB[2];
#pragma unroll
    for (int i = 0; i < 2; ++i) { int R, C; stage_rc(tid * 16 + i * 8192, R, C); const int Rb = Epi::PERM ? ((R & ~31) + perm32(R & 31)) : R;
        voffA[i] = g.amode == 1 ? (unsigned)((((C >> 4) * 1024 + (R >> 5)) * 512 + (R & 31) * 16 + (C & 15)) * 2) : g.amode == 2 ? (unsigned)((((R & ~63) | (4 * (R & 15) + ((R >> 4) & 3))) * g.lda + C) * 2) : g.amode == 3 ? (unsigned)((((((R >> 6) * 2 + (C >> 5)) * 2) * 4 + (R & 3)) * 1024) + ((((R & 63) >> 2) * 4 + ((C >> 3) & 3)) * 16)) : (g.amode == 4 || g.amode == 5) ? (unsigned)((((R >> 4) * 2 + (C >> 5)) * 1024) + (((R & 15) * 32 + (C & 31)) * 2)) : (unsigned)(R * g.lda + C) * 2u; voffB[i] = (unsigned)(Rb * g.ldb + C) * 2u; }
    const size_t kstep = (size_t)(BK * 2), kstepA = g.amode == 1 ? (size_t)4 * 1024 * 512 * 2 : (g.amode == 3 || g.amode == 4 || g.amode == 5) ? (size_t)32768 : kstep;
    const size_t hstepA = g.amode == 1 ? (size_t)4 * 512 * 2 : g.amode == 3 ? (size_t)4096 : (g.amode == 4 || g.amode == 5) ? (size_t)16384 : (size_t)HALF * g.lda * 2, hstepB = (size_t)HALF * g.ldb * 2;
    const size_t tstepA = g.amode == 3 ? (size_t)44 * 32768 : g.amode == 4 ? (size_t)(g.K / 64) * 32768 : g.amode == 5 ? (size_t)(g.K / 64) * 65536 : 2 * hstepA, tstepB = 2 * hstepB;
    const unsigned ldsw = (unsigned)wid * 1024u;
    const int aoff = lds_byte(wr * 64 + fr, fq * 8), boff = lds_byte(wc * 32 + fr, fq * 8);
#define PG8_SA(b, h) (((b) * 2 + (h)) * HTB)
#define PG8_SB(b, h) ((4 + (b) * 2 + (h)) * HTB)
#define PG8_STAGE(bufoff, gbase, voff) do { _Pragma("unroll") for (int _i = 0; _i < 2; ++_i) \
        __builtin_amdgcn_global_load_lds((const unsigned*)((const char*)(gbase) + (voff)[_i]), (LAS unsigned*)(lds + (bufoff) + ldsw + _i * 8192), 16, 0, 0); } while (0)
#define PG8_LDA(dst, b, h) do { _Pragma("unroll") for (int m = 0; m < 4; ++m) _Pragma("unroll") for (int k = 0; k < 2; ++k) dst[m][k] = *(const LAS bf16x8*)(lds + PG8_SA(b, h) + aoff + m * 2048 + k * 1024); } while (0)
#define PG8_LDB(dst, b, h) do { _Pragma("unroll") for (int n = 0; n < 2; ++n) _Pragma("unroll") for (int k = 0; k < 2; ++k) dst[n][k] = *(const LAS bf16x8*)(lds + PG8_SB(b, h) + boff + n * 2048 + k * 1024); } while (0)
#define PG8_MMA(ai, bj, At, Bt) do { __builtin_amdgcn_s_setprio(1); _Pragma("unroll") for (int m = 0; m < 4; ++m) _Pragma("unroll") for (int n = 0; n < 2; ++n) _Pragma("unroll") for (int k = 0; k < 2; ++k) \
        acc[ai][bj][m][n] = __builtin_amdgcn_mfma_f32_16x16x32_bf16(Bt[n][k], At[m][k], acc[ai][bj][m][n], 0, 0, 0); __builtin_amdgcn_s_setprio(0); } while (0)
#define PG8_WAIT_V(n) asm volatile("s_waitcnt vmcnt(" #n ")" ::: "memory")
#define PG8_WAIT_L(n) asm volatile("s_waitcnt lgkmcnt(" #n ")" ::: "memory")
#define PG8_BAR __builtin_amdgcn_s_barrier()
#define PG8_SCHED __builtin_amdgcn_sched_barrier(0)
    Unit cur, nxt; int ui = 0;
    if (!S.next(0, cur)) return;
    f32x4 acc[2][2][4][2];
#pragma unroll
    for (int a = 0; a < 2; ++a)
#pragma unroll
        for (int b = 0; b < 2; ++b)
#pragma unroll
            for (int m = 0; m < 4; ++m)
#pragma unroll
                for (int n = 0; n < 2; ++n) acc[a][b][m][n] = (f32x4){0.f, 0.f, 0.f, 0.f};
    bf16x8 At[4][2], B0[2][2], B1[2][2];
    const char* cA = (const char*)g.A + (size_t)cur.grp * g.a_grp + (size_t)cur.pm * tstepA + ((g.amode == 3 && cur.pm >= A_SPLIT_PM) ? A_HI_SHIFT : (size_t)0); const char* cB = (const char*)g.Bt + (size_t)cur.grp * g.b_grp + (size_t)cur.pn * tstepB;
    typename Epi::Pre pre = E.pre(cur, wid, lane);
    if constexpr (SP2) {
        PG8_STAGE(PG8_SB(0, 0), cB, voffB); PG8_STAGE(PG8_SB(0, 1), cB + hstepB, voffB); PG8_STAGE(PG8_SA(0, 0), cA, voffA); PG8_STAGE(PG8_SA(0, 1), cA + hstepA, voffA);
        if (wr == 1) PG8_BAR;
        PG8_WAIT_V(2); PG8_BAR;
        PG8_STAGE(PG8_SB(1, 0), cB + kstep, voffB); PG8_STAGE(PG8_SA(1, 0), cA + kstepA, voffA); PG8_STAGE(PG8_SB(1, 1), cB + hstepB + kstep, voffB);
        PG8_WAIT_V(6); PG8_BAR;
    } else {
        PG8_STAGE(PG8_SB(0, 0), cB, voffB); PG8_STAGE(PG8_SA(0, 0), cA, voffA); PG8_STAGE(PG8_SB(0, 1), cB + hstepB, voffB); PG8_STAGE(PG8_SA(0, 1), cA + hstepA, voffA);
        if (wr == 1) PG8_BAR;
        PG8_WAIT_V(4); PG8_BAR;
        PG8_STAGE(PG8_SB(1, 0), cB + kstep, voffB); PG8_STAGE(PG8_SA(1, 0), cA + kstepA, voffA); PG8_STAGE(PG8_SB(1, 1), cB + hstepB + kstep, voffB);
        PG8_WAIT_V(6); PG8_BAR;
    }
    for (;;) {
        const bool has_next = S.next(ui + 1, nxt);
        const char* nA = has_next ? (const char*)g.A + (size_t)nxt.grp * g.a_grp + (size_t)nxt.pm * tstepA + ((g.amode == 3 && nxt.pm >= A_SPLIT_PM) ? A_HI_SHIFT : (size_t)0) : cA; const char* nB = has_next ? (const char*)g.Bt + (size_t)nxt.grp * g.b_grp + (size_t)nxt.pn * tstepB : cB;
        for (int t = 0; t < nt; t += 2) {
            const bool last = (t == nt - 2);
            const char* a1 = cA + (size_t)(t + 1) * kstepA;
            const char* a2 = last ? nA : cA + (size_t)(t + 2) * kstepA; const char* b2 = last ? nB : cB + (size_t)(t + 2) * kstep;
            const char* a3 = a2 + kstepA; const char* b3 = b2 + kstep;
            if constexpr (SP2) {
            PG8_LDB(B0, 0, 0); PG8_LDB(B1, 0, 1); PG8_SCHED; PG8_LDA(At, 0, 0); PG8_STAGE(PG8_SA(1, 1), a1 + hstepA, voffA);
            PG8_WAIT_V(8); PG8_WAIT_L(0); PG8_BAR; PG8_MMA(0, 0, At, B0); PG8_MMA(0, 1, At, B1); PG8_BAR; PG8_SCHED;
            PG8_LDA(At, 0, 1); PG8_STAGE(PG8_SB(0, 0), b2, voffB); PG8_STAGE(PG8_SB(0, 1), b2 + hstepB, voffB); PG8_STAGE(PG8_SA(0, 0), a2, voffA);
            PG8_WAIT_V(8); PG8_WAIT_L(0); PG8_BAR; PG8_MMA(1, 0, At, B0); PG8_MMA(1, 1, At, B1); PG8_BAR; PG8_SCHED;
            PG8_LDB(B0, 1, 0); PG8_LDB(B1, 1, 1); PG8_SCHED; PG8_LDA(At, 1, 0); PG8_STAGE(PG8_SA(0, 1), a2 + hstepA, voffA);
            PG8_WAIT_V(8); PG8_WAIT_L(0); PG8_BAR; PG8_MMA(0, 0, At, B0); PG8_MMA(0, 1, At, B1); PG8_BAR; PG8_SCHED;
            PG8_LDA(At, 1, 1); PG8_STAGE(PG8_SB(1, 0), b3, voffB); PG8_STAGE(PG8_SB(1, 1), b3 + hstepB, voffB); PG8_STAGE(PG8_SA(1, 0), a3, voffA);
            PG8_WAIT_V(8); PG8_WAIT_L(0); PG8_BAR; PG8_MMA(1, 0, At, B0); PG8_MMA(1, 1, At, B1); PG8_BAR; PG8_SCHED;
            } else {
            PG8_LDB(B0, 0, 0); PG8_SCHED; PG8_LDA(At, 0, 0); PG8_STAGE(PG8_SA(1, 1), a1 + hstepA, voffA);
            PG8_WAIT_L(8); PG8_BAR; PG8_WAIT_L(0); PG8_MMA(0, 0, At, B0); PG8_BAR; PG8_SCHED;
            PG8_LDB(B1, 0, 1); PG8_STAGE(PG8_SB(0, 0), b2, voffB);
            PG8_BAR; PG8_WAIT_L(0); PG8_MMA(0, 1, At, B1); PG8_BAR;
            PG8_LDA(At, 0, 1); PG8_STAGE(PG8_SA(0, 0), a2, voffA);
            PG8_BAR; PG8_WAIT_L(0); PG8_MMA(1, 0, At, B0); PG8_BAR; PG8_SCHED;
            PG8_STAGE(PG8_SB(0, 1), b2 + hstepB, voffB);
            PG8_WAIT_V(6); PG8_BAR; PG8_MMA(1, 1, At, B1); PG8_BAR;
            PG8_LDB(B0, 1, 0); PG8_SCHED; PG8_LDA(At, 1, 0); PG8_STAGE(PG8_SA(0, 1), a2 + hstepA, voffA);
            PG8_WAIT_L(8); PG8_BAR; PG8_WAIT_L(0); PG8_MMA(0, 0, At, B0); PG8_BAR; PG8_SCHED;
            PG8_LDB(B1, 1, 1); PG8_STAGE(PG8_SB(1, 0), b3, voffB);
            PG8_BAR; PG8_WAIT_L(0); PG8_MMA(0, 1, At, B1); PG8_BAR;
            PG8_LDA(At, 1, 1); PG8_STAGE(PG8_SA(1, 0), a3, voffA);
            PG8_BAR; PG8_WAIT_L(0); PG8_MMA(1, 0, At, B0); PG8_BAR; PG8_SCHED;
            PG8_STAGE(PG8_SB(1, 1), b3 + hstepB, voffB);
            PG8_WAIT_V(6); PG8_BAR; PG8_MMA(1, 1, At, B1); PG8_BAR;
            }
        }
        if constexpr (ALIGN_EPI) { if (wr == 0) PG8_BAR; }
        E(acc, cur, wr, wc, fr, fq, pre);
        if (!has_next) break;
#pragma unroll
        for (int a = 0; a < 2; ++a)
#pragma unroll
            for (int b = 0; b < 2; ++b)
#pragma unroll
                for (int m = 0; m < 4; ++m)
#pragma unroll
                    for (int n = 0; n < 2; ++n) acc[a][b][m][n] = (f32x4){0.f, 0.f, 0.f, 0.f};
        cur = nxt; cA = nA; cB = nB; ++ui;
        pre = E.pre(cur, wid, lane);
        if constexpr (ALIGN_EPI) { if (wr == 1) PG8_BAR; }
    }
    PG8_WAIT_V(0);
    if constexpr (!ALIGN_EPI) { if (wr == 0) PG8_BAR; }
    PG8_BAR;
#undef PG8_SA
#undef PG8_SB
#undef PG8_STAGE
#undef PG8_LDA
#undef PG8_LDB
#undef PG8_MMA
#undef PG8_WAIT_V
#undef PG8_WAIT_L
#undef PG8_BAR
#undef PG8_SCHED
}
}

__device__ __forceinline__ int sidx(int d, int ri, int n);
template <int NI, int RB> __device__ __forceinline__ void s5_recur(const float* __restrict__ Lb, const float* __restrict__ A32, bf16_t* __restrict__ Ucat, int tid, const int* gg, const int* pp) {
    const int bl = tid >> 7, d = (tid >> 6) & 1, n = tid & 63;
    float ar[NI], ai[NI], sr[NI], si[NI]; const float* Lg[NI]; bf16_t* Sg[NI]; int b[NI];
#pragma unroll
    for (int k = 0; k < NI; ++k) { b[k] = pp[k] * 4 + bl; ar[k] = A32[((d * NG + gg[k]) * NS + n) * 2]; ai[k] = A32[((d * NG + gg[k]) * NS + n) * 2 + 1];
        Lg[k] = Lb + (size_t)gg[k] * UROWS * 256 + sidx(d, 0, n); Sg[k] = Ucat + (size_t)gg[k] * UROWS * KCAT + 512 + sidx(d, 0, n); sr[k] = 0.f; si[k] = 0.f; }
    { float lr[NI][8], li[NI][8];
#pragma unroll
      for (int k = 0; k < NI; ++k)
#pragma unroll
          for (int i = 0; i < 8; ++i) { const int row = 1024 + b[k] * 8 + (d == 0 ? i : 7 - i); lr[k][i] = Lg[k][(size_t)row * 256]; li[k][i] = Lg[k][(size_t)row * 256 + 64]; }
#pragma unroll
      for (int i = 0; i < 8; ++i)
#pragma unroll
          for (int k = 0; k < NI; ++k) { const float t0 = ar[k] * sr[k] - ai[k] * si[k] + lr[k][i], t1 = ar[k] * si[k] + ai[k] * sr[k] + li[k][i]; sr[k] = t0; si[k] = t1; } }
#pragma unroll 1
    for (int i0 = 0; i0 < 64; i0 += RB) { float lr[NI][RB], li[NI][RB];
#pragma unroll
        for (int k = 0; k < NI; ++k)
#pragma unroll
            for (int i = 0; i < RB; ++i) { const int row = b[k] * 64 + (d == 0 ? i0 + i : 63 - i0 - i); lr[k][i] = Lg[k][(size_t)row * 256]; li[k][i] = Lg[k][(size_t)row * 256 + 64]; }
#pragma unroll
        for (int i = 0; i < RB; ++i)
#pragma unroll
            for (int k = 0; k < NI; ++k) { const int row = b[k] * 64 + (d == 0 ? i0 + i : 63 - i0 - i);
                Sg[k][(size_t)row * KCAT] = f2bf(sr[k]); Sg[k][(size_t)row * KCAT + 64] = f2bf(si[k]);
                const float t0 = ar[k] * sr[k] - ai[k] * si[k] + lr[k][i], t1 = ar[k] * si[k] + ai[k] * sr[k] + li[k][i]; sr[k] = t0; si[k] = t1; } }
    asm volatile("s_waitcnt vmcnt(0)" ::: "memory"); __syncthreads();
}
#define XB_TMO      128
#define XB_XCNT(j)  (256  + 64 * (j))
#define XB_XSUB(j)  (1280 + 64 * (j))
#define XB_XGEN(j)  (2304 + 64 * (j))
#define XB_TOP      3328
#define XB_TOPGEN   3392
#define XCD_BAR_WORDS 3456
#define XB_SPIN_CAP (1u << 18)
__device__ __forceinline__ unsigned xb_ld(unsigned* p)              { return __hip_atomic_load(p, __ATOMIC_RELAXED, __HIP_MEMORY_SCOPE_AGENT); }
__device__ __forceinline__ unsigned xb_add(unsigned* p, unsigned v) { return __hip_atomic_fetch_add(p, v, __ATOMIC_RELAXED, __HIP_MEMORY_SCOPE_AGENT); }
__device__ __forceinline__ unsigned xb_xcc_id() { return (unsigned)__builtin_amdgcn_s_getreg((3 << 11) | 20) & 0xFu; }
#define XB_SPIN(cond, bar) do { unsigned _sp = 0; while (cond) { __builtin_amdgcn_s_sleep(1); \
    if ((++_sp & 255u) == 0u) { if (xb_ld(&(bar)[XB_TMO])) break; if (_sp > XB_SPIN_CAP) { atomicAdd(&(bar)[XB_TMO], 1u); break; } } } } while (0)
struct XcdBarrier { unsigned* bar; unsigned x; volatile LAS unsigned* st; };
__device__ __forceinline__ XcdBarrier xcd_barrier_post(unsigned* bar, volatile LAS unsigned* st) {
    XcdBarrier b; b.bar = bar; b.x = xb_xcc_id(); b.st = st;
    if (threadIdx.x == 0) (void)xb_add(&bar[XB_XCNT(b.x)], 1u);
    return b;
}
__device__ __forceinline__ void xcd_barrier_complete(unsigned* bar, unsigned x, unsigned& nloc, unsigned& nx) {
    const unsigned G = gridDim.x * gridDim.y * gridDim.z;
    unsigned sum, cnt, mine, sp = 0u;
    for (;;) {
        sum = 0u; cnt = 0u; mine = 0u;
#pragma unroll
        for (unsigned j = 0; j < 16; ++j) { const unsigned c = xb_ld(&bar[XB_XCNT(j)]); sum += c; cnt += (c > 0u) ? 1u : 0u; mine = (j == x) ? c : mine; }
        if (sum == G) break;
        __builtin_amdgcn_s_sleep(1);
        if ((++sp & 255u) == 0u) { if (xb_ld(&bar[XB_TMO])) break; if (sp > XB_SPIN_CAP) { atomicAdd(&bar[XB_TMO], 1u); break; } }
    }
    nloc = mine > 0u ? mine : 1u; nx = cnt > 0u ? cnt : 1u;
}
__device__ __forceinline__ void xcd_barrier(const XcdBarrier& b) {
    asm volatile("s_waitcnt vmcnt(0)" ::: "memory");
    __syncthreads();
    if (threadIdx.x == 0) {
        unsigned* bar = b.bar;
        __builtin_amdgcn_s_waitcnt(0);
        unsigned nloc = b.st[0], nx = b.st[1];
        if (nloc == 0u) { xcd_barrier_complete(bar, b.x, nloc, nx); b.st[0] = nloc; b.st[1] = nx; }
        const unsigned old = xb_add(&bar[XB_XSUB(b.x)], 1u);
        const unsigned gen = old / nloc;
        if (old + 1u == (gen + 1u) * nloc) {
            __builtin_amdgcn_fence(__ATOMIC_RELEASE, "agent");
            asm volatile("s_waitcnt vmcnt(0)" ::: "memory");
            const unsigned og = xb_add(&bar[XB_TOP], 1u);
            const unsigned tg = og / nx;
            if (og + 1u == (tg + 1u) * nx) xb_add(&bar[XB_TOPGEN], 1u);
            else XB_SPIN(xb_ld(&bar[XB_TOPGEN]) == tg, bar);
            __builtin_amdgcn_fence(__ATOMIC_ACQUIRE, "agent");
            xb_add(&bar[XB_XGEN(b.x)], 1u);
            asm volatile("s_waitcnt vmcnt(0)" ::: "memory");
        } else {
            XB_SPIN(xb_ld(&bar[XB_XGEN(b.x)]) == gen, bar);
            __builtin_amdgcn_fence(__ATOMIC_ACQUIRE, "agent");
            asm volatile("s_waitcnt vmcnt(0)" ::: "memory");
        }
    }
    __syncthreads();
}

#define TB_WORD(x, p) (26624 + 64 * ((x) * 8 + (p)))
__device__ __forceinline__ void team_barrier(unsigned* cnt, unsigned gen) {
    asm volatile("s_waitcnt vmcnt(0)" ::: "memory");
    __syncthreads();
    if (threadIdx.x == 0) {
        (void)xb_add(cnt, 1u);
        unsigned spins = 0;
        while (xb_ld(cnt) < 4u * gen) { __builtin_amdgcn_s_sleep(1); if (++spins > (1u << 22)) break; }
        __builtin_amdgcn_fence(__ATOMIC_ACQUIRE, "agent");
        asm volatile("s_waitcnt vmcnt(0)" ::: "memory");
    }
    __syncthreads();
}
#define GB_SUB(j)   (12288 + 64 * (j))
#define GB_GEN(j)   (13312 + 64 * (j))
#define GB_MISMATCH 14400
#define GB_TOPA     14976
#define GB_TOPB     15040
__device__ __forceinline__ void top_wait(unsigned* top) {
    if (threadIdx.x < 64) { unsigned spins = 0;
        while ((unsigned)__builtin_amdgcn_readfirstlane(xb_ld(top)) < 8u) { __builtin_amdgcn_s_sleep(2); if (++spins > (1u << 22)) break; }
        __builtin_amdgcn_fence(__ATOMIC_ACQUIRE, "agent"); asm volatile("s_waitcnt vmcnt(0)" ::: "memory"); }
    __syncthreads();
}
__device__ __forceinline__ void grp_barrier(const XcdBarrier& b, unsigned* top = nullptr) {
    asm volatile("s_waitcnt vmcnt(0)" ::: "memory");
    __syncthreads();
    if (threadIdx.x == 0) {
        unsigned* bar = b.bar;
        __builtin_amdgcn_s_waitcnt(0);
        const unsigned nloc = b.st[0];
        const unsigned old = xb_add(&bar[GB_SUB(b.x)], 1u);
        const unsigned gen = old / nloc;
        if (old + 1u == (gen + 1u) * nloc) {
            __builtin_amdgcn_fence(__ATOMIC_RELEASE, "agent");
            asm volatile("s_waitcnt vmcnt(0)" ::: "memory");
            if (top) (void)xb_add(top, 1u);
            __builtin_amdgcn_fence(__ATOMIC_ACQUIRE, "agent");
            xb_add(&bar[GB_GEN(b.x)], 1u);
            asm volatile("s_waitcnt vmcnt(0)" ::: "memory");
        } else {
            XB_SPIN(xb_ld(&bar[GB_GEN(b.x)]) == gen, bar);
            __builtin_amdgcn_fence(__ATOMIC_ACQUIRE, "agent");
            asm volatile("s_waitcnt vmcnt(0)" ::: "memory");
        }
    }
    __syncthreads();
}

constexpr int MK_LDS = 147456;
constexpr int NWV = 8;
#ifndef MK_HI
#define MK_HI 16
#endif
#ifndef S5_NAIVE
#define S5_NAIVE 0
#endif
#ifndef USE_XBAR
#define USE_XBAR 1
#endif
#ifndef X1_BF16
#define X1_BF16 1
#endif
#ifndef GRP_SEAMS
#define GRP_SEAMS 1
#endif
#ifndef STAGGER8_US
#define STAGGER8_US 0
#endif
#ifndef REPMASK
#define REPMASK 0x0
#endif
#define REPS(k) for (int rep_ = 0; rep_ <= ((REPMASK >> (k)) & 1); ++rep_)
struct MkArgs { const float* in[27]; float* out; unsigned char* ws; int ph_lo, ph_hi; };

template <int MAP> __device__ __forceinline__ void transpose_item(const float* __restrict__ W, int K, int N, bf16_t* __restrict__ WT, LAS float* scr, int item, int lane) {
    const int nblk = N / 32, kb = item / nblk, nb = item % nblk, k0 = 64 * kb, n0 = 32 * nb;
    { f32x4 v[8];
#pragma unroll
      for (int i = 0; i < 8; ++i) v[i] = *(const f32x4*)(W + (size_t)(k0 + 8 * i + (lane >> 3)) * N + n0 + (lane & 7) * 4);
#pragma unroll
      for (int i = 0; i < 8; ++i) { LAS float* d = scr + (8 * i + (lane >> 3)) * 33 + (lane & 7) * 4; d[0] = v[i][0]; d[1] = v[i][1]; d[2] = v[i][2]; d[3] = v[i][3]; } }
    asm volatile("s_waitcnt lgkmcnt(0)" ::: "memory");
    const int c = lane & 7;
#pragma unroll
    for (int j = 0; j < 4; ++j) { const int n = (lane >> 3) + 8 * j; const LAS float* s = scr + (8 * c) * 33 + n;
        u32x4 o; o.x = pk2(s[0 * 33], s[1 * 33]); o.y = pk2(s[2 * 33], s[3 * 33]); o.z = pk2(s[4 * 33], s[5 * 33]); o.w = pk2(s[6 * 33], s[7 * 33]);
        int dr = n0 + n; if (MAP == 1) { const int cc = dr >= DFF ? dr - DFF : dr; dr = (cc >> 7) * 256 + (dr >= DFF ? 128 : 0) + (cc & 127); }
        if (MAP == 2) { const int cc = dr & 1023; dr = (cc >> 7) * 256 + (dr >= 1024 ? 128 : 0) + (cc & 127); }
        *(u32x4*)(WT + (size_t)dr * K + k0 + 8 * c) = o; }
    asm volatile("s_waitcnt lgkmcnt(0)" ::: "memory");
}
__device__ __forceinline__ void norm_mod_rows4(const float* __restrict__ src, const float* __restrict__ w, const float* __restrict__ sh, const float* __restrict__ sc, bf16_t* __restrict__ dst, int lane) {
    f32x4 v[4][4]; float ss[4];
#pragma unroll
    for (int r = 0; r < 4; ++r)
#pragma unroll
        for (int j = 0; j < 4; ++j) v[r][j] = *(const f32x4*)(src + (size_t)r * DM + j * 256 + lane * 4);
#pragma unroll
    for (int r = 0; r < 4; ++r) { float s = 0.f;
#pragma unroll
        for (int j = 0; j < 4; ++j) s += (v[r][j][0] * v[r][j][0] + v[r][j][1] * v[r][j][1]) + (v[r][j][2] * v[r][j][2] + v[r][j][3] * v[r][j][3]);
        ss[r] = s; }
#pragma unroll
    for (int o = 1; o < 64; o <<= 1) {
#pragma unroll
        for (int r = 0; r < 4; ++r) ss[r] += __shfl_xor(ss[r], o); }
#pragma unroll
    for (int r = 0; r < 4; ++r) ss[r] = rsqrtf(ss[r] * (1.f / DM) + EPS);
#pragma unroll
    for (int j = 0; j < 4; ++j) { const int k = j * 256 + lane * 4; const f32x4 ww = *(const f32x4*)(w + k), s1 = *(const f32x4*)(sc + k) + 1.f, s0 = *(const f32x4*)(sh + k);
#pragma unroll
        for (int r = 0; r < 4; ++r) { const f32x4 y = (v[r][j] * ss[r] * ww) * s1 + s0; u32x2 o; o.x = pk2(y[0], y[1]); o.y = pk2(y[2], y[3]); *(u32x2*)(dst + (size_t)r * DM + k) = o; } }
}
__device__ __forceinline__ unsigned pack4_u8(float a, float b, float c, float d) { unsigned w = 0u; w = __builtin_amdgcn_cvt_pk_u8_f32(a * 255.f, 0u, w); w = __builtin_amdgcn_cvt_pk_u8_f32(b * 255.f, 1u, w); w = __builtin_amdgcn_cvt_pk_u8_f32(c * 255.f, 2u, w); w = __builtin_amdgcn_cvt_pk_u8_f32(d * 255.f, 3u, w); return w; }
__device__ __forceinline__ void unpack8_u8(const u32x2 w, float (&f)[8]) { constexpr float s = 1.f / 255.f;
    f[0] = (float)(w.x & 0xffu) * s; f[1] = (float)((w.x >> 8) & 0xffu) * s; f[2] = (float)((w.x >> 16) & 0xffu) * s; f[3] = (float)(w.x >> 24) * s;
    f[4] = (float)(w.y & 0xffu) * s; f[5] = (float)((w.y >> 8) & 0xffu) * s; f[6] = (float)((w.y >> 16) & 0xffu) * s; f[7] = (float)(w.y >> 24) * s; }
__device__ __forceinline__ size_t ll_idx(int t, int w, int S, int s, int l) { return ((size_t)(t * 8 + w) * S + s) * 64 + l; }
__device__ __forceinline__ size_t a_blk(int pm, int kt, int wr, int wcl, int ai, int m) { return ((((((size_t)pm * 44 + kt) * 2 + wr) * 2 + wcl) * 2 + ai) * 4 + m) * 1024 + (pm >= A_SPLIT_PM ? A_HI_SHIFT : (size_t)0); }
struct NoPre {};
#define EPI_NOPRE typedef NoPre Pre; __device__ __forceinline__ Pre pre(const pg8::Unit&, int, int) const { return Pre{}; }
__device__ __forceinline__ float xf_id(float v) { return v; }
struct EpiAfast {
    static constexpr bool PERM = true;
    EPI_NOPRE
    bf16_t *Q, *Kb, *Vb, *Ucat, *SG; const float *qnw, *knw; LAS float* SS;
    __device__ __forceinline__ void operator()(const f32x4 (&acc)[2][2][4][2], const pg8::Unit& u, int wr, int wc, int fr, int fq, const Pre& pre_) const {
        using namespace pg8;
        const int row0 = u.pm * BM + wr * 64 + fr, cl = wc * 32 + 8 * fq;
        const bool lat = u.pm < ML / 256;
        if (u.pn < 5) {
            const bool isq = u.pn < 4; const float* nw = isq ? qnw : knw;
#pragma unroll
            for (int ai = 0; ai < 2; ++ai)
#pragma unroll
                for (int m = 0; m < 4; ++m)
#pragma unroll
                    for (int bj = 0; bj < 2; ++bj) { const f32x4 v0 = acc[ai][bj][m][0], v1 = acc[ai][bj][m][1];
                        float s = (v0[0] * v0[0] + v0[1] * v0[1]) + (v0[2] * v0[2] + v0[3] * v0[3]) + (v1[0] * v1[0] + v1[1] * v1[1]) + (v1[2] * v1[2] + v1[3] * v1[3]);
                        s += __shfl_xor(s, 16); s += __shfl_xor(s, 32);
                        if (fq == 0) SS[((ai * HALF + wr * 64 + m * 16 + fr) * 2 + bj) * 4 + wc] = s; }
            asm volatile("s_waitcnt lgkmcnt(0)" ::: "memory"); __builtin_amdgcn_s_barrier(); asm volatile("" ::: "memory");
            const f32x4 w0 = *(const f32x4*)(nw + cl), w1 = *(const f32x4*)(nw + cl + 4);
            float invf[4];
#pragma unroll
            for (int e = 0; e < 4; ++e) invf[e] = exp2f(-(float)(2 * (((cl >> 1) + e) & 31)) * (13.287712379549449f / 64.f));
#pragma unroll
            for (int ai = 0; ai < 2; ++ai)
#pragma unroll
                for (int m = 0; m < 4; ++m) { const int row = row0 + ai * HALF + m * 16;
                    float cs[4], sn[4];
                    if (lat) { const int t = row % SEQ; const float coord = (wc < 2) ? (float)(t >> 6) : (float)(t & 63);
#pragma unroll
                        for (int e = 0; e < 4; ++e) { const float ang = coord * invf[e]; cs[e] = __cosf(ang); sn[e] = __sinf(ang); } }
                    else {
#pragma unroll
                        for (int e = 0; e < 4; ++e) { cs[e] = 1.f; sn[e] = 0.f; } }
                    bf16_t* rp = isq ? Q + (size_t)row * 1024 + u.pn * 256 + cl
                                     : Kb + ((size_t)(lat ? (row / SEQ) * LKV + LC + (row % SEQ) : ((row - ML) / LC) * LKV + ((row - ML) % LC))) * 256 + cl;
#pragma unroll
                    for (int bj = 0; bj < 2; ++bj) {
                        const f32x4 p = *(const LAS f32x4*)(SS + ((ai * HALF + wr * 64 + m * 16 + fr) * 2 + bj) * 4);
                        const float rs = rsqrtf(((p[0] + p[1]) + (p[2] + p[3])) * (1.f / 128.f) + EPS);
                        const f32x4 y0 = acc[ai][bj][m][0] * rs * w0, y1 = acc[ai][bj][m][1] * rs * w1;
                        u32x4 w; w.x = cvt_pk_bf16(y0[0] * cs[0] - y0[1] * sn[0], y0[0] * sn[0] + y0[1] * cs[0]); w.y = cvt_pk_bf16(y0[2] * cs[1] - y0[3] * sn[1], y0[2] * sn[1] + y0[3] * cs[1]);
                        w.z = cvt_pk_bf16(y1[0] * cs[2] - y1[1] * sn[2], y1[0] * sn[2] + y1[1] * cs[2]); w.w = cvt_pk_bf16(y1[2] * cs[3] - y1[3] * sn[3], y1[2] * sn[3] + y1[3] * cs[3]);
                        *(u32x4*)(rp + bj * 128) = w; } }
        }
        else if (u.pn == 5) {
            EPI_ROWS_BF16(Vb + ((size_t)(lat ? (row / SEQ) * LKV + LC + (row % SEQ) : ((row - ML) / LC) * LKV + ((row - ML) % LC))) * 256 + cl, 128, xf_id); }
        else if (u.pn < 8) { const int ch0 = (u.pn - 6) * 256 + cl;
            if (lat) { EPI_ROWS_BF16(Ucat + ucat_idx(row / SEQ, row % SEQ, ch0), (size_t)8 * UROWS * KCAT, xf_id); }
            else { EPI_ROWS_BF16(Ucat + ucat_ctx_idx((row - ML) / LC, (row - ML) % LC, ch0), (size_t)8 * UROWS * KCAT, xf_id); } }
        else { unsigned char* sg8 = (unsigned char*)SG;
#pragma unroll
            for (int ai = 0; ai < 2; ++ai)
#pragma unroll
                for (int m = 0; m < 4; ++m) { const int row = row0 + ai * HALF + m * 16;
#pragma unroll
                    for (int bj = 0; bj < 2; ++bj) { const f32x4 v0 = acc[ai][bj][m][0], v1 = acc[ai][bj][m][1]; u32x2 w;
                        w.x = pack4_u8(sigmoidf_(v0[0]), sigmoidf_(v0[1]), sigmoidf_(v0[2]), sigmoidf_(v0[3])); w.y = pack4_u8(sigmoidf_(v1[0]), sigmoidf_(v1[1]), sigmoidf_(v1[2]), sigmoidf_(v1[3]));
                        ((u32x2*)sg8)[ll_idx(u.pm * 8 + (u.pn - 8), wr * 4 + wc, 16, ai * 8 + m * 2 + bj, fq * 16 + fr)] = w; } } }
    }
};
struct EpiStoreFast {
    static constexpr bool PERM = true; bf16_t* O; int ldo;
    EPI_NOPRE
    __device__ __forceinline__ void operator()(const f32x4 (&acc)[2][2][4][2], const pg8::Unit& u, int wr, int wc, int fr, int fq, const Pre& pre_) const {
        using namespace pg8; const int row0 = u.pm * BM + wr * 64 + fr, cl = u.pn * BM + wc * 32 + 8 * fq;
        EPI_ROWS_BF16(O + (size_t)row * ldo + cl, 128, xf_id);
    }
};
__device__ __forceinline__ void unpack8(const u32x4 w, float (&f)[8]) {
    f[0] = __uint_as_float(w.x << 16); f[1] = __uint_as_float(w.x & 0xffff0000u); f[2] = __uint_as_float(w.y << 16); f[3] = __uint_as_float(w.y & 0xffff0000u);
    f[4] = __uint_as_float(w.z << 16); f[5] = __uint_as_float(w.z & 0xffff0000u); f[6] = __uint_as_float(w.w << 16); f[7] = __uint_as_float(w.w & 0xffff0000u);
}
struct EpiGluPair {
    static constexpr bool PERM = true;
    EPI_NOPRE const bf16_t* SG; bf16_t* PS;
    __device__ __forceinline__ void operator()(const f32x4 (&acc)[2][2][4][2], const pg8::Unit& u, int wr, int wc, int fr, int fq, const Pre& pre_) const {
        using namespace pg8; const int row0 = u.pm * BM + wr * 64 + fr, c0 = u.pn * 128 + wc * 32 + 8 * fq;
        u32x2 gw[2][4]; const unsigned char* sg8 = (const unsigned char*)SG;
#pragma unroll
        for (int ai = 0; ai < 2; ++ai)
#pragma unroll
            for (int m = 0; m < 4; ++m) gw[ai][m] = ((const u32x2*)sg8)[ll_idx(u.pm * 8 + 4 + (u.pn >> 1), wr * 4 + wc, 16, ai * 8 + m * 2 + (u.pn & 1), fq * 16 + fr)];
#pragma unroll
        for (int ai = 0; ai < 2; ++ai)
#pragma unroll
            for (int m = 0; m < 4; ++m) { const int row = row0 + ai * HALF + m * 16; float gs[8], r[8];
                unpack8_u8(gw[ai][m], gs);
#pragma unroll
                for (int j = 0; j < 8; ++j) { const float av = (j < 4) ? acc[ai][0][m][0][j & 3] : acc[ai][0][m][1][j & 3], bv = (j < 4) ? acc[ai][1][m][0][j & 3] : acc[ai][1][m][1][j & 3]; r[j] = gs[j] * av * sigmoidf_(bv); }
                u32x4 w; w.x = cvt_pk_bf16(r[0], r[1]); w.y = cvt_pk_bf16(r[2], r[3]); w.z = cvt_pk_bf16(r[4], r[5]); w.w = cvt_pk_bf16(r[6], r[7]);
                ((u32x4*)PS)[ll_idx(u.pm * 8 + u.pn, wr * 4 + wc, 8, ai * 4 + m, fq * 16 + fr)] = w; }
    }
};
struct EpiMergeFast {
    static constexpr bool PERM = true;
    EPI_NOPRE const bf16_t *SG, *GLU; bf16_t* MG;
    __device__ __forceinline__ void operator()(const f32x4 (&acc)[2][2][4][2], const pg8::Unit& u, int wr, int wc, int fr, int fq, const Pre& pre_) const {
        using namespace pg8; const int row0 = u.pm * BM + wr * 64 + fr, cl = u.pn * BM + wc * 32 + 8 * fq;
#pragma unroll
        for (int ai = 0; ai < 2; ++ai) {
            u32x2 gw[4][2]; u32x4 pw[4][2]; const unsigned char* sg8 = (const unsigned char*)SG;
#pragma unroll
            for (int m = 0; m < 4; ++m)
#pragma unroll
                for (int bj = 0; bj < 2; ++bj) { gw[m][bj] = ((const u32x2*)sg8)[ll_idx(u.pm * 8 + u.pn, wr * 4 + wc, 16, ai * 8 + m * 2 + bj, fq * 16 + fr)]; pw[m][bj] = ((const u32x4*)GLU)[ll_idx(u.pm * 8 + 2 * u.pn + bj, wr * 4 + wc, 8, ai * 4 + m, fq * 16 + fr)]; }
#pragma unroll
            for (int m = 0; m < 4; ++m)
#pragma unroll
                for (int bj = 0; bj < 2; ++bj) { const int row = row0 + ai * HALF + m * 16; float ga[8], ps[8], r[8];
                    unpack8_u8(gw[m][bj], ga); unpack8(pw[m][bj], ps);
#pragma unroll
                    for (int j = 0; j < 8; ++j) { const float v = (j < 4) ? acc[ai][bj][m][0][j & 3] : acc[ai][bj][m][1][j & 3]; r[j] = ga[j] * v + ps[j]; }
                    u32x4 w; w.x = cvt_pk_bf16(r[0], r[1]); w.y = cvt_pk_bf16(r[2], r[3]); w.z = cvt_pk_bf16(r[4], r[5]); w.w = cvt_pk_bf16(r[6], r[7]);
                    *(u32x4*)((char*)MG + blk16x32(u.pm, 32, u.pn * 4 + bj * 2 + (wc >> 1), ai, wr * 4 + m, wc & 1) + (fr * 32 + 8 * fq) * 2) = w; } }
    }
};
struct EpiResidFast {
    static constexpr bool PERM = false; const float* base; float* out; const float* gate;
    EPI_NOPRE
    __device__ __forceinline__ void operator()(const f32x4 (&acc)[2][2][4][2], const pg8::Unit& u, int wr, int wc, int fr, int fq, const Pre& pre_) const {
        using namespace pg8; const int row0 = u.pm * BM + wr * 64 + fr, col0 = u.pn * BM + wc * 32 + 4 * fq;
        const float* gp = gate + (size_t)((u.pm * BM) / SEQ) * 6144 + col0;
        f32x4 gv[2][2];
#pragma unroll
        for (int bj = 0; bj < 2; ++bj)
#pragma unroll
            for (int n = 0; n < 2; ++n) gv[bj][n] = *(const f32x4*)(gp + bj * HALF + n * 16);
#pragma unroll
        for (int ai = 0; ai < 2; ++ai)
#pragma unroll
            for (int m = 0; m < 4; ++m) { const size_t off = (size_t)(row0 + ai * HALF + m * 16) * 1024 + col0;
#pragma unroll
                for (int bj = 0; bj < 2; ++bj)
#pragma unroll
                    for (int n = 0; n < 2; ++n) { const f32x4 bs = *(const f32x4*)(base + off + bj * HALF + n * 16); *(f32x4*)(out + off + bj * HALF + n * 16) = bs + gv[bj][n] * acc[ai][bj][m][n]; }
                asm volatile("" ::: "memory"); }
    }
};
template <int CTRL> __device__ __forceinline__ float dppf(float x) { return __builtin_bit_cast(float, __builtin_amdgcn_mov_dpp(__builtin_bit_cast(int, x), CTRL, 0xf, 0xf, true)); }
template <int CTRL> __device__ __forceinline__ float dpp_old(float old, float x) { return __builtin_bit_cast(float, __builtin_amdgcn_update_dpp(__builtin_bit_cast(int, old), __builtin_bit_cast(int, x), CTRL, 0xf, 0xf, false)); }
struct EpiUpConv {
    static constexpr bool PERM = true;
    struct Pre { f32x2 v; };
    __device__ __forceinline__ Pre pre(const pg8::Unit& u, int p, int lane) const { const int c = u.pn * 128 + lane * 2;
        const float* sp = p < 3 ? cw + p * NUP + c : p == 3 ? cb + c : p < 7 ? cw + (p - 4) * NUP + DFF + c : cb + DFF + c; Pre r; r.v = *(const f32x2*)sp; return r; }
    bf16_t* A; float* HALO; const float* cw; const float* cb; LAS float* Bd; LAS float* Pm;
    __device__ __forceinline__ void operator()(const f32x4 (&acc)[2][2][4][2], const pg8::Unit& u, int wr, int wc, int fr, int fq, const Pre& pre_) const {
        using namespace pg8;
        const int x0 = wc * 32 + 8 * fq;
        if (fr == 0) {
#pragma unroll
            for (int ai = 0; ai < 2; ++ai)
#pragma unroll
                for (int bj = 0; bj < 2; ++bj)
#pragma unroll
                    for (int n = 0; n < 2; ++n) *(LAS f32x4*)(Bd + (ai * 4 + wr * 2) * 256 + bj * 128 + x0 + 4 * n) = acc[ai][bj][0][n]; }
        if (fr == 15) {
#pragma unroll
            for (int ai = 0; ai < 2; ++ai)
#pragma unroll
                for (int bj = 0; bj < 2; ++bj)
#pragma unroll
                    for (int n = 0; n < 2; ++n) *(LAS f32x4*)(Bd + (ai * 4 + wr * 2 + 1) * 256 + bj * 128 + x0 + 4 * n) = acc[ai][bj][3][n]; }
        {
          const int p = wr * 4 + wc, xx = (fq * 16 + fr) * 2; Pm[p * 128 + xx] = pre_.v.x; Pm[p * 128 + xx + 1] = pre_.v.y; }
        asm volatile("s_waitcnt lgkmcnt(0)" ::: "memory"); __builtin_amdgcn_s_barrier(); asm volatile("" ::: "memory");
        const int cbase = u.pn * 128 + x0;
        float* hz = HALO + ((size_t)(u.pm * 22 + u.pn) * 4) * 256;
#pragma unroll
        for (int ai = 0; ai < 2; ++ai) {
            const int blk = 2 * ai + wr;
            const LAS float* pbp = Bd + (((blk - 1) >> 1) * 4 + ((blk - 1) & 1) * 2 + 1) * 256 + x0;
            const LAS float* nbp = Bd + (((blk + 1) >> 1) * 4 + ((blk + 1) & 1) * 2) * 256 + x0;
#pragma unroll
            for (int n = 0; n < 2; ++n) {
                const int c = cbase + 4 * n;
                const LAS float* pp = Pm + x0 + 4 * n;
                float o[4][4];
#pragma unroll
                for (int j = 0; j < 4; ++j) {
                    const float w0v = pp[j], w1v = pp[128 + j], w2v = pp[256 + j], bv = pp[384 + j], w0g = pp[512 + j], w1g = pp[640 + j], w2g = pp[768 + j], bg = pp[896 + j];
                    float pbv = 0.f, pbg = 0.f, nbv = 0.f, nbg = 0.f;
                    if (blk > 0) { pbv = pbp[4 * n + j]; pbg = pbp[128 + 4 * n + j]; }
                    if (blk < 3) { nbv = nbp[4 * n + j]; nbg = nbp[128 + 4 * n + j]; }
                    float zv[4], zg[4];
#pragma unroll
                    for (int m = 0; m < 4; ++m) { zv[m] = acc[ai][0][m][n][j]; zg[m] = acc[ai][1][m][n][j]; }
                    const float pv0 = dpp_old<0x111>(pbv, zv[3]), pg0 = dpp_old<0x111>(pbg, zg[3]), nv3 = dpp_old<0x101>(nbv, zv[0]), ng3 = dpp_old<0x101>(nbg, zg[0]);
#pragma unroll
                    for (int m = 0; m < 4; ++m) {
                        const float pv = m == 0 ? pv0 : zv[m > 0 ? m - 1 : 0], pg = m == 0 ? pg0 : zg[m > 0 ? m - 1 : 0], nv = m == 3 ? nv3 : zv[m < 3 ? m + 1 : 3], ng = m == 3 ? ng3 : zg[m < 3 ? m + 1 : 3];
                        const float cv = fmaf(w0v, pv, fmaf(w1v, zv[m], fmaf(w2v, nv, bv))), cg = fmaf(w0g, pg, fmaf(w1g, zg[m], fmaf(w2g, ng, bg)));
                        if (m == 0 && blk == 0 && fr == 0) { hz[0 * 256 + x0 + 4 * n + j] = zv[0]; hz[0 * 256 + 128 + x0 + 4 * n + j] = zg[0]; hz[2 * 256 + x0 + 4 * n + j] = cv; hz[2 * 256 + 128 + x0 + 4 * n + j] = cg; }
                        if (m == 3 && blk == 3 && fr == 15) { hz[1 * 256 + x0 + 4 * n + j] = zv[3]; hz[1 * 256 + 128 + x0 + 4 * n + j] = zg[3]; hz[3 * 256 + x0 + 4 * n + j] = cv; hz[3 * 256 + 128 + x0 + 4 * n + j] = cg; }
                        o[m][j] = siluf_(cg) * cv; }
                }
#pragma unroll
                for (int m = 0; m < 4; ++m) { u32x2 w; w.x = cvt_pk_bf16(o[m][0], o[m][1]); w.y = cvt_pk_bf16(o[m][2], o[m][3]);
                    *(u32x2*)((char*)A + a_blk(u.pm, u.pn * 2 + (wc >> 1), wr, wc & 1, ai, m) + (fr * 4 + fq) * 16 + n * 8) = w; }
                asm volatile("" ::: "memory");
            }
        }
    }
};
__device__ __forceinline__ void conv_fix_panel(int pm, const float* __restrict__ HALO, const float* __restrict__ cw, bf16_t* __restrict__ A, int tid) {
#pragma unroll
    for (int rk = 0; rk < 2; ++rk) {
        if (rk == 0 ? (pm & 7) == 0 : (pm & 7) == 7) continue;
        const int nb = rk == 0 ? pm - 1 : pm + 1;
        for (int c = tid; c < DFF; c += NWV * 64) { const int pn = c >> 7, x = c & 127;
            const float* hp = HALO + ((size_t)(pm * 22 + pn) * 4 + 2 + rk) * 256; const float* hn = HALO + ((size_t)(nb * 22 + pn) * 4 + (rk == 0 ? 1 : 0)) * 256;
            const float wv = cw[(rk == 0 ? 0 : 2) * NUP + c], wg = cw[(rk == 0 ? 0 : 2) * NUP + DFF + c];
            const float val = hp[x] + wv * hn[x], gate = hp[128 + x] + wg * hn[128 + x];
            const int wc = x >> 5, fq = (x >> 3) & 3;
            *(bf16_t*)((char*)A + a_blk(pm, pn * 2 + (wc >> 1), rk, wc & 1, rk, rk ? 3 : 0) + ((rk ? 15 : 0) * 4 + fq) * 16 + (x & 7) * 2) = f2bf(siluf_(gate) * val); }
    }
}
__device__ __forceinline__ int sidx(int d, int ri, int n) { return d * 128 + ri * 64 + n; }
__device__ __forceinline__ void s5_tables_block(const S5In& P, int g, int qr, bf16_t* __restrict__ W1, bf16_t* __restrict__ B3, float* __restrict__ A32, LAS unsigned char* lds, int tid) {
    LAS float* BBs = (LAS float*)lds;
    LAS float* PWs = BBs + 4096;
    LAS float* CCs = PWs + 66 * 130;
    LAS float* KT = CCs + 32 * 130;
    if (tid < 128) {
        const int d = tid >> 6, n = tid & 63, dg = d * NG + g;
        const float dt = expf(P.ldt[dg]), lr = P.lre[dg * NS + n], li = P.lim[dg * NS + n];
        const float mag = expf(lr * dt), ang = li * dt, are = mag * cosf(ang), aim = mag * sinf(ang);
        const float den = lr * lr + li * li, nr = are - 1.f, ni = aim, fre = (nr * lr + ni * li) / den, fim = (ni * lr - nr * li) / den;
#pragma unroll
        for (int q = 0; q < PG; ++q) { const float br = P.bre[((size_t)dg * NS + n) * PG + q], bi = P.bim[((size_t)dg * NS + n) * PG + q];
            BBs[((d * 64 + n) * 16 + q) * 2] = fre * br - fim * bi; BBs[((d * 64 + n) * 16 + q) * 2 + 1] = fre * bi + fim * br; }
        double pr = 1.0, pi = 0.0; const double ar = (double)are, ai = (double)aim;
        for (int k = 0; k <= 32; ++k) { PWs[(d * 33 + k) * 130 + n * 2] = (float)pr; PWs[(d * 33 + k) * 130 + n * 2 + 1] = (float)pi; const double t0 = pr * ar - pi * ai, t1 = pr * ai + pi * ar; pr = t0; pi = t1; }
        if (qr == 0) { A32[(dg * NS + n) * 2] = PWs[(d * 33 + 32) * 130 + n * 2]; A32[(dg * NS + n) * 2 + 1] = PWs[(d * 33 + 32) * 130 + n * 2 + 1]; }
    }
    for (int i = tid; i < 2048; i += 512) { const int d = i >> 10, p = (i >> 6) & 15, n = i & 63; CCs[(i >> 6) * 130 + (i & 63) * 2] = P.cre[((size_t)(d * NG + g) * PG + p) * NS + n]; CCs[(i >> 6) * 130 + (i & 63) * 2 + 1] = P.cim[((size_t)(d * NG + g) * PG + p) * NS + n]; }
    __syncthreads();
    REPS(22) { const int d = tid >> 8, lagA = (tid >> 4) & 15, p = tid & 15; float accA[16], accB[16];
#pragma unroll
        for (int q = 0; q < 16; ++q) { accA[q] = 0.f; accB[q] = 0.f; }
        const LAS float* cp = CCs + (d * 16 + p) * 130; const LAS float* pa = PWs + (d * 33 + lagA) * 130; const LAS float* pb = PWs + (d * 33 + lagA + 16) * 130;
#pragma unroll 2
        for (int n = 0; n < 64; ++n) { const float cr = cp[2 * n], ci = cp[2 * n + 1], par = pa[2 * n], pai = pa[2 * n + 1], pbr = pb[2 * n], pbi = pb[2 * n + 1];
            const float xr = cr * par - ci * pai, xi = cr * pai + ci * par, yr = cr * pbr - ci * pbi, yi = cr * pbi + ci * pbr; const LAS float* bb = BBs + ((d * 64 + n) * 16) * 2;
#pragma unroll
            for (int q = 0; q < 16; ++q) { const float br = bb[2 * q], bi = bb[2 * q + 1]; accA[q] += xr * br - xi * bi; accB[q] += yr * br - yi * bi; } }
#pragma unroll
        for (int q = 0; q < 16; ++q) { KT[(d * 32 + lagA) * 260 + p * 16 + q] = accA[q]; KT[(d * 32 + lagA + 16) * 260 + p * 16 + q] = accB[q]; } }
    __syncthreads();
    for (int ch = tid; ch < 128 * 96; ch += 512) { const int r = ch / 96, cc = ch % 96, j = qr * 8 + (r >> 4), p = r & 15; float v[8];
        if (cc < 64) { const int i = cc >> 1, q0 = (cc & 1) * 8, lag = j - i;
#pragma unroll
            for (int e = 0; e < 8; ++e) { const int q = q0 + e; float x;
                if (lag > 0) x = KT[lag * 260 + p * 16 + q]; else if (lag < 0) x = KT[(32 - lag) * 260 + p * 16 + q];
                else x = KT[p * 16 + q] + KT[32 * 260 + p * 16 + q] + (q == p ? P.dsk[g * PG + p] : 0.f);
                v[e] = x; } }
        else { const int s0 = (cc - 64) * 8, d = s0 >> 7, ri = (s0 >> 6) & 1, n0 = s0 & 63, k = d == 0 ? j + 1 : 32 - j;
#pragma unroll
            for (int e = 0; e < 8; ++e) { const int n = n0 + e; const float cr = CCs[(d * 16 + p) * 130 + n * 2], ci = CCs[(d * 16 + p) * 130 + n * 2 + 1], pr = PWs[(d * 33 + k) * 130 + n * 2], pi = PWs[(d * 33 + k) * 130 + n * 2 + 1];
                v[e] = ri == 0 ? (cr * pr - ci * pi) : -(cr * pi + ci * pr); } }
        u32x4 w; w.x = pk2(v[0], v[1]); w.y = pk2(v[2], v[3]); w.z = pk2(v[4], v[5]); w.w = pk2(v[6], v[7]);
        *(u32x4*)(B3 + ((size_t)(g * 512 + j * 16 + p)) * KCAT + cc * 8) = w; }
    { const int d = qr >> 1, ri = qr & 1;
      for (int ch = tid; ch < 64 * 64; ch += 512) { const int n = ch >> 6, cc = ch & 63, i = cc >> 1, q0 = (cc & 1) * 8, k = d == 0 ? 31 - i : i; float v[8];
          const float pr = PWs[(d * 33 + k) * 130 + n * 2], pi = PWs[(d * 33 + k) * 130 + n * 2 + 1];
#pragma unroll
          for (int e = 0; e < 8; ++e) { const float br = BBs[((d * 64 + n) * 16 + q0 + e) * 2], bi = BBs[((d * 64 + n) * 16 + q0 + e) * 2 + 1]; v[e] = ri == 0 ? (pr * br - pi * bi) : (pr * bi + pi * br); }
          u32x4 w; w.x = pk2(v[0], v[1]); w.y = pk2(v[2], v[3]); w.z = pk2(v[4], v[5]); w.w = pk2(v[6], v[7]);
          *(u32x4*)(W1 + ((size_t)(g * 256 + qr * 64 + n)) * 512 + cc * 8) = w; } }
    __syncthreads();
}
struct EpiS1 {
    static constexpr bool PERM = false; float* L;
    EPI_NOPRE
    __device__ __forceinline__ void operator()(const f32x4 (&acc)[2][2][4][2], const pg8::Unit& u, int wr, int wc, int fr, int fq, const Pre& pre_) const {
        using namespace pg8; const int row0 = u.pm * BM + wr * 64 + fr, col0 = wc * 32 + 4 * fq;
#pragma unroll
        for (int ai = 0; ai < 2; ++ai)
#pragma unroll
            for (int m = 0; m < 4; ++m) { float* rp = L + ((size_t)u.grp * UROWS + row0 + ai * HALF + m * 16) * 256 + col0;
#pragma unroll
                for (int bj = 0; bj < 2; ++bj)
#pragma unroll
                    for (int n = 0; n < 2; ++n) *(f32x4*)(rp + bj * HALF + n * 16) = acc[ai][bj][m][n]; }
    }
};
struct EpiS3 {
    static constexpr bool PERM = true; bf16_t* SSM;
    EPI_NOPRE
    __device__ __forceinline__ void operator()(const f32x4 (&acc)[2][2][4][2], const pg8::Unit& u, int wr, int wc, int fr, int fq, const Pre& pre_) const {
        using namespace pg8; const int row0 = u.pm * BM + wr * 64 + fr, cl = u.pn * BM + wc * 32 + 8 * fq;
        EPI_ROWS_BF16(SSM + ((size_t)(u.grp * 1024 + row)) * 512 + cl, 128, gelu_tanh);
    }
};
struct OrderS1 { int G, c; bool xm;
    __device__ __forceinline__ bool next(int i, pg8::Unit& u) const {
        if (xm) { const int k = c >> 3; if (i != 0 || k >= 20) return false; u.grp = (c & 7) + 8 * (k / 5); u.pm = k % 5; u.pn = 0; return true; }
        const int L = i * G + c; if (L >= NG * 5) return false; u.grp = L / 5; u.pm = L % 5; u.pn = 0; return true; } };
struct OrderOne { pg8::Unit u0; __device__ __forceinline__ bool next(int i, pg8::Unit& u) const { if (i != 0) return false; u = u0; return true; } };
template <int MODE> struct EpiResNorm {
    static constexpr bool PERM = true;
    EPI_NOPRE
    const float* base; float* out; const float* gate; const float* fw; unsigned* xs; unsigned* cnt; LAS float* P;
    bf16_t* H2; const float* sh; const float* sc;
    bf16_t* x1b;
    __device__ __forceinline__ void operator()(f32x4 (&acc)[2][2][4][2], const pg8::Unit& u, int wr, int wc, int fr, int fq, const Pre& pre_) const {
        using namespace pg8; const int row0 = u.pm * BM + wr * 64 + fr, col0 = u.pn * BM + wc * 32 + 8 * fq;
        const int wid = wr * 4 + wc, lane = fq * 16 + fr;
        { const float* gp = gate + (size_t)((u.pm * BM) / SEQ) * 6144 + col0; f32x4 gv[2][2];
#pragma unroll
          for (int bj = 0; bj < 2; ++bj)
#pragma unroll
              for (int n = 0; n < 2; ++n) gv[bj][n] = *(const f32x4*)(gp + bj * HALF + n * 4);
#pragma unroll
          for (int ai = 0; ai < 2; ++ai) {
#pragma unroll
              for (int mh = 0; mh < 2; ++mh) {
              f32x4 xb[2][2][2];
#pragma unroll
              for (int m2 = 0; m2 < 2; ++m2)
#pragma unroll
                  for (int bj = 0; bj < 2; ++bj)
                      { const size_t o_ = (size_t)(row0 + ai * HALF + (2 * mh + m2) * 16) * 1024 + col0 + bj * HALF;
                          if (X1_BF16 && MODE == 0) { const u32x4 w_ = ((const u32x4*)x1b)[ll_idx(u.pm * 4 + u.pn, wr * 4 + wc, 16, ai * 8 + (2 * mh + m2) * 2 + bj, fq * 16 + fr)];
                              xb[m2][bj][0] = (f32x4){__uint_as_float(w_.x << 16), __uint_as_float(w_.x & 0xffff0000u), __uint_as_float(w_.y << 16), __uint_as_float(w_.y & 0xffff0000u)};
                              xb[m2][bj][1] = (f32x4){__uint_as_float(w_.z << 16), __uint_as_float(w_.z & 0xffff0000u), __uint_as_float(w_.w << 16), __uint_as_float(w_.w & 0xffff0000u)}; }
                          else { xb[m2][bj][0] = *(const f32x4*)(base + o_); xb[m2][bj][1] = *(const f32x4*)(base + o_ + 4); } }
#pragma unroll
              for (int m2 = 0; m2 < 2; ++m2) { const int m = 2 * mh + m2; float s = 0.f;
#pragma unroll
                  for (int bj = 0; bj < 2; ++bj)
#pragma unroll
                      for (int n = 0; n < 2; ++n) { const f32x4 x = xb[m2][bj][n] + gv[bj][n] * acc[ai][bj][m][n]; acc[ai][bj][m][n] = x; s += (x[0] * x[0] + x[1] * x[1]) + (x[2] * x[2] + x[3] * x[3]); }
                  s += __shfl_xor(s, 16); s += __shfl_xor(s, 32);
                  if (fq == 0) P[(ai * HALF + wr * 64 + m * 16 + fr) * 4 + wc] = s; } } } }
        asm volatile("s_waitcnt lgkmcnt(0)" ::: "memory"); __builtin_amdgcn_s_barrier(); asm volatile("" ::: "memory");
        const int prow = wid * 32 + (lane & 31);
        if (lane < 32) { const f32x4 p = *(const LAS f32x4*)(P + prow * 4);
            __hip_atomic_store(xs + ((size_t)(u.pm * BM + prow)) * 4 + u.pn, __float_as_uint((p[0] + p[1]) + (p[2] + p[3])), __ATOMIC_RELAXED, __HIP_MEMORY_SCOPE_AGENT); }
        asm volatile("s_waitcnt vmcnt(0)" ::: "memory");
        if (lane == 0) __hip_atomic_fetch_add(cnt + 64 * u.pm, 1u, __ATOMIC_RELAXED, __HIP_MEMORY_SCOPE_AGENT);
        if (wid == 0) {
            unsigned spins = 0;
            while ((unsigned)__builtin_amdgcn_readfirstlane(__hip_atomic_load(cnt + 64 * u.pm, __ATOMIC_RELAXED, __HIP_MEMORY_SCOPE_AGENT)) < 32u) { __builtin_amdgcn_s_sleep(2); if (++spins > (1u << 22)) break; }
            __builtin_amdgcn_fence(__ATOMIC_ACQUIRE, "agent");
        }
        asm volatile("s_waitcnt vmcnt(0) lgkmcnt(0)" ::: "memory"); __builtin_amdgcn_s_barrier(); asm volatile("" ::: "memory");
        if (lane < 32) { const unsigned* sl = xs + ((size_t)(u.pm * BM + prow)) * 4; float t = 0.f;
#pragma unroll
            for (int k = 0; k < 4; ++k) t += __uint_as_float(__hip_atomic_load(sl + k, __ATOMIC_RELAXED, __HIP_MEMORY_SCOPE_AGENT));
            P[1024 + prow] = rsqrtf(t * (1.f / DM) + EPS); }
        asm volatile("s_waitcnt lgkmcnt(0)" ::: "memory"); __builtin_amdgcn_s_barrier(); asm volatile("" ::: "memory");
        if (MODE == 0) {
            f32x4 fv[2][2];
#pragma unroll
            for (int bj = 0; bj < 2; ++bj)
#pragma unroll
                for (int n = 0; n < 2; ++n) fv[bj][n] = *(const f32x4*)(fw + col0 + bj * HALF + n * 4);
#pragma unroll
            for (int ai = 0; ai < 2; ++ai)
#pragma unroll
                for (int m = 0; m < 4; ++m) { const int r = ai * HALF + wr * 64 + m * 16 + fr; const float rs = P[1024 + r]; const size_t off = (size_t)(u.pm * BM + r) * 1024 + col0;
#pragma unroll
                    for (int bj = 0; bj < 2; ++bj)
#pragma unroll
                        for (int n = 0; n < 2; ++n) *(f32x4*)(out + off + bj * HALF + n * 4) = acc[ai][bj][m][n] * rs * fv[bj][n]; }
        } else {
            float rsv[2][4];
#pragma unroll
            for (int ai = 0; ai < 2; ++ai)
#pragma unroll
                for (int m = 0; m < 4; ++m) rsv[ai][m] = P[1024 + ai * HALF + wr * 64 + m * 16 + fr];
            const size_t mo = (size_t)((u.pm * BM) / SEQ) * 6144 + col0;
#pragma unroll
            for (int bj = 0; bj < 2; ++bj) { const int cc = bj * HALF;
                const f32x4 wwa = *(const f32x4*)(fw + col0 + cc), wwb = *(const f32x4*)(fw + col0 + cc + 4), s1a = *(const f32x4*)(sc + mo + cc) + 1.f, s1b = *(const f32x4*)(sc + mo + cc + 4) + 1.f, s0a = *(const f32x4*)(sh + mo + cc), s0b = *(const f32x4*)(sh + mo + cc + 4);
#pragma unroll
                for (int ai = 0; ai < 2; ++ai)
#pragma unroll
                    for (int m = 0; m < 4; ++m) { const size_t ro = (size_t)(row0 + ai * HALF + m * 16) * 1024 + col0 + cc; const f32x4 xa = acc[ai][bj][m][0], xb_ = acc[ai][bj][m][1];
                        if (X1_BF16) { u32x4 xw; xw.x = cvt_pk_bf16(xa[0], xa[1]); xw.y = cvt_pk_bf16(xa[2], xa[3]); xw.z = cvt_pk_bf16(xb_[0], xb_[1]); xw.w = cvt_pk_bf16(xb_[2], xb_[3]); ((u32x4*)x1b)[ll_idx(u.pm * 4 + u.pn, wr * 4 + wc, 16, ai * 8 + m * 2 + bj, fq * 16 + fr)] = xw; }
                        else { *(f32x4*)(out + ro) = xa; *(f32x4*)(out + ro + 4) = xb_; }
                        const f32x4 ya = (xa * rsv[ai][m] * wwa) * s1a + s0a, yb = (xb_ * rsv[ai][m] * wwb) * s1b + s0b; u32x4 w; w.x = cvt_pk_bf16(ya[0], ya[1]); w.y = cvt_pk_bf16(ya[2], ya[3]); w.z = cvt_pk_bf16(yb[0], yb[1]); w.w = cvt_pk_bf16(yb[2], yb[3]);
                        { const int t64 = m * 16 + fr, rv = ((t64 & 3) << 4) | (t64 >> 2);
                          *(u32x4*)((char*)H2 + blk16x32(u.pm, 16, u.pn * 4 + bj * 2 + (wc >> 1), ai, wr * 4 + (rv >> 4), wc & 1) + ((rv & 15) * 32 + 8 * fq) * 2) = w; } }
                asm volatile("" ::: "memory"); }
        }
    }
};
struct OrderRect { pg8::StaticOrder so; __device__ __forceinline__ bool next(int i, pg8::Unit& u) const { return so.next(i, u); } };
struct OrderRot { pg8::StaticOrder so; __device__ __forceinline__ bool next(int i, pg8::Unit& u) const { if (!so.next(i, u)) return false; u.pn = (u.pn & ~3) | ((u.pn + ((u.pm >> 3) & 1)) & 3); return true; } };
struct OrderA {
    pg8::StaticOrder so;
    __device__ __forceinline__ bool next(int i, pg8::Unit& u) const {
        if (so.next(i, u)) return true;
        const long L = (long)i * so.G + so.c - so.nwg; if (L < 0 || L >= 64) return false;
        u.pm = 128 + (int)(L >> 2); u.pn = 4 + (int)(L & 3); u.grp = 0; return true;
    }
};

__global__ void __launch_bounds__(NWV * 64, 2) mk_fwd(MkArgs a) {
    extern __shared__ __attribute__((aligned(16))) unsigned char lds_raw[];
    LAS unsigned char* lds = (LAS unsigned char*)lds_raw;
#if !USE_XBAR
    cg::grid_group grid = cg::this_grid();
#endif
    const int tid0 = threadIdx.x, wave = __builtin_amdgcn_readfirstlane(tid0 >> 6);
#define PHASE_IDS const int tid = opaque_tid(wave), lane = tid & 63; (void)tid; (void)lane
    const int G = gridDim.x, bx = blockIdx.x;
    const int gw = bx * NWV + wave, NGW = G * NWV;
    unsigned char* ws = a.ws;
#define mod ((float*)(ws + WS_MOD))
#define WTin ((bf16_t*)(ws + WS_WIN))
#define WTbr ((bf16_t*)(ws + WS_WBR))
#define WTglu ((bf16_t*)(ws + WS_WGLU))
#define WTout ((bf16_t*)(ws + WS_WOUT))
#define WTup ((bf16_t*)(ws + WS_WUP))
#define WTdn ((bf16_t*)(ws + WS_WDN))
#define H ((bf16_t*)(ws + WS_H))
#define Q ((bf16_t*)(ws + WS_Q))
#define Kb ((bf16_t*)(ws + WS_K))
#define Vb ((bf16_t*)(ws + WS_V))
#define Ucat ((bf16_t*)(ws + WS_UCAT))
#define Uctx Ucat
#define SG ((bf16_t*)(ws + WS_SG))
#define O ((bf16_t*)(ws + WS_O))
#define SSM ((bf16_t*)(ws + WS_SSM))
#define GLU ((bf16_t*)(ws + WS_GLU))
#define MG ((bf16_t*)out)
#define H2 ((bf16_t*)(ws + WS_H2))
#define Ab ((bf16_t*)(ws + WS_A))
#define Ytmp ((float*)(ws + WS_YTMP))
    float* const out = a.out;
    const int lo = a.ph_lo, hi = a.ph_hi;
    volatile LAS unsigned* bst = (volatile LAS unsigned*)(lds + MK_LDS - 16);
    if (tid0 < 3) bst[tid0] = 0u;
    __syncthreads();
    XcdBarrier xbar = xcd_barrier_post((unsigned*)(ws + WS_CTL), bst);
    if (tid0 == 0 && xbar.x != (unsigned)(bx & 7)) (void)xb_add((unsigned*)(ws + WS_CTL) + GB_MISMATCH, 1u);
    bool grp_ok = false; unsigned tgen = 0u; (void)tgen;
#define IN(k) (lo <= (k) && (k) < hi)
#if USE_XBAR
#define SEAM(k) do { if (IN(k) && IN((k) + 1)) xcd_barrier(xbar); } while (0)
#define SEAMG(k) do { if (IN(k) && IN((k) + 1)) { if (grp_ok) grp_barrier(xbar); else xcd_barrier(xbar); } } while (0)
#define SEAMGT(k, topw) do { if (IN(k) && IN((k) + 1)) { if (grp_ok) grp_barrier(xbar, (unsigned*)(ws + WS_CTL) + (topw)); else xcd_barrier(xbar); } } while (0)
#define SEAMT(k) do { if (IN(k) && IN((k) + 1)) { if (grp_ok) team_barrier((unsigned*)(ws + WS_CTL) + TB_WORD(bx & 7, (bx >> 3) & 7), ++tgen); else xcd_barrier(xbar); } } while (0)
#else
#define SEAM(k) do { if (IN(k) && IN((k) + 1)) grid.sync(); } while (0)
#define SEAMG(k) SEAM(k)
#define SEAMGT(k, topw) SEAM(k)
#define SEAMT(k) SEAM(k)
#endif

    if (IN(0)) REPS(0) { PHASE_IDS;
        if (bx < 256) {
            LAS float* sc = (LAS float*)lds;
            LAS float* red = (LAS float*)(lds + 17 * 1024 * 4);
            for (int i = tid; i < 17 * 1024; i += NWV * 64) { const int r = i >> 10, k = i & 1023; sc[i] = siluf_(r < NB ? a.in[1][(size_t)r * DM + k] : a.in[3][k]); }
            __syncthreads();
            const float* wm = a.in[4]; const int ks = tid >> 5, c = tid & 31;
            for (int ch = bx; ch < 256; ch += G) {
                float acc[17];
#pragma unroll
                for (int r = 0; r < 17; ++r) acc[r] = 0.f;
                if (c < 24) { const float* wp = wm + (size_t)(ks * 64) * 6144 + ch * 24 + c;
#pragma unroll 4
                    for (int k = 0; k < 64; ++k) { const float w = wp[(size_t)k * 6144];
#pragma unroll
                        for (int r = 0; r < 17; ++r) acc[r] = fmaf(sc[r * 1024 + ks * 64 + k], w, acc[r]); }
#pragma unroll
                    for (int r = 0; r < 17; ++r) red[(ks * 17 + r) * 24 + c] = acc[r]; }
                __syncthreads();
                if (tid < 17 * 24) { const int r = tid / 24, cc = tid % 24; float s = a.in[5][ch * 24 + cc];
#pragma unroll
                    for (int w = 0; w < 16; ++w) s += red[(w * 17 + r) * 24 + cc];
                    mod[(size_t)r * 6144 + ch * 24 + cc] = s; }
                __syncthreads();
            }
        }
        LAS float* scr = (LAS float*)(lds + wave * 16384);
        for (int it = gw; it < (DM / 64) * (DIN / 32); it += NGW) transpose_item<0>(a.in[8], DM, DIN, WTin, scr, it, lane);
    }
    SEAM(0);
#if USE_XBAR && GRP_SEAMS
    if (IN(0) && IN(1)) {
        if (tid0 == 0) bst[2] = (xb_ld((unsigned*)(ws + WS_CTL) + GB_MISMATCH) == 0u && bst[0] == 32u && bst[1] == 8u && G == 256) ? 1u : 0u;
        __syncthreads();
        grp_ok = bst[2] != 0u;
    }
#endif
    if (IN(1)) REPS(1) { PHASE_IDS;
        const bool full = G >= 256;
        unsigned* ctxcnt = (unsigned*)(ws + WS_CTL + 98304) + 64 * 8;
        constexpr int I_SQ = (DM / 64) * (DM / 32), I_GLU = (512 / 64) * (2048 / 32), I_UP = (DM / 64) * (NUP / 32), I_DN = (DFF / 64) * (DM / 32);
        constexpr int NITEMS = 2 * I_SQ + I_GLU + I_UP + I_DN, A_ITEMS = 1664;
#define COPY_ITEM(r_) do { int r = (r_); \
            if (r < I_SQ) { transpose_item<0>(a.in[11], DM, DM, WTbr, scr, r, lane); break; } r -= I_SQ; \
            if (r < I_GLU) { transpose_item<2>(a.in[20], 512, 2048, WTglu, scr, r, lane); break; } r -= I_GLU; \
            if (r < I_SQ) { transpose_item<0>(a.in[21], DM, DM, WTout, scr, r, lane); break; } r -= I_SQ; \
            if (r < I_UP) { transpose_item<1>(a.in[22], DM, NUP, WTup, scr, r, lane); break; } r -= I_UP; \
            transpose_item<0>(a.in[25], DFF, DM, WTdn, scr, r, lane); } while (0)
        if (full) {
            if (bx >= 192) {
                const int lane = opaque_tid(wave) & 63; const int r0 = ML + 64 * (bx - 192);
                for (int r = r0 + 4 * wave; r < r0 + 64; r += 4 * NWV) norm_mod_rows4(a.in[2] + (size_t)(r - ML) * DM, a.in[6], mod + (size_t)NB * 6144, mod + (size_t)NB * 6144 + 1024, H + (size_t)r * DM, lane);
                asm volatile("s_waitcnt vmcnt(0)" ::: "memory"); __syncthreads();
                if (threadIdx.x == 0) { __builtin_amdgcn_fence(__ATOMIC_RELEASE, "agent"); asm volatile("s_waitcnt vmcnt(0)" ::: "memory"); __hip_atomic_fetch_add(ctxcnt, 1u, __ATOMIC_RELAXED, __HIP_MEMORY_SCOPE_AGENT); }
            }
            if (bx < 64) {
                const int L = bx; const int lane = opaque_tid(wave) & 63; LAS float* scr = (LAS float*)(lds + wave * 16384);
                for (int it = bx * NWV + wave; it < A_ITEMS; it += 64 * NWV) COPY_ITEM(it);
                if (threadIdx.x < 64) { unsigned spins = 0;
                    while ((unsigned)__builtin_amdgcn_readfirstlane(__hip_atomic_load(ctxcnt, __ATOMIC_RELAXED, __HIP_MEMORY_SCOPE_AGENT)) < 64u) { __builtin_amdgcn_s_sleep(2); if (++spins > (1u << 22)) break; }
                    __builtin_amdgcn_fence(__ATOMIC_ACQUIRE, "agent"); asm volatile("s_waitcnt vmcnt(0)" ::: "memory"); }
                __syncthreads();
                pg8::Gemm g{H, WTin, DM, DM, DM, 0, 0, 0}; OrderOne S{{128 + (L >> 2), 4 + (L & 3), 0}}; EpiAfast E{Q, Kb, Vb, Ucat, SG, a.in[9], a.in[10], (LAS float*)(lds + 131072)};
                pg8::gemm_phase<EpiAfast, OrderOne>(lds, g, S, E, wave);
            }
            if (bx >= 64 && bx < 192) {
                const int ib = bx - 64; const int tid = opaque_tid(wave), lane = tid & 63;
                S5In s5{a.in[12], a.in[13], a.in[14], a.in[15], a.in[16], a.in[17], a.in[18], a.in[19]};
                __syncthreads();
                REPS(17) s5_tables_block(s5, ib >> 2, ib & 3, (bf16_t*)((char*)a.out + OUT_W1), (bf16_t*)((char*)a.out + OUT_B3), (float*)(ws + WS_A32), lds, tid);
                LAS float* scr = (LAS float*)(lds + wave * 16384);
                REPS(18) for (int it = A_ITEMS + ib * NWV + wave; it < NITEMS; it += 128 * NWV) COPY_ITEM(it);
            }
        } else {
            { const int tid = opaque_tid(wave), lane = tid & 63; S5In s5{a.in[12], a.in[13], a.in[14], a.in[15], a.in[16], a.in[17], a.in[18], a.in[19]};
              __syncthreads();
              for (int it = bx; it < 128; it += G) s5_tables_block(s5, it >> 2, it & 3, (bf16_t*)((char*)a.out + OUT_W1), (bf16_t*)((char*)a.out + OUT_B3), (float*)(ws + WS_A32), lds, tid);
              LAS float* scr = (LAS float*)(lds + wave * 16384);
              for (int it = bx * NWV + wave; it < NITEMS; it += G * NWV) COPY_ITEM(it); }
            for (int L = bx; L < 64; L += G) {
                const int r0 = ML + 256 * (L >> 2); const int lane = opaque_tid(wave) & 63;
                __syncthreads();
                for (int r = r0 + 4 * wave; r < r0 + 256; r += 4 * NWV) norm_mod_rows4(a.in[2] + (size_t)(r - ML) * DM, a.in[6], mod + (size_t)NB * 6144, mod + (size_t)NB * 6144 + 1024, H + (size_t)r * DM, lane);
                asm volatile("s_waitcnt vmcnt(0)" ::: "memory"); __syncthreads();
                pg8::Gemm g{H, WTin, DM, DM, DM, 0, 0, 0}; OrderOne S{{128 + (L >> 2), 4 + (L & 3), 0}}; EpiAfast E{Q, Kb, Vb, Ucat, SG, a.in[9], a.in[10], (LAS float*)(lds + 131072)};
                pg8::gemm_phase<EpiAfast, OrderOne>(lds, g, S, E, wave);
            }
        }
#undef COPY_ITEM
        { const int lane = opaque_tid(wave) & 63; const int xl = bx & 7; unsigned* head = (unsigned*)(ws + WS_CTL + 98304) + 64 * xl;
          for (;;) { unsigned c = 0; if (lane == 0) c = __hip_atomic_fetch_add(head, 1u, __ATOMIC_RELAXED, __HIP_MEMORY_SCOPE_AGENT); c = (unsigned)__builtin_amdgcn_readfirstlane((int)c);
              if (c >= 256u) break;
              const int r0 = xl * 4096 + (int)c * 16; const int mb = r0 / SEQ;
#pragma unroll 1
              for (int r = r0; r < r0 + 16; r += 4) norm_mod_rows4(a.in[0] + (size_t)r * DM, a.in[6], mod + (size_t)mb * 6144, mod + (size_t)mb * 6144 + 1024, H + (size_t)r * DM, lane); } }
    }
    SEAMGT(1, GB_TOPA);
    if (IN(2)) REPS(2) {
        pg8::Gemm g{H, WTin, DM, DM, DM, 0, 0, 0}; OrderRot S; S.so.init(ML / 256, DIN / 256, G, bx);
        EpiAfast E{Q, Kb, Vb, Ucat, SG, a.in[9], a.in[10], (LAS float*)(lds + 131072)};
        pg8::gemm_phase<EpiAfast, OrderRot>(lds, g, S, E, wave);
    }
    SEAMGT(2, GB_TOPB);
    const float* Lb = (const float*)((char*)a.out + OUT_L); const float* A32 = (const float*)(ws + WS_A32);
    unsigned* s1cnt = (unsigned*)(ws + WS_CTL) + 14464 + 64 * (bx & 7);
#define S5_RECUR(g, pm) do { const int bl = tid >> 7, d = (tid >> 6) & 1, n = tid & 63, b = pm * 4 + bl; \
              const float ar = A32[((d * NG + g) * NS + n) * 2], ai = A32[((d * NG + g) * NS + n) * 2 + 1]; \
              const float* Lg = Lb + (size_t)g * UROWS * 256 + sidx(d, 0, n); bf16_t* Sg = Ucat + (size_t)g * UROWS * KCAT + 512 + sidx(d, 0, n); \
              float sr = 0.f, si = 0.f; \
              { float lr[8], li[8]; \
_Pragma("unroll") \
                for (int i = 0; i < 8; ++i) { const int row = 1024 + b * 8 + (d == 0 ? i : 7 - i); lr[i] = Lg[(size_t)row * 256]; li[i] = Lg[(size_t)row * 256 + 64]; } \
_Pragma("unroll") \
                for (int i = 0; i < 8; ++i) { const float t0 = ar * sr - ai * si + lr[i], t1 = ar * si + ai * sr + li[i]; sr = t0; si = t1; } } \
_Pragma("unroll 1") \
              for (int i0 = 0; i0 < 64; i0 += 32) { float lr[32], li[32]; \
_Pragma("unroll") \
                  for (int i = 0; i < 32; ++i) { const int row = b * 64 + (d == 0 ? i0 + i : 63 - i0 - i); lr[i] = Lg[(size_t)row * 256]; li[i] = Lg[(size_t)row * 256 + 64]; } \
_Pragma("unroll") \
                  for (int i = 0; i < 32; ++i) { const int row = b * 64 + (d == 0 ? i0 + i : 63 - i0 - i); \
                      Sg[(size_t)row * KCAT] = f2bf(sr); Sg[(size_t)row * KCAT + 64] = f2bf(si); \
                      const float t0 = ar * sr - ai * si + lr[i], t1 = ar * si + ai * sr + li[i]; sr = t0; si = t1; } } \
              asm volatile("s_waitcnt vmcnt(0)" ::: "memory"); __syncthreads(); } while (0)
    if (IN(4)) REPS(4) {
        if (grp_ok) top_wait((unsigned*)(ws + WS_CTL) + GB_TOPA);
        const int nrounds = (NB * 2 * 32 + G - 1) / G;
        for (int i = 0; i < nrounds; ++i) {
#if !S5_NAIVE
            if (i == (grp_ok ? 1 : 0)) {
                if (grp_ok && (bx >> 3) < 20) top_wait((unsigned*)(ws + WS_CTL) + GB_TOPB);
                pg8::Gemm g{Ucat, (const bf16_t*)((char*)a.out + OUT_W1), KCAT, 512, 512, (size_t)UROWS * KCAT * 2, (size_t)256 * 512 * 2, 0}; OrderS1 S{G, bx, grp_ok}; EpiS1 E{(float*)((char*)a.out + OUT_L)}; pg8::gemm_phase<EpiS1, OrderS1>(lds, g, S, E, wave);
                if (grp_ok && (bx >> 3) < 20 && tid0 == 0) (void)xb_add(s1cnt, 1u); }
#endif
            int unit; if (G == 256) { const int bk = grp_ok ? (2 * (bx & 7) + (i >> 1)) * 2 + (i & 1) : i * 8 + (bx & 7), s = bx >> 3; unit = bk * 32 + s; } else unit = i * G + bx;
            if (unit >= NB * 2 * 32) break;
            const int bk = unit >> 5, s = unit & 31, b = bk >> 1, kvh = bk & 1, h = kvh * 4 + (s >> 3), qb = s & 7;
            const size_t q0 = ((size_t)b * SEQ + (size_t)qb * 256) * 1024 + h * 128, k0 = (size_t)b * LKV * 256 + kvh * 128;
            att::attn_dense_body(Q + q0, Kb + k0, Vb + k0, O, LKV, (char*)lds_raw, wave, b * 8 + qb, h);
        }
#if !S5_NAIVE
        if (grp_ok && (bx >> 3) >= 20) {
            const int tid = opaque_tid(wave);
            if (tid0 < 64) { unsigned spins = 0;
                while ((unsigned)__builtin_amdgcn_readfirstlane(xb_ld(s1cnt)) < 20u) { __builtin_amdgcn_s_sleep(2); if (++spins > (1u << 22)) break; }
                __builtin_amdgcn_fence(__ATOMIC_ACQUIRE, "agent"); asm volatile("s_waitcnt vmcnt(0)" ::: "memory"); }
            __syncthreads();
            { const int j = (bx >> 3) - 20, x8 = bx & 7;
              if (j < 4) { const int gg[2] = {x8 + 8 * (j >> 2), x8 + 8 * ((j + 12) >> 2)}, pp[2] = {j & 3, (j + 12) & 3}; s5_recur<2, 16>(Lb, A32, Ucat, tid, gg, pp); }
              else { const int gg[1] = {x8 + 8 * (j >> 2)}, pp[1] = {j & 3}; s5_recur<1, 32>(Lb, A32, Ucat, tid, gg, pp); } }
        }
#endif
    }
    SEAMG(4);
    if (IN(5)) REPS(5) { PHASE_IDS;
#if S5_NAIVE
        S5In s5{a.in[12], a.in[13], a.in[14], a.in[15], a.in[16], a.in[17], a.in[18], a.in[19]};
        for (int it = bx * 2 + wave; wave < 2 && it < NB * NG; it += G * 2) s5_naive_wave(s5, Ucat, Uctx, Ytmp, SSM, lane, it & 31, it >> 5);
#else
        for (int un = bx; un < 256; un += G) {
            const int g = grp_ok ? (un & 7) + 8 * (un >> 6) : un >> 3, pm = grp_ok ? (un >> 4) & 3 : (un >> 1) & 3, pn = grp_ok ? (un >> 3) & 1 : un & 1;
            if (!grp_ok) S5_RECUR(g, pm);
            pg8::Gemm gm{Ucat, (const bf16_t*)((char*)a.out + OUT_B3), KCAT, KCAT, KCAT, (size_t)UROWS * KCAT * 2, (size_t)512 * KCAT * 2, 0}; OrderOne S{{pm, pn, g}}; EpiS3 E{SSM};
            REPS(20) pg8::gemm_phase<EpiS3, OrderOne>(lds, gm, S, E, wave);
        }
#endif
    }
    SEAM(5);
#undef S5_RECUR
    if (IN(6)) REPS(6) { pg8::Gemm g{SSM, WTglu, 512, 512, 512, 0, 0, 1}; OrderRect S; S.so.init(ML / 256, 2048 / 256, G, bx); EpiGluPair E{SG, GLU}; pg8::gemm_phase<EpiGluPair, OrderRect>(lds, g, S, E, wave); }
    SEAMT(6);
    if (IN(7)) REPS(7) { pg8::Gemm g{O, WTbr, DM, DM, DM, 0, 0, 4}; OrderRect S; S.so.init(ML / 256, DM / 256, G, bx); EpiMergeFast E{SG, GLU, MG}; pg8::gemm_phase<EpiMergeFast, OrderRect>(lds, g, S, E, wave); }
    SEAMT(7);
    if (IN(8)) REPS(8) {
#if STAGGER8_US > 0
        if ((bx & 7) >= 4) { const unsigned long long t0 = __builtin_amdgcn_s_memrealtime(); while (__builtin_amdgcn_s_memrealtime() - t0 < (unsigned long long)(STAGGER8_US * 100)) __builtin_amdgcn_s_sleep(32); }
#endif
        pg8::Gemm g{MG, WTout, DM, DM, DM, 0, 0, 5}; OrderRect S; S.so.init(ML / 256, DM / 256, G, bx); EpiResNorm<1> E{a.in[0], out, mod + 2048, a.in[7], (unsigned*)(ws + WS_XS2), (unsigned*)(ws + WS_CTL + 65536), (LAS float*)(lds + 131072), H2, mod + 3072, mod + 4096, (bf16_t*)(ws + WS_X1B)}; pg8::gemm_phase<EpiResNorm<1>, OrderRect>(lds, g, S, E, wave); }
    SEAMT(8);
    if (IN(10)) REPS(10) { pg8::Gemm g{H2, WTup, DM, DM, DM, 0, 0, 4}; OrderRect S; S.so.init(ML / 256, NUP / 256, G, bx);
        EpiUpConv E{Ab, (float*)(ws + WS_HALO), a.in[23], a.in[24], (LAS float*)(lds + 131072), (LAS float*)(lds + 131072 + 8192)}; pg8::gemm_phase<EpiUpConv, OrderRect>(lds, g, S, E, wave); }
    SEAMG(10);
    if (IN(14)) { PHASE_IDS; pg8::Gemm g{Ab, WTdn, DFF, DFF, DFF, 0, 0, 3}; OrderRect S; S.so.init(ML / 256, DM / 256, G, bx);
        { pg8::Unit u; for (int i = 0; S.next(i, u); ++i) conv_fix_panel(u.pm, (const float*)(ws + WS_HALO), a.in[23], Ab, tid); asm volatile("s_waitcnt vmcnt(0)" ::: "memory"); __syncthreads(); }
        EpiResNorm<0> E{out, out, mod + 5120, a.in[26], (unsigned*)(ws + WS_XS), (unsigned*)(ws + WS_CTL + 16384), (LAS float*)(lds + 131072), nullptr, nullptr, nullptr, (bf16_t*)(ws + WS_X1B)}; pg8::gemm_phase<EpiResNorm<0>, OrderRect>(lds, g, S, E, wave); }
#undef IN
#undef SEAM
#undef SEAMG
#undef SEAMGT
#undef SEAMT
#undef mod
#undef WTin
#undef WTbr
#undef WTglu
#undef WTout
#undef WTup
#undef WTdn
#undef H
#undef Q
#undef Kb
#undef Vb
#undef Ucat
#undef Uctx
#undef SG
#undef O
#undef SSM
#undef GLU
#undef MG
#undef H2
#undef Ab
#undef Ytmp
}

extern "C" void kernel_launch(void* const* d_in, const int* in_sizes, int n_in, void* d_out, int out_size, void* d_ws, size_t ws_size, hipStream_t stream) {
    static int grid_blocks = 0;
    if (grid_blocks == 0) {
        if (n_in != 27 || in_sizes[0] != ML * DM || out_size != ML * DM || ws_size < WS_NEED) {
            fprintf(stderr, "kernel_launch: unexpected shapes: n_in %d in0 %d out %d ws %zu (need >= %zu)\n", n_in, n_in > 0 ? in_sizes[0] : -1, out_size, ws_size, (size_t)WS_NEED); grid_blocks = -1; return; }
        int dev = 0, cus = 0, per_cu = 0;
        if (hipGetDevice(&dev) != hipSuccess || hipDeviceGetAttribute(&cus, hipDeviceAttributeMultiprocessorCount, dev) != hipSuccess) { fprintf(stderr, "kernel_launch: device query failed\n"); grid_blocks = -1; return; }
        if (hipFuncSetAttribute((const void*)mk_fwd, hipFuncAttributeMaxDynamicSharedMemorySize, MK_LDS) != hipSuccess) { fprintf(stderr, "kernel_launch: hipFuncSetAttribute(mk_fwd) failed\n"); grid_blocks = -1; return; }
        if (hipOccupancyMaxActiveBlocksPerMultiprocessor(&per_cu, (const void*)mk_fwd, NWV * 64, MK_LDS) != hipSuccess || per_cu < 1) { fprintf(stderr, "kernel_launch: occupancy query says %d blocks/CU\n", per_cu); grid_blocks = -1; return; }
        grid_blocks = cus;
    }
    if (grid_blocks < 0) return;
    if (hipMemsetAsync((char*)d_ws + WS_CTL, 0, 131072, stream) != hipSuccess) fprintf(stderr, "kernel_launch: memset failed\n");
    MkArgs a{};
    for (int i = 0; i < 27; ++i) a.in[i] = (const float*)d_in[i];
    a.out = (float*)d_out; a.ws = (unsigned char*)d_ws; a.ph_lo = 0; a.ph_hi = 16;
    void* args[] = {&a};
    hipError_t e = hipLaunchCooperativeKernel((const void*)mk_fwd, dim3(grid_blocks), dim3(NWV * 64), args, MK_LDS, stream);
    if (e != hipSuccess) fprintf(stderr, "kernel_launch: cooperative launch failed: %s (grid %d)\n", hipGetErrorString(e), grid_blocks);
}
```
